# Optimizing an MI355X kernel written in HIP

```python
import jax, jax.numpy as jnp
from jax import lax
import numpy as np

D_MODEL = 1024
BATCH = 16
SEQ = 2048
DEPTH = 1

MEM_LEN = 256
GM_GROUPS = 4
GM_CHUNK = 128
GM_WIDTH = 512
GM_GROUP_DIM = GM_WIDTH // GM_GROUPS
HG_HEADS = 4
HG_KDIM = 128
HG_VDIM = 128
HG_WIDTH = HG_HEADS * HG_KDIM
HG_VWIDTH = HG_HEADS * HG_VDIM
HG_CHUNK = 64
XA_HEADS = 4
XA_HEAD_DIM = 128
XA_WIDTH = XA_HEADS * XA_HEAD_DIM
N_BRANCH = 3
BRANCH_WIDTH = 512
D_FF = 2816
CONV_WIDTH = 3
EPS = 1e-6
IN_SPLITS = (GM_WIDTH, GM_WIDTH, HG_WIDTH, HG_WIDTH, HG_VWIDTH, HG_VWIDTH, XA_WIDTH, N_BRANCH * D_MODEL)
IN_WIDTH = GM_WIDTH * 2 + HG_WIDTH * 2 + HG_VWIDTH * 2 + XA_WIDTH + N_BRANCH * D_MODEL

kernel_name = 'hybrid_gmlp_hgrn2_memattn_convffn'


def rms_norm(x, g):
    xf = x.astype(jnp.float32)
    y = xf * lax.rsqrt(jnp.mean(xf * xf, axis=-1, keepdims=True) + EPS)
    return y.astype(x.dtype) * g


def layer_norm(x, g, b):
    xf = x.astype(jnp.float32)
    mu = jnp.mean(xf, axis=-1, keepdims=True)
    var = jnp.mean(jnp.square(xf - mu), axis=-1, keepdims=True)
    return ((xf - mu) * lax.rsqrt(var + EPS)).astype(x.dtype) * g + b


def spatial_gating(z_u, z_v, ln_g, ln_b, w_s, b_s):
    B, S, _ = z_u.shape
    v = layer_norm(z_v, ln_g, ln_b).reshape(B, S // GM_CHUNK, GM_CHUNK, GM_GROUPS, GM_GROUP_DIM)
    causal = jnp.tril(jnp.ones((GM_CHUNK, GM_CHUNK), dtype=bool))
    w = jnp.where(causal[None], w_s, 0)
    mixed = jnp.einsum('gts,bnsgc->bntgc', w, v) + b_s.T[None, None, :, :, None]
    return z_u * mixed.reshape(B, S, GM_WIDTH)


def hgrn2(q, f_raw, i, g, lb, norm_g):
    B, S, _ = q.shape
    N = S // HG_CHUNK
    f32 = jnp.float32
    lbf = lb.astype(f32).reshape(HG_HEADS, HG_KDIM)
    fg = lbf + (1.0 - lbf) * jax.nn.sigmoid(f_raw.astype(f32).reshape(B, S, HG_HEADS, HG_KDIM))
    k = 1.0 - fg
    logf = jnp.log(fg)
    qf = jax.nn.silu(q.astype(f32)).reshape(B, S, HG_HEADS, HG_KDIM)
    vf = i.astype(f32).reshape(B, S, HG_HEADS, HG_VDIM)

    def to_chunks(t):
        return t.reshape(B, N, HG_CHUNK, HG_HEADS, t.shape[-1]).transpose(1, 0, 3, 2, 4)

    causal = jnp.tril(jnp.ones((HG_CHUNK, HG_CHUNK), dtype=bool))

    def step(state, xs):
        qc, kc, vc, lfc = xs
        a = jnp.cumsum(lfc, axis=2)
        inter = jnp.einsum('bhtk,bhkv->bhtv', qc * jnp.exp(a), state)
        diff = a[:, :, :, None, :] - a[:, :, None, :, :]
        decay = jnp.exp(jnp.where(causal[:, :, None], diff, -jnp.inf))
        scores = jnp.einsum('bhtk,bhtsk,bhsk->bhts', qc, decay, kc)
        intra = jnp.einsum('bhts,bhsv->bhtv', scores, vc)
        a_last = a[:, :, -1:, :]
        new_state = (jnp.exp(a_last[:, :, 0, :])[..., None] * state
                     + jnp.einsum('bhsk,bhsv->bhkv', kc * jnp.exp(a_last - a), vc))
        return new_state, inter + intra

    s0 = jnp.zeros((B, HG_HEADS, HG_KDIM, HG_VDIM), f32)
    _, o = lax.scan(step, s0, (to_chunks(qf), to_chunks(k), to_chunks(vf), to_chunks(logf)))
    o = o.transpose(1, 0, 3, 2, 4).reshape(B, S, HG_HEADS, HG_VDIM)
    o = rms_norm(o, norm_g.astype(f32)) * jax.nn.silu(g.astype(f32).reshape(B, S, HG_HEADS, HG_VDIM))
    return o.reshape(B, S, HG_VWIDTH).astype(q.dtype)


def memory_attention(q, mem, mem_g, w_kv):
    B, S, _ = q.shape
    M = mem.shape[1]
    kv = rms_norm(mem, mem_g) @ w_kv
    k, v = jnp.split(kv, 2, axis=-1)
    k = k.reshape(B, M, XA_HEADS, XA_HEAD_DIM)
    v = v.reshape(B, M, XA_HEADS, XA_HEAD_DIM)
    qh = q.reshape(B, S, XA_HEADS, XA_HEAD_DIM)
    s = jnp.einsum('bshd,bmhd->bhsm', qh, k).astype(jnp.float32) * (XA_HEAD_DIM ** -0.5)
    p = jax.nn.softmax(s, axis=-1).astype(q.dtype)
    return jnp.einsum('bhsm,bmhd->bshd', p, v).reshape(B, S, XA_WIDTH)


def conv_ffn(h, w_up, conv_w, conv_b, w_down):
    S = h.shape[1]
    a, b = jnp.split(h @ w_up, 2, axis=-1)
    ap = jnp.pad(a, ((0, 0), (CONV_WIDTH - 1, 0), (0, 0)))
    ac = conv_b + conv_w[0] * ap[:, 0:S]
    for j in range(1, CONV_WIDTH):
        ac = ac + conv_w[j] * ap[:, j:j + S]
    return (jax.nn.silu(ac) * b) @ w_down


def setup_inputs(seed: int = 0) -> dict:
    key = jax.random.key(seed)
    ks = jax.random.split(key, 24)
    f32 = jnp.float32
    nrm = lambda k, shape, scale: jax.random.normal(k, shape, f32) * scale
    return {
        'x': nrm(ks[0], (BATCH, SEQ, D_MODEL), 1.0),
        'mem': nrm(ks[1], (BATCH, MEM_LEN, D_MODEL), 1.0),
        'norm1_g': 1.0 + nrm(ks[2], (DEPTH, D_MODEL), 0.02),
        'w_in': nrm(ks[3], (DEPTH, D_MODEL, IN_WIDTH), D_MODEL ** -0.5),
        'ln_v_g': 1.0 + nrm(ks[4], (DEPTH, GM_WIDTH), 0.02),
        'ln_v_b': nrm(ks[5], (DEPTH, GM_WIDTH), 0.02),
        'w_spatial': nrm(ks[6], (DEPTH, GM_GROUPS, GM_CHUNK, GM_CHUNK), GM_CHUNK ** -0.5),
        'b_spatial': 1.0 + nrm(ks[7], (DEPTH, GM_GROUPS, GM_CHUNK), 0.02),
        'lb_logits': nrm(ks[8], (DEPTH + 1, HG_WIDTH), 0.5),
        'hgrn_norm_g': 1.0 + nrm(ks[9], (DEPTH, HG_VDIM), 0.02),
        'mem_norm_g': 1.0 + nrm(ks[10], (DEPTH, D_MODEL), 0.02),
        'w_mem_kv': nrm(ks[11], (DEPTH, D_MODEL, 2 * XA_WIDTH), D_MODEL ** -0.5),
        'w_branch': nrm(ks[12], (DEPTH, N_BRANCH, BRANCH_WIDTH, D_MODEL), BRANCH_WIDTH ** -0.5),
        'w_out': nrm(ks[13], (DEPTH, D_MODEL, D_MODEL), D_MODEL ** -0.5),
        'norm2_g': 1.0 + nrm(ks[14], (DEPTH, D_MODEL), 0.02),
        'w_up': nrm(ks[15], (DEPTH, D_MODEL, 2 * D_FF), D_MODEL ** -0.5),
        'conv_w': nrm(ks[16], (DEPTH, CONV_WIDTH, D_FF), CONV_WIDTH ** -0.5),
        'conv_b': nrm(ks[17], (DEPTH, D_FF), 0.02),
        'w_down': nrm(ks[18], (DEPTH, D_FF, D_MODEL), D_FF ** -0.5),
        'final_g': 1.0 + nrm(ks[19], (D_MODEL,), 0.02),
    }


def reference(x, mem, norm1_g, w_in, ln_v_g, ln_v_b, w_spatial, b_spatial, lb_logits,
              hgrn_norm_g, mem_norm_g, w_mem_kv, w_branch, w_out, norm2_g, w_up,
              conv_w, conv_b, w_down, final_g):
    B, S, D = x.shape
    split_points = np.cumsum(IN_SPLITS)[:-1].tolist()
    lb_all = jnp.cumsum(jax.nn.softmax(lb_logits.astype(jnp.float32), axis=0), axis=0)
    for l in range(DEPTH):
        h = rms_norm(x, norm1_g[l])
        proj = h @ w_in[l]
        zu, zv, hq, hf, hi, hg, xq, gate_logits = jnp.split(proj, split_points, axis=-1)
        a_out = spatial_gating(jax.nn.gelu(zu), jax.nn.gelu(zv), ln_v_g[l], ln_v_b[l],
                               w_spatial[l], b_spatial[l])
        b_out = hgrn2(hq, hf, hi, hg, lb_all[l], hgrn_norm_g[l])
        c_out = memory_attention(xq, mem, mem_norm_g[l], w_mem_kv[l])
        branches = jnp.stack([a_out, b_out, c_out], axis=0)
        up = jnp.einsum('nbsc,ncd->nbsd', branches, w_branch[l])
        gates = jax.nn.sigmoid(gate_logits.reshape(B, S, N_BRANCH, D))
        merged = jnp.einsum('bsnd,nbsd->bsd', gates, up)
        x = x + merged @ w_out[l]
        x = x + conv_ffn(rms_norm(x, norm2_g[l]), w_up[l], conv_w[l], conv_b[l], w_down[l])
    return rms_norm(x, final_g)
```

```cpp
#include <hip/hip_runtime.h>
#include <hip/hip_cooperative_groups.h>
#include <cstdio>
#include <cstdint>
namespace cg = cooperative_groups;

#define DBG_SANITIZE 0
#define DBG_ATTN_COPY 0
#define DBG_ZERO_MASK 0
#define DBG_NO_FFN 0
#ifndef MK_PER_PHASE
#define MK_PER_PHASE 0
#endif

#define LAS __attribute__((address_space(3)))
typedef unsigned short bf16_t;
typedef short bf16x8 __attribute__((ext_vector_type(8)));
typedef short s16x4 __attribute__((ext_vector_type(4)));
typedef _Float16 f16x8 __attribute__((ext_vector_type(8)));
typedef float f32x4 __attribute__((ext_vector_type(4)));
typedef float f32x2 __attribute__((ext_vector_type(2)));
typedef unsigned u32x4 __attribute__((ext_vector_type(4)));
typedef unsigned u32x2 __attribute__((ext_vector_type(2)));

constexpr int M = 32768, D = 1024, SEQ = 2048, INW = 6656, MEMROWS = 4096, MEML = 256, DFF = 2816, NUP = 5632;
constexpr float EPS = 1e-6f;
constexpr size_t MiB = 1u << 20;
constexpr size_t WS_WIN = 0, WS_WKV = 13 * MiB, WS_WBR = 15 * MiB, WS_WO = 18 * MiB, WS_WUP = 20 * MiB, WS_WD = 31 * MiB;
constexpr size_t WS_RS1 = 37 * MiB, WS_RSM = WS_RS1 + 128 * 1024, WS_SSQ2 = WS_RS1 + 256 * 1024, WS_SSQ3 = WS_RS1 + 384 * 1024, WS_HD = 38 * MiB;
constexpr size_t WS_XB = 48 * MiB;
constexpr size_t WS_MEMB = 112 * MiB, WS_KV = 120 * MiB;
constexpr size_t WS_HI = 128 * MiB, WS_HG = 160 * MiB, WS_XQ = 192 * MiB;
constexpr size_t WS_GATES = 224 * MiB;
constexpr size_t WS_AOUT = 416 * MiB, WS_BOUT = 448 * MiB, WS_COUT = 480 * MiB;
constexpr size_t WS_END = 512 * MiB;
constexpr int LDS_BYTES = 159744;

typedef __bf16 bf16x2_t __attribute__((ext_vector_type(2)));
__device__ __forceinline__ unsigned pk2(float lo, float hi) { f32x2 v = {lo, hi}; bf16x2_t b = __builtin_convertvector(v, bf16x2_t); return __builtin_bit_cast(unsigned, b); }
__device__ __forceinline__ float bflo(unsigned w) { return __uint_as_float(w << 16); }
__device__ __forceinline__ float bfhi(unsigned w) { return __uint_as_float(w & 0xffff0000u); }
__device__ __forceinline__ float fexp(float x) { return __builtin_amdgcn_exp2f(x * 1.4426950408889634f); }
__device__ __forceinline__ float fsigmoid(float x) { return __builtin_amdgcn_rcpf(1.0f + fexp(-x)); }
__device__ __forceinline__ float fsilu(float x) { return x * fsigmoid(x); }
__device__ __forceinline__ float fgelu(float x) { return x * fsigmoid(1.5957691216057308f * (x + 0.044715f * x * x * x)); }
__device__ __forceinline__ unsigned pkh2(float lo, float hi) { _Float16 a = (_Float16)lo, b = (_Float16)hi; return (unsigned)__builtin_bit_cast(unsigned short, a) | ((unsigned)__builtin_bit_cast(unsigned short, b) << 16); }
__device__ __forceinline__ float wave_sum(float v) {
#pragma unroll
    for (int o = 1; o < 64; o <<= 1) v += __shfl_xor(v, o);
    return v;
}
typedef short v4i16_t __attribute__((ext_vector_type(4)));
__device__ __forceinline__ s16x4 tr4(const LAS bf16_t* p) { return __builtin_bit_cast(s16x4, __builtin_amdgcn_ds_read_tr16_b64_v4i16((LAS v4i16_t*)p)); }
__device__ __forceinline__ bf16x8 tr8(const LAS bf16_t* tile, int P, int k0, int c0, int lane) {
    const int g = lane >> 4, q = (lane & 15) >> 2, p = lane & 3;
    const LAS bf16_t* a = tile + (k0 + 4 * g + q) * P + c0 + 4 * p;
    const s16x4 lo = tr4(a), hi = tr4(a + 16 * P);
    return (bf16x8){lo[0], lo[1], lo[2], lo[3], hi[0], hi[1], hi[2], hi[3]};
}
#define MFMA_BF16(a, b, c) __builtin_amdgcn_mfma_f32_16x16x32_bf16((a), (b), (c), 0, 0, 0)

namespace pg8 {
constexpr int BM = 256, BK = 64, HALF = 128, HTB = HALF * BK * 2, STAGE_BYTES = 8 * HTB, NXCD = 8, WGM = 8;
__host__ __device__ __forceinline__ int lds_byte(int r, int c) { const int st = (r >> 4) * 2 + (c >> 5), rr = r & 15, cc = c & 31, ob = rr * 64 + cc * 2; return st * 1024 + (ob ^ (((ob >> 9) & 1) << 5)); }
__host__ __device__ __forceinline__ void stage_rc(int b, int& R, int& C) { const int st = b / 1024, sb = b % 1024, swz = sb ^ (((sb >> 9) & 1) << 5); R = (st >> 1) * 16 + swz / 64; C = (st & 1) * 32 + (swz % 64) / 2; }
__host__ __device__ __forceinline__ int perm32(int rho) { const int n = rho >> 4, i = rho & 15; return 8 * (i >> 2) + 4 * n + (i & 3); }
struct Unit { int pm, pn, z; };
__device__ __forceinline__ void tile_map(int wgid, int nM, int nN, Unit& u) {
    const int nwg = nM * nN;
    { const int q = nwg / NXCD, r = nwg % NXCD, xcd = wgid % NXCD, off = wgid / NXCD; wgid = (xcd < r ? xcd * (q + 1) : r * (q + 1) + (xcd - r) * q) + off; }
    const int nig = WGM * nN, gid = wgid / nig, fm = gid * WGM, gsz = (nM - fm) < WGM ? (nM - fm) : WGM;
    u.pm = fm + ((wgid % nig) % gsz); u.pn = (wgid % nig) / gsz;
}
template <class Prob, class Epi, class Sched>
__device__ __forceinline__ void gemm_phase(LAS unsigned char* lds, const Prob& Pb, const Sched& S, const Epi& E) {
    const int tid = threadIdx.x, wid = __builtin_amdgcn_readfirstlane(tid >> 6), lane = tid & 63, wr = wid >> 2, wc = wid & 3, fr = lane & 15, fq = lane >> 4;
    const int K = Pb.K, nt = K / BK;
    unsigned voffA[2], voffB[2];
#pragma unroll
    for (int i = 0; i < 2; ++i) { int R, C; stage_rc(tid * 16 + i * 8192, R, C); const int Rb = Epi::PERM ? ((R & ~31) + perm32(R & 31)) : R;
        voffA[i] = (unsigned)(R * Pb.lda + C) * 2u; voffB[i] = (unsigned)(Rb * Pb.ldb + C) * 2u; }
    const size_t kstep = (size_t)(BK * 2);
    const size_t hsA = (size_t)HALF * Pb.lda * 2, hsB = (size_t)HALF * Pb.ldb * 2;
    const unsigned ldsw = (unsigned)wid * 1024u;
    const int aoff = lds_byte(wr * 64 + fr, fq * 8), boff = lds_byte(wc * 32 + fr, fq * 8);
#define PG8_SA(b, h) (((b) * 2 + (h)) * HTB)
#define PG8_SB(b, h) ((4 + (b) * 2 + (h)) * HTB)
#define PG8_STAGE(bufoff, gbase, voff) do { _Pragma("unroll") for (int _i = 0; _i < 2; ++_i) \
        __builtin_amdgcn_global_load_lds((const unsigned*)((const char*)(gbase) + (voff)[_i]), (LAS unsigned*)(lds + (bufoff) + ldsw + _i * 8192), 16, 0, 0); } while (0)
#define PG8_LDA(dst, b, h) do { _Pragma("unroll") for (int m = 0; m < 4; ++m) _Pragma("unroll") for (int k = 0; k < 2; ++k) dst[m][k] = *(const LAS bf16x8*)(lds + PG8_SA(b, h) + aoff + m * 2048 + k * 1024); } while (0)
#define PG8_LDB(dst, b, h) do { _Pragma("unroll") for (int n = 0; n < 2; ++n) _Pragma("unroll") for (int k = 0; k < 2; ++k) dst[n][k] = *(const LAS bf16x8*)(lds + PG8_SB(b, h) + boff + n * 2048 + k * 1024); } while (0)
#define PG8_MMA(ai, bj, At, Bt) do { __builtin_amdgcn_s_setprio(1); _Pragma("unroll") for (int m = 0; m < 4; ++m) _Pragma("unroll") for (int n = 0; n < 2; ++n) _Pragma("unroll") for (int k = 0; k < 2; ++k) \
        acc[ai][bj][m][n] = __builtin_amdgcn_mfma_f32_16x16x32_bf16(Bt[n][k], At[m][k], acc[ai][bj][m][n], 0, 0, 0); __builtin_amdgcn_s_setprio(0); } while (0)
#define PG8_WAIT_V(n) asm volatile("s_waitcnt vmcnt(" #n ")" ::: "memory")
#define PG8_WAIT_L(n) asm volatile("s_waitcnt lgkmcnt(" #n ")" ::: "memory")
#define PG8_BAR __builtin_amdgcn_s_barrier()
#define PG8_SCHED __builtin_amdgcn_sched_barrier(0)
    Unit cur, nxt; int ui = 0;
    if (!S.next(0, cur)) return;
    f32x4 acc[2][2][4][2];
#pragma unroll
    for (int a = 0; a < 2; ++a)
#pragma unroll
        for (int b = 0; b < 2; ++b)
#pragma unroll
            for (int m = 0; m < 4; ++m)
#pragma unroll
                for (int n = 0; n < 2; ++n) acc[a][b][m][n] = (f32x4){0.f, 0.f, 0.f, 0.f};
    bf16x8 At[4][2], B0[2][2], B1[2][2];
    const char* cA = Pb.a(cur); const char* cB = Pb.b(cur);
    PG8_STAGE(PG8_SB(0, 0), cB, voffB); PG8_STAGE(PG8_SB(0, 1), cB + hsB, voffB); PG8_STAGE(PG8_SA(0, 0), cA, voffA); PG8_STAGE(PG8_SA(0, 1), cA + hsA, voffA);
    if (wr == 1) PG8_BAR;
    PG8_WAIT_V(2); PG8_BAR;
    PG8_STAGE(PG8_SB(1, 0), cB + kstep, voffB); PG8_STAGE(PG8_SA(1, 0), cA + kstep, voffA); PG8_STAGE(PG8_SB(1, 1), cB + hsB + kstep, voffB);
    PG8_WAIT_V(6); PG8_BAR;
    for (;;) {
        const bool has_next = S.next(ui + 1, nxt);
        const char* nA = has_next ? Pb.a(nxt) : cA; const char* nB = has_next ? Pb.b(nxt) : cB;
        for (int t = 0; t < nt; t += 2) {
            const bool last = (t == nt - 2);
            const char* a1 = cA + (size_t)(t + 1) * kstep;
            const char* a2 = last ? nA : cA + (size_t)(t + 2) * kstep; const char* b2 = last ? nB : cB + (size_t)(t + 2) * kstep;
            const char* a3 = a2 + kstep; const char* b3 = b2 + kstep;
            PG8_LDB(B0, 0, 0); PG8_LDB(B1, 0, 1); PG8_SCHED; PG8_LDA(At, 0, 0); PG8_STAGE(PG8_SA(1, 1), a1 + hsA, voffA);
            PG8_WAIT_V(8); PG8_WAIT_L(0); PG8_BAR; PG8_MMA(0, 0, At, B0); PG8_MMA(0, 1, At, B1); PG8_BAR; PG8_SCHED;
            PG8_LDA(At, 0, 1); PG8_STAGE(PG8_SB(0, 0), b2, voffB); PG8_STAGE(PG8_SB(0, 1), b2 + hsB, voffB); PG8_STAGE(PG8_SA(0, 0), a2, voffA);
            PG8_WAIT_V(8); PG8_WAIT_L(0); PG8_BAR; PG8_MMA(1, 0, At, B0); PG8_MMA(1, 1, At, B1); PG8_BAR; PG8_SCHED;
            PG8_LDB(B0, 1, 0); PG8_LDB(B1, 1, 1); PG8_SCHED; PG8_LDA(At, 1, 0); PG8_STAGE(PG8_SA(0, 1), a2 + hsA, voffA);
            PG8_WAIT_V(8); PG8_WAIT_L(0); PG8_BAR; PG8_MMA(0, 0, At, B0); PG8_MMA(0, 1, At, B1); PG8_BAR; PG8_SCHED;
            PG8_LDA(At, 1, 1); PG8_STAGE(PG8_SB(1, 0), b3, voffB); PG8_STAGE(PG8_SB(1, 1), b3 + hsB, voffB); PG8_STAGE(PG8_SA(1, 0), a3, voffA);
            PG8_WAIT_V(8); PG8_WAIT_L(0); PG8_BAR; PG8_MMA(1, 0, At, B0); PG8_MMA(1, 1, At, B1); PG8_BAR; PG8_SCHED;
        }
        if (wr == 0) PG8_BAR;
        const bool keep = E(acc, cur, wr, wc, fr, fq);
        if (!has_next) break;
        if (!keep) {
#pragma unroll
        for (int a = 0; a < 2; ++a)
#pragma unroll
            for (int b = 0; b < 2; ++b)
#pragma unroll
                for (int m = 0; m < 4; ++m)
#pragma unroll
                    for (int n = 0; n < 2; ++n) acc[a][b][m][n] = (f32x4){0.f, 0.f, 0.f, 0.f};
        }
        cur = nxt; cA = nA; cB = nB; ++ui;
        if (wr == 1) PG8_BAR;
    }
    PG8_WAIT_V(0);
    PG8_BAR;
#undef PG8_SA
#undef PG8_SB
#undef PG8_STAGE
#undef PG8_LDA
#undef PG8_LDB
#undef PG8_MMA
#undef PG8_WAIT_V
#undef PG8_WAIT_L
#undef PG8_BAR
#undef PG8_SCHED
}
}
using pg8::Unit;

struct Args { const float* in[20]; float* out; unsigned char* ws; int ph_lo, ph_hi; };
enum { I_X = 0, I_MEM, I_N1G, I_WIN, I_LNG, I_LNB, I_WSP, I_BSP, I_LB, I_HNG, I_MNG, I_WKV, I_WBR, I_WOUT, I_N2G, I_WUP, I_CW, I_CB, I_WDN, I_FG };

template <int MAP> __device__ __forceinline__ void transpose_item(const float* W, int K, int N, bf16_t* WT, const float* sk, LAS float* scr, int item, int lane) {
    const int nblk = N / 32, kb = item / nblk, nb = item % nblk, k0 = 64 * kb, n0 = 32 * nb;
#pragma unroll 8
    for (int i = 0; i < 32; ++i) { const int kk = 2 * i + (lane >> 5); float v = W[(size_t)(k0 + kk) * N + n0 + (lane & 31)]; if (sk) v *= sk[k0 + kk]; scr[kk * 33 + (lane & 31)] = v; }
    asm volatile("s_waitcnt lgkmcnt(0)" ::: "memory");
    const int c = lane & 7;
    int r0 = n0;
    if (MAP == 1) { const int half = n0 >= DFF, ch = n0 - half * DFF; r0 = 256 * (ch >> 7) + 128 * half + (ch & 127); }
#pragma unroll
    for (int j = 0; j < 4; ++j) { const int n = (lane >> 3) + 8 * j; const LAS float* s = scr + (8 * c) * 33 + n;
        u32x4 o; o.x = pk2(s[0 * 33], s[1 * 33]); o.y = pk2(s[2 * 33], s[3 * 33]); o.z = pk2(s[4 * 33], s[5 * 33]); o.w = pk2(s[6 * 33], s[7 * 33]);
        *(u32x4*)(WT + (size_t)(r0 + n) * K + k0 + 8 * c) = o; }
    asm volatile("s_waitcnt lgkmcnt(0)" ::: "memory");
}
__device__ __forceinline__ void row_to_bf16(const float* xrow, bf16_t* orow, float* rs, int lane) {
    const f32x4* xr = (const f32x4*)xrow + lane;
    f32x4 v[4]; float s = 0.f;
#pragma unroll
    for (int j = 0; j < 4; ++j) { v[j] = xr[64 * j]; s += (v[j].x * v[j].x + v[j].y * v[j].y) + (v[j].z * v[j].z + v[j].w * v[j].w); }
    s = wave_sum(s);
    if (lane == 0) *rs = 1.0f / sqrtf(s * (1.0f / D) + EPS);
    u32x2* o8 = (u32x2*)orow + lane;
#pragma unroll
    for (int j = 0; j < 4; ++j) o8[64 * j] = (u32x2){pk2(v[j].x, v[j].y), pk2(v[j].z, v[j].w)};
}
__device__ __forceinline__ void p0_prologue(const Args& A, LAS unsigned char* lds) {
    const int tid = threadIdx.x, lane = tid & 63, wave = tid >> 6;
    LAS float* scr = (LAS float*)(lds + wave * 16384);
    const int gw = blockIdx.x * 8 + wave, NGW = gridDim.x * 8;
    unsigned char* ws = A.ws;
    constexpr int I0 = 16 * (INW / 32), I1 = 16 * 32, I2 = 8 * 32, I3 = 16 * 32, I4 = 16 * (NUP / 32), I5 = (DFF / 64) * 32;
    constexpr int NITEMS = I0 + I1 + 3 * I2 + I3 + I4 + I5;
    for (int it = gw; it < NITEMS; it += NGW) {
        int r = it;
        if (r < I0) { transpose_item<0>(A.in[I_WIN], D, INW, (bf16_t*)(ws + WS_WIN), A.in[I_N1G], scr, r, lane); continue; } r -= I0;
        if (r < I1) { transpose_item<0>(A.in[I_WKV], D, 1024, (bf16_t*)(ws + WS_WKV), A.in[I_MNG], scr, r, lane); continue; } r -= I1;
        if (r < 3 * I2) { const int z = r / I2; transpose_item<0>(A.in[I_WBR] + (size_t)z * 512 * 1024, 512, 1024, (bf16_t*)(ws + WS_WBR) + (size_t)z * 1024 * 512, nullptr, scr, r % I2, lane); continue; } r -= 3 * I2;
        if (r < I3) { transpose_item<0>(A.in[I_WOUT], D, D, (bf16_t*)(ws + WS_WO), nullptr, scr, r, lane); continue; } r -= I3;
        if (r < I4) { transpose_item<1>(A.in[I_WUP], D, NUP, (bf16_t*)(ws + WS_WUP), A.in[I_N2G], scr, r, lane); continue; } r -= I4;
        transpose_item<0>(A.in[I_WDN], DFF, D, (bf16_t*)(ws + WS_WD), nullptr, scr, r, lane);
    }
    for (int m = gw; m < M; m += NGW) row_to_bf16(A.in[I_X] + (size_t)m * D, (bf16_t*)(ws + WS_XB) + (size_t)m * D, (float*)(ws + WS_RS1) + m, lane);
    for (int m = gw; m < MEMROWS; m += NGW) row_to_bf16(A.in[I_MEM] + (size_t)m * D, (bf16_t*)(ws + WS_MEMB) + (size_t)m * D, (float*)(ws + WS_RSM) + m, lane);
    for (int i = blockIdx.x * 512 + tid; i < 2 * M; i += gridDim.x * 512) ((float*)(ws + WS_SSQ2))[i] = 0.f;
}

struct ProbP1 { int K, lda, ldb; const bf16_t *xb, *memb, *win, *wkv;
    __device__ __forceinline__ const char* a(const Unit& u) const { return (const char*)((u.z ? memb : xb) + (size_t)u.pm * 256 * 1024); }
    __device__ __forceinline__ const char* b(const Unit& u) const { return (const char*)((u.z ? wkv : win) + (size_t)u.pn * 256 * 1024); } };
struct SchedP1 { int G, c;
    __device__ __forceinline__ bool next(int i, Unit& u) const { int L = i * G + c; if (L < 3328) { pg8::tile_map(L, 128, 26, u); u.z = 0; return true; } L -= 3328; if (L >= 64) return false; u.pm = L & 15; u.pn = L >> 4; u.z = 1; return true; } };
template <int MODE> __device__ __forceinline__ void p1_store(const f32x4 (&acc)[2][2][4][2], const float* rs, int row0, bf16_t* dst, int ldc, int col0, float sc, const float* lbl, int lcol0) {
    float lb[2][8];
    if (MODE == 4) {
#pragma unroll
        for (int bj = 0; bj < 2; ++bj)
#pragma unroll
            for (int j = 0; j < 8; ++j) { const int c = lcol0 + bj * 128 + j; lb[bj][j] = fsigmoid(lbl[c] - lbl[512 + c]); }
    }
#pragma unroll
    for (int ai = 0; ai < 2; ++ai)
#pragma unroll
        for (int m = 0; m < 4; ++m) { const int row = row0 + ai * 128 + m * 16; const float r = rs[row]; bf16_t* rowp = dst + (size_t)row * ldc + col0;
#pragma unroll
            for (int bj = 0; bj < 2; ++bj) { float v[8];
#pragma unroll
                for (int j = 0; j < 8; ++j) { float x = acc[ai][bj][m][j >> 2][j & 3] * r;
                    if (MODE == 0) x *= sc; if (MODE == 1) x = fgelu(x); if (MODE == 2) x = fsilu(x); if (MODE == 3) x = fsigmoid(x);
                    if (MODE == 4) { const float fg = lb[bj][j] + (1.0f - lb[bj][j]) * fsigmoid(x); x = __logf(fg); }
                    v[j] = x; }
                u32x4 w;
                if (MODE == 4) { w.x = pkh2(v[0], v[1]); w.y = pkh2(v[2], v[3]); w.z = pkh2(v[4], v[5]); w.w = pkh2(v[6], v[7]); }
                else { w.x = pk2(v[0], v[1]); w.y = pk2(v[2], v[3]); w.z = pk2(v[4], v[5]); w.w = pk2(v[6], v[7]); }
                *(u32x4*)(rowp + bj * 128) = w; } }
}
struct EpiP1 { static constexpr bool PERM = true;
    const float *rs1, *rsm, *lbl; bf16_t *U, *V, *HQ, *HF, *HI, *HG, *XQ, *GATES, *KV;
    __device__ __forceinline__ bool operator()(f32x4 (&acc)[2][2][4][2], const Unit& u, int wr, int wc, int fr, int fq) const {
        const int row0 = u.pm * 256 + wr * 64 + fr, cw = wc * 32 + 8 * fq;
        if (u.z) { p1_store<0>(acc, rsm, row0, KV, 1024, u.pn * 256 + cw, 1.0f, nullptr, 0); return false; }
        const int seg = u.pn >> 1, col0 = (u.pn & 1) * 256 + cw;
        if (u.pn >= 14) { p1_store<3>(acc, rs1, row0, GATES, 3072, (u.pn - 14) * 256 + cw, 1.f, nullptr, 0); return false; }
        switch (seg) {
            case 0: p1_store<1>(acc, rs1, row0, U, 512, col0, 1.f, nullptr, 0); break;
            case 1: p1_store<1>(acc, rs1, row0, V, 512, col0, 1.f, nullptr, 0); break;
            case 2: p1_store<2>(acc, rs1, row0, HQ, 512, col0, 1.f, nullptr, 0); break;
            case 3: p1_store<4>(acc, rs1, row0, HF, 512, col0, 1.f, lbl, col0); break;
            case 4: p1_store<0>(acc, rs1, row0, HI, 512, col0, 1.f, nullptr, 0); break;
            case 5: p1_store<2>(acc, rs1, row0, HG, 512, col0, 1.f, nullptr, 0); break;
            default: p1_store<0>(acc, rs1, row0, XQ, 512, col0, 0.08838834764831845f * 1.4426950408889634f, nullptr, 0); break;
        }
        return false;
    }
};

__device__ __forceinline__ void attn_item(int item, const bf16_t* XQ, const bf16_t* KV, bf16_t* COUT, LAS unsigned char* lds) {
    const int tid = threadIdx.x, lane = tid & 63, wave = tid >> 6, g = lane >> 4, l15 = lane & 15;
    const int qt = item & 15, h = (item >> 4) & 3, b = item >> 6;
    LAS bf16_t* Ks = (LAS bf16_t*)lds; LAS bf16_t* Vs = Ks + 256 * 144;
#pragma unroll
    for (int i = 0; i < 8; ++i) { const int idx = tid + 512 * i, row = idx >> 4, ch = idx & 15;
        const bf16_t* src = KV + (size_t)(b * 256 + row) * 1024 + h * 128 + ch * 8;
        *(LAS u32x4*)(Ks + row * 144 + ch * 8) = *(const u32x4*)src; *(LAS u32x4*)(Vs + row * 144 + ch * 8) = *(const u32x4*)(src + 512); }
    const int t = b * SEQ + qt * 128 + wave * 16 + l15;
#if DBG_ATTN_COPY
    { __syncthreads(); const int rr = tid >> 2, cc = (tid & 3) * 32; const size_t o = (size_t)(b * SEQ + qt * 128 + rr) * 512 + h * 128 + cc;
      for (int e = 0; e < 4; ++e) *(u32x4*)(COUT + o + 8 * e) = *(const u32x4*)(KV + (size_t)((b * 256 + ((qt * 128 + rr) & 255))) * 1024 + (qt & 1) * 512 + h * 128 + cc + 8 * e);
      __syncthreads(); return; }
#endif
    bf16x8 Qf[4];
#pragma unroll
    for (int ks = 0; ks < 4; ++ks) Qf[ks] = *(const bf16x8*)(XQ + (size_t)t * 512 + h * 128 + 32 * ks + 8 * g);
    __syncthreads();
    f32x4 s[16];
#pragma unroll
    for (int i = 0; i < 16; ++i) { s[i] = (f32x4){0.f, 0.f, 0.f, 0.f};
#pragma unroll
        for (int ks = 0; ks < 4; ++ks) { const bf16x8 a = *(const LAS bf16x8*)(Ks + (16 * i + l15) * 144 + 32 * ks + 8 * g); s[i] = MFMA_BF16(a, Qf[ks], s[i]); } }
    float mx = -3.0e38f;
#pragma unroll
    for (int i = 0; i < 16; ++i) mx = fmaxf(fmaxf(fmaxf(s[i][0], s[i][1]), fmaxf(s[i][2], s[i][3])), mx);
    mx = fmaxf(mx, __shfl_xor(mx, 16)); mx = fmaxf(mx, __shfl_xor(mx, 32));
    float sum = 0.f;
#pragma unroll
    for (int i = 0; i < 16; ++i)
#pragma unroll
        for (int r = 0; r < 4; ++r) { const float p = __builtin_amdgcn_exp2f(s[i][r] - mx); s[i][r] = p; sum += p; }
    sum += __shfl_xor(sum, 16); sum += __shfl_xor(sum, 32);
    const float inv = 1.0f / sum;
    bf16x8 Pf[8];
#pragma unroll
    for (int kk = 0; kk < 8; ++kk) { u32x4 w; w.x = pk2(s[2 * kk][0] * inv, s[2 * kk][1] * inv); w.y = pk2(s[2 * kk][2] * inv, s[2 * kk][3] * inv);
        w.z = pk2(s[2 * kk + 1][0] * inv, s[2 * kk + 1][1] * inv); w.w = pk2(s[2 * kk + 1][2] * inv, s[2 * kk + 1][3] * inv); Pf[kk] = __builtin_bit_cast(bf16x8, w); }
    bf16_t* orow = COUT + (size_t)t * 512 + h * 128 + 4 * g;
#pragma unroll
    for (int dt = 0; dt < 8; ++dt) { f32x4 o = (f32x4){0.f, 0.f, 0.f, 0.f};
#pragma unroll
        for (int kk = 0; kk < 8; ++kk) { const bf16x8 a = tr8(Vs, 144, 32 * kk, 16 * dt, lane); o = MFMA_BF16(a, Pf[kk], o); }
        *(u32x2*)(orow + 16 * dt) = (u32x2){pk2(o[0], o[1]), pk2(o[2], o[3])}; }
    __syncthreads();
}
__device__ __forceinline__ void sgu_item(int item, const bf16_t* U, const bf16_t* V, const float* lng, const float* lnb, const float* wsp, const float* bsp, bf16_t* AOUT, LAS unsigned char* lds) {
    const int tid = threadIdx.x, lane = tid & 63, wave = tid >> 6, g = lane >> 4, l15 = lane & 15;
    const int t0 = item * 128;
    LAS bf16_t* vn = (LAS bf16_t*)lds;
    { float gg[8], bb[8];
#pragma unroll
      for (int j = 0; j < 8; ++j) { gg[j] = lng[8 * lane + j]; bb[j] = lnb[8 * lane + j]; }
#pragma unroll 4
      for (int i = 0; i < 16; ++i) { const int srow = wave * 16 + i; const u32x4 w = *(const u32x4*)(V + (size_t)(t0 + srow) * 512 + 8 * lane);
        float v[8] = {bflo(w.x), bfhi(w.x), bflo(w.y), bfhi(w.y), bflo(w.z), bfhi(w.z), bflo(w.w), bfhi(w.w)};
        float s = 0.f;
#pragma unroll
        for (int j = 0; j < 8; ++j) s += v[j];
        const float mu = wave_sum(s) * (1.0f / 512.0f); float q = 0.f;
#pragma unroll
        for (int j = 0; j < 8; ++j) { v[j] -= mu; q += v[j] * v[j]; }
        const float rstd = 1.0f / sqrtf(wave_sum(q) * (1.0f / 512.0f) + EPS);
#pragma unroll
        for (int j = 0; j < 8; ++j) v[j] = v[j] * rstd * gg[j] + bb[j];
        *(LAS u32x4*)(vn + srow * 528 + 8 * lane) = (u32x4){pk2(v[0], v[1]), pk2(v[2], v[3]), pk2(v[4], v[5]), pk2(v[6], v[7])}; } }
    __syncthreads();
    const int tl = wave * 16 + l15, nks = (wave >> 1) + 1;
#pragma unroll 1
    for (int g4 = 0; g4 < 4; ++g4) {
        bf16x8 Wf[4];
#pragma unroll
        for (int ks = 0; ks < 4; ++ks) { Wf[ks] = (bf16x8){0, 0, 0, 0, 0, 0, 0, 0};
            if (ks < nks) { const float* wp = wsp + (size_t)(g4 * 128 + tl) * 128 + 32 * ks + 4 * g; const f32x4 w0 = *(const f32x4*)wp, w1 = *(const f32x4*)(wp + 16);
                const int s0 = 32 * ks + 4 * g, s1 = s0 + 16; float e[8];
#pragma unroll
                for (int j = 0; j < 4; ++j) { e[j] = (s0 + j <= tl) ? w0[j] : 0.f; e[4 + j] = (s1 + j <= tl) ? w1[j] : 0.f; }
                const u32x4 w = (u32x4){pk2(e[0], e[1]), pk2(e[2], e[3]), pk2(e[4], e[5]), pk2(e[6], e[7])}; Wf[ks] = __builtin_bit_cast(bf16x8, w); } }
        const float bias = bsp[g4 * 128 + tl];
#pragma unroll
        for (int ct = 0; ct < 8; ++ct) { const int c0 = g4 * 128 + 16 * ct; f32x4 acc = (f32x4){0.f, 0.f, 0.f, 0.f};
#pragma unroll
            for (int ks = 0; ks < 4; ++ks) if (ks < nks) { const bf16x8 a = tr8(vn, 528, 32 * ks, c0, lane); acc = MFMA_BF16(a, Wf[ks], acc); }
            const size_t o = (size_t)(t0 + tl) * 512 + c0 + 4 * g; const u32x2 uw = *(const u32x2*)(U + o);
            *(u32x2*)(AOUT + o) = (u32x2){pk2(bflo(uw.x) * (acc[0] + bias), bfhi(uw.x) * (acc[1] + bias)), pk2(bflo(uw.y) * (acc[2] + bias), bfhi(uw.y) * (acc[3] + bias))}; }
    }
    __syncthreads();
}
constexpr int H_LF = 0, H_A = 18432, H_T0 = 52224, H_T1 = 70656, H_T2 = 89088, H_VS = 107520, H_RED = 125952;
__device__ __forceinline__ void hgrn_load_cumsum(int t0, int cb, const bf16_t* HF, const bf16_t* HI, LAS unsigned char* lds) {
    const int tid = threadIdx.x, lane = tid & 63, wave = tid >> 6, g = lane >> 4, l15 = lane & 15;
    LAS bf16_t* LF = (LAS bf16_t*)(lds + H_LF); LAS bf16_t* VS = (LAS bf16_t*)(lds + H_VS); LAS float* A_ = (LAS float*)(lds + H_A);
#pragma unroll
    for (int i = 0; i < 2; ++i) { const int idx = tid + 512 * i, row = idx >> 4, ch = idx & 15; const size_t o = (size_t)(t0 + row) * 512 + cb + ch * 8;
        *(LAS u32x4*)(LF + row * 144 + ch * 8) = *(const u32x4*)(HF + o); *(LAS u32x4*)(VS + row * 144 + ch * 8) = *(const u32x4*)(HI + o); }
    __syncthreads();
    f16x8 Bf[2];
#pragma unroll
    for (int ks = 0; ks < 2; ++ks) Bf[ks] = __builtin_bit_cast(f16x8, tr8(LF, 144, 32 * ks, 16 * wave, lane));
#pragma unroll
    for (int tt = 0; tt < 4; ++tt) { f32x4 acc = (f32x4){0.f, 0.f, 0.f, 0.f}; const int t = 16 * tt + l15;
#pragma unroll
        for (int ks = 0; ks < 2; ++ks) { f16x8 a;
#pragma unroll
            for (int j = 0; j < 8; ++j) { const int s = 32 * ks + 4 * g + (j & 3) + 16 * (j >> 2); a[j] = (s <= t) ? (_Float16)1.0f : (_Float16)0.0f; }
            acc = __builtin_amdgcn_mfma_f32_16x16x32_f16(a, Bf[ks], acc, 0, 0, 0); }
#pragma unroll
        for (int r = 0; r < 4; ++r) A_[(16 * tt + 4 * g + r) * 132 + 16 * wave + l15] = acc[r]; }
    __syncthreads();
}
__device__ __forceinline__ float h2f(unsigned short h) { return (float)__builtin_bit_cast(_Float16, h); }
__device__ __forceinline__ void hgrn1_item(int item, const bf16_t* HF, const bf16_t* HI, bf16_t* GS, float* HD, LAS unsigned char* lds) {
    const int tid = threadIdx.x, lane = tid & 63, wave = tid >> 6, g = lane >> 4, l15 = lane & 15;
    const int n = item & 31, bh = item >> 5, h = bh & 3, b = bh >> 2, t0 = b * SEQ + n * 64, cb = h * 128;
    hgrn_load_cumsum(t0, cb, HF, HI, lds);
    LAS bf16_t* LF = (LAS bf16_t*)(lds + H_LF); LAS bf16_t* VS = (LAS bf16_t*)(lds + H_VS); LAS float* A_ = (LAS float*)(lds + H_A); LAS bf16_t* KD = (LAS bf16_t*)(lds + H_T0);
    { const int t = tid >> 3, kc = (tid & 7) * 16; unsigned w[8];
#pragma unroll
      for (int e = 0; e < 16; e += 2) { float o[2];
#pragma unroll
        for (int d = 0; d < 2; ++d) { const int kk = kc + e + d; const float a = A_[t * 132 + kk], al = A_[63 * 132 + kk], lf = h2f(LF[t * 144 + kk]); o[d] = (1.0f - fexp(lf)) * fexp(al - a); }
        w[e >> 1] = pk2(o[0], o[1]); }
      *(LAS u32x4*)(KD + t * 144 + kc) = (u32x4){w[0], w[1], w[2], w[3]}; *(LAS u32x4*)(KD + t * 144 + kc + 8) = (u32x4){w[4], w[5], w[6], w[7]};
      if (tid < 128) HD[(size_t)item * 128 + tid] = fexp(A_[63 * 132 + tid]); }
    __syncthreads();
    bf16x8 Af[2];
#pragma unroll
    for (int ks = 0; ks < 2; ++ks) Af[ks] = tr8(KD, 144, 32 * ks, 16 * wave, lane);
    bf16_t* gp = GS + (size_t)item * 16384 + 16 * wave + 4 * g;
#pragma unroll
    for (int vt = 0; vt < 8; ++vt) { f32x4 acc = (f32x4){0.f, 0.f, 0.f, 0.f};
#pragma unroll
        for (int ks = 0; ks < 2; ++ks) { const bf16x8 bb = tr8(VS, 144, 32 * ks, 16 * vt, lane); acc = MFMA_BF16(Af[ks], bb, acc); }
        *(u32x2*)(gp + (size_t)(16 * vt + l15) * 128) = (u32x2){pk2(acc[0], acc[1]), pk2(acc[2], acc[3])}; }
    __syncthreads();
}
__device__ __forceinline__ void hgrn2_scan(bf16_t* GS, const float* HD) {
    for (int gid = blockIdx.x * 512 + threadIdx.x; gid < 64 * 2048; gid += gridDim.x * 512) {
        const int bh = gid >> 11, e8 = gid & 2047, kk0 = (8 * e8) & 127;
        float S[8] = {0.f, 0.f, 0.f, 0.f, 0.f, 0.f, 0.f, 0.f};
#pragma unroll 4
        for (int n = 0; n < 32; ++n) { const int item = bh * 32 + n; u32x4* p = (u32x4*)(GS + (size_t)item * 16384 + 8 * e8);
            const u32x4 gw = *p; const f32x4 d0 = *(const f32x4*)(HD + (size_t)item * 128 + kk0), d1 = *(const f32x4*)(HD + (size_t)item * 128 + kk0 + 4);
            *p = (u32x4){pk2(S[0], S[1]), pk2(S[2], S[3]), pk2(S[4], S[5]), pk2(S[6], S[7])};
            S[0] = d0[0] * S[0] + bflo(gw.x); S[1] = d0[1] * S[1] + bfhi(gw.x); S[2] = d0[2] * S[2] + bflo(gw.y); S[3] = d0[3] * S[3] + bfhi(gw.y);
            S[4] = d1[0] * S[4] + bflo(gw.z); S[5] = d1[1] * S[5] + bfhi(gw.z); S[6] = d1[2] * S[6] + bflo(gw.w); S[7] = d1[3] * S[7] + bfhi(gw.w); }
    }
}
__device__ __forceinline__ void hgrn3_item(int item, const bf16_t* HQ, const bf16_t* HF, const bf16_t* HI, const bf16_t* HG, const bf16_t* GS, const float* ng, bf16_t* BOUT, LAS unsigned char* lds) {
    const int tid = threadIdx.x, lane = tid & 63, wave = tid >> 6, g = lane >> 4, l15 = lane & 15;
    const int n = item & 31, bh = item >> 5, h = bh & 3, b = bh >> 2, t0 = b * SEQ + n * 64, cb = h * 128;
    hgrn_load_cumsum(t0, cb, HF, HI, lds);
    LAS bf16_t* LF = (LAS bf16_t*)(lds + H_LF); LAS bf16_t* VS = (LAS bf16_t*)(lds + H_VS); LAS float* A_ = (LAS float*)(lds + H_A);
    LAS bf16_t* QI = (LAS bf16_t*)(lds + H_T0); LAS bf16_t* QE = (LAS bf16_t*)(lds + H_T1); LAS bf16_t* KE = (LAS bf16_t*)(lds + H_T2); LAS float* RED = (LAS float*)(lds + H_RED);
    { const int t = tid >> 3, kc = (tid & 7) * 16; unsigned wi[8], we[8], wk[8];
      const u32x4 q0 = *(const u32x4*)(HQ + (size_t)(t0 + t) * 512 + cb + kc), q1 = *(const u32x4*)(HQ + (size_t)(t0 + t) * 512 + cb + kc + 8);
      const unsigned qw[8] = {q0.x, q0.y, q0.z, q0.w, q1.x, q1.y, q1.z, q1.w};
#pragma unroll
      for (int e = 0; e < 16; e += 2) { float oi[2], oe[2], ok[2];
#pragma unroll
        for (int d = 0; d < 2; ++d) { const int kk = kc + e + d; const float a = A_[t * 132 + kk], am = A_[31 * 132 + kk], lf = h2f(LF[t * 144 + kk]);
            const float q = d ? bfhi(qw[e >> 1]) : bflo(qw[e >> 1]);
            oi[d] = q * fexp(a); oe[d] = q * fexp(a - am); ok[d] = (1.0f - fexp(lf)) * fexp(am - a); }
        wi[e >> 1] = pk2(oi[0], oi[1]); we[e >> 1] = pk2(oe[0], oe[1]); wk[e >> 1] = pk2(ok[0], ok[1]); }
      *(LAS u32x4*)(QI + t * 144 + kc) = (u32x4){wi[0], wi[1], wi[2], wi[3]}; *(LAS u32x4*)(QI + t * 144 + kc + 8) = (u32x4){wi[4], wi[5], wi[6], wi[7]};
      *(LAS u32x4*)(QE + t * 144 + kc) = (u32x4){we[0], we[1], we[2], we[3]}; *(LAS u32x4*)(QE + t * 144 + kc + 8) = (u32x4){we[4], we[5], we[6], we[7]};
      *(LAS u32x4*)(KE + t * 144 + kc) = (u32x4){wk[0], wk[1], wk[2], wk[3]}; *(LAS u32x4*)(KE + t * 144 + kc + 8) = (u32x4){wk[4], wk[5], wk[6], wk[7]}; }
    __syncthreads();
    const int tt = wave & 3, vh = wave >> 2, tl = 16 * tt + l15;
    f32x4 P[4];
#pragma unroll
    for (int si = 0; si < 4; ++si) { P[si] = (f32x4){0.f, 0.f, 0.f, 0.f};
        if (si <= tt) {
#pragma unroll
            for (int ks = 0; ks < 4; ++ks) { const bf16x8 a = *(const LAS bf16x8*)(KE + (16 * si + l15) * 144 + 32 * ks + 8 * g), bb = *(const LAS bf16x8*)(QE + tl * 144 + 32 * ks + 8 * g); P[si] = MFMA_BF16(a, bb, P[si]); }
            if (si == tt) {
#pragma unroll
                for (int r = 0; r < 4; ++r) if (4 * g + r > l15) P[si][r] = 0.f; } } }
    bf16x8 Pf[2];
#pragma unroll
    for (int k2 = 0; k2 < 2; ++k2) { const u32x4 w = (u32x4){pk2(P[2 * k2][0], P[2 * k2][1]), pk2(P[2 * k2][2], P[2 * k2][3]), pk2(P[2 * k2 + 1][0], P[2 * k2 + 1][1]), pk2(P[2 * k2 + 1][2], P[2 * k2 + 1][3])}; Pf[k2] = __builtin_bit_cast(bf16x8, w); }
    bf16x8 Qf[4];
#pragma unroll
    for (int ks = 0; ks < 4; ++ks) Qf[ks] = *(const LAS bf16x8*)(QI + tl * 144 + 32 * ks + 8 * g);
    const bf16_t* ST = GS + (size_t)item * 16384;
    f32x4 o[4]; float ssq = 0.f;
#pragma unroll
    for (int vt = 0; vt < 4; ++vt) { const int vd0 = 64 * vh + 16 * vt; o[vt] = (f32x4){0.f, 0.f, 0.f, 0.f};
#pragma unroll
        for (int k2 = 0; k2 < 2; ++k2) if (2 * k2 <= tt) { const bf16x8 a = tr8(VS, 144, 32 * k2, vd0, lane); o[vt] = MFMA_BF16(a, Pf[k2], o[vt]); }
#pragma unroll
        for (int ks = 0; ks < 4; ++ks) { const bf16x8 a = *(const bf16x8*)(ST + (size_t)(vd0 + l15) * 128 + 32 * ks + 8 * g); o[vt] = MFMA_BF16(a, Qf[ks], o[vt]); }
        ssq += (o[vt][0] * o[vt][0] + o[vt][1] * o[vt][1]) + (o[vt][2] * o[vt][2] + o[vt][3] * o[vt][3]); }
    ssq += __shfl_xor(ssq, 16); ssq += __shfl_xor(ssq, 32);
    if (g == 0) RED[vh * 64 + tl] = ssq;
    __syncthreads();
    const float rstd = 1.0f / sqrtf((RED[tl] + RED[64 + tl]) * (1.0f / 128.0f) + EPS);
#pragma unroll
    for (int vt = 0; vt < 4; ++vt) { const int vd = 64 * vh + 16 * vt + 4 * g; const size_t off = (size_t)(t0 + tl) * 512 + cb + vd;
        const u32x2 gw = *(const u32x2*)(HG + off); const f32x4 nw = *(const f32x4*)(ng + vd);
        *(u32x2*)(BOUT + off) = (u32x2){pk2(o[vt][0] * rstd * nw[0] * bflo(gw.x), o[vt][1] * rstd * nw[1] * bfhi(gw.x)), pk2(o[vt][2] * rstd * nw[2] * bflo(gw.y), o[vt][3] * rstd * nw[3] * bfhi(gw.y))}; }
    __syncthreads();
}

struct ProbP3 { int K, lda, ldb; const bf16_t *br, *wbr;
    __device__ __forceinline__ const char* a(const Unit& u) const { return (const char*)(br + (size_t)u.z * M * 512 + (size_t)u.pm * 256 * 512); }
    __device__ __forceinline__ const char* b(const Unit& u) const { return (const char*)(wbr + (size_t)u.z * 1024 * 512 + (size_t)u.pn * 256 * 512); } };
struct SchedP3 { int G, c;
    __device__ __forceinline__ bool next(int i, Unit& u) const { const int L = (i / 3) * G + c; if (L >= 512) return false; pg8::tile_map(L, 128, 4, u); u.z = i % 3; return true; } };
struct EpiP3 { static constexpr bool PERM = true; const bf16_t* GATES; bf16_t* MERGED;
    __device__ __forceinline__ bool operator()(f32x4 (&acc)[2][2][4][2], const Unit& u, int wr, int wc, int fr, int fq) const {
        const int row0 = u.pm * 256 + wr * 64 + fr, col0 = u.pn * 256 + wc * 32 + 8 * fq;
#pragma unroll
        for (int ai = 0; ai < 2; ++ai)
#pragma unroll
            for (int m = 0; m < 4; ++m) { const int row = row0 + ai * 128 + m * 16;
#pragma unroll
                for (int bj = 0; bj < 2; ++bj) { const bf16_t* gp = GATES + (size_t)row * 3072 + u.z * 1024 + col0 + bj * 128;
                    const u32x4 g0 = *(const u32x4*)gp; float f[8] = {bflo(g0.x), bfhi(g0.x), bflo(g0.y), bfhi(g0.y), bflo(g0.z), bfhi(g0.z), bflo(g0.w), bfhi(g0.w)};
                    if (u.z < 2) { const u32x4 g1 = *(const u32x4*)(gp + 1024); const float d[8] = {bflo(g1.x), bfhi(g1.x), bflo(g1.y), bfhi(g1.y), bflo(g1.z), bfhi(g1.z), bflo(g1.w), bfhi(g1.w)};
#pragma unroll
                        for (int j = 0; j < 8; ++j) f[j] = f[j] / fmaxf(d[j], 1e-30f); }
#pragma unroll
                    for (int j = 0; j < 8; ++j) acc[ai][bj][m][j >> 2][j & 3] *= f[j];
                    if (u.z == 2) { const f32x4 v0 = acc[ai][bj][m][0], v1 = acc[ai][bj][m][1];
                        *(u32x4*)(MERGED + (size_t)row * 1024 + col0 + bj * 128) = (u32x4){pk2(v0[0], v0[1]), pk2(v0[2], v0[3]), pk2(v1[0], v1[1]), pk2(v1[2], v1[3])}; } } }
        return u.z < 2;
    }
};

struct ProbN { int K, lda, ldb; const bf16_t *A_, *B_;
    __device__ __forceinline__ const char* a(const Unit& u) const { return (const char*)(A_ + (size_t)u.pm * 256 * lda); }
    __device__ __forceinline__ const char* b(const Unit& u) const { return (const char*)(B_ + (size_t)u.pn * 256 * ldb); } };
struct SchedN { int G, c, nM, nN;
    __device__ __forceinline__ bool next(int i, Unit& u) const { const int L = i * G + c; if (L >= nM * nN) return false; pg8::tile_map(L, nM, nN, u); u.z = 0; return true; } };
template <bool WB> struct EpiRes { static constexpr bool PERM = false; const float* base; float* out; bf16_t* ob; float* ssq; int nofn = 0;
    __device__ __forceinline__ bool operator()(f32x4 (&acc)[2][2][4][2], const Unit& u, int wr, int wc, int fr, int fq) const {
        const int row0 = u.pm * 256 + wr * 64 + fr, col0 = u.pn * 256 + wc * 32 + 4 * fq;
#pragma unroll
        for (int ai = 0; ai < 2; ++ai)
#pragma unroll
            for (int m = 0; m < 4; ++m) { const int row = row0 + ai * 128 + m * 16; const size_t off = (size_t)row * 1024 + col0; float s = 0.f;
#pragma unroll
                for (int bj = 0; bj < 2; ++bj)
#pragma unroll
                    for (int n = 0; n < 2; ++n) { f32x4 v = *(const f32x4*)(base + off + bj * 128 + n * 16); if (!nofn) v = v + acc[ai][bj][m][n];
                        *(f32x4*)(out + off + bj * 128 + n * 16) = v; s += (v[0] * v[0] + v[1] * v[1]) + (v[2] * v[2] + v[3] * v[3]);
                        if (WB) *(u32x2*)(ob + off + bj * 128 + n * 16) = (u32x2){pk2(v[0], v[1]), pk2(v[2], v[3])}; }
                s += __shfl_xor(s, 16); s += __shfl_xor(s, 32);
                if (fq == 0) atomicAdd(ssq + row, s); }
        return false;
    }
};

struct EpiP5 { static constexpr bool PERM = true; const float *ssq2, *cw, *cbias; bf16_t* ACT; float *HALO, *TOPA, *TOPB;
    __device__ __forceinline__ bool operator()(f32x4 (&acc)[2][2][4][2], const Unit& u, int wr, int wc, int fr, int fq) const {
        const int lane = threadIdx.x & 63;
        const int ch0 = u.pn * 128 + wc * 32 + 8 * fq;
        float w0[8], w1[8], w2[8], cb[8];
#pragma unroll
        for (int j = 0; j < 8; ++j) { w0[j] = cw[ch0 + j]; w1[j] = cw[DFF + ch0 + j]; w2[j] = cw[2 * DFF + ch0 + j]; cb[j] = cbias[ch0 + j]; }
        const int src1 = (lane & 48) | ((fr + 15) & 15), src2 = (lane & 48) | ((fr + 14) & 15);
#pragma unroll
        for (int ai = 0; ai < 2; ++ai) {
            const int blk = u.pm * 4 + ai * 2 + wr, rowb = blk * 64;
            float p1[8], p2[8];
#pragma unroll
            for (int j = 0; j < 8; ++j) { p1[j] = 0.f; p2[j] = 0.f; }
#pragma unroll
            for (int m = 0; m < 4; ++m) { const int row = rowb + m * 16 + fr; const float r = 1.0f / sqrtf(ssq2[row] * (1.0f / D) + EPS);
                float a[8], bv[8], r1[8], r2[8];
#pragma unroll
                for (int j = 0; j < 8; ++j) { a[j] = acc[ai][0][m][j >> 2][j & 3] * r; bv[j] = acc[ai][1][m][j >> 2][j & 3] * r; r1[j] = __shfl(a[j], src1); r2[j] = __shfl(a[j], src2); }
                float o[8];
#pragma unroll
                for (int j = 0; j < 8; ++j) { const float am1 = fr >= 1 ? r1[j] : p1[j], am2 = fr >= 2 ? r2[j] : p2[j]; const float cv = cb[j] + w0[j] * am2 + w1[j] * am1 + w2[j] * a[j]; o[j] = fsilu(cv) * bv[j]; p1[j] = r1[j]; p2[j] = r2[j]; }
                if (m > 0 || fr >= 2) *(u32x4*)(ACT + (size_t)row * DFF + ch0) = (u32x4){pk2(o[0], o[1]), pk2(o[2], o[3]), pk2(o[4], o[5]), pk2(o[6], o[7])};
                else { float* ta = TOPA + ((size_t)blk * 2 + fr) * DFF + ch0; float* tb = TOPB + ((size_t)blk * 2 + fr) * DFF + ch0;
                    *(f32x4*)ta = (f32x4){a[0], a[1], a[2], a[3]}; *(f32x4*)(ta + 4) = (f32x4){a[4], a[5], a[6], a[7]}; *(f32x4*)tb = (f32x4){bv[0], bv[1], bv[2], bv[3]}; *(f32x4*)(tb + 4) = (f32x4){bv[4], bv[5], bv[6], bv[7]}; }
                if (m == 3 && fr >= 14) { float* hp = HALO + ((size_t)blk * 2 + (fr - 14)) * DFF + ch0; *(f32x4*)hp = (f32x4){a[0], a[1], a[2], a[3]}; *(f32x4*)(hp + 4) = (f32x4){a[4], a[5], a[6], a[7]}; }
            }
        }
        return false;
    }
};
__device__ __forceinline__ void p6_fix_panel(int pm, const float* HALO, const float* TOPA, const float* TOPB, const float* cw, const float* cbias, bf16_t* ACT) {
    for (int i = threadIdx.x; i < 4 * 2 * DFF; i += 512) { const int ch = i % DFF, lr = (i / DFF) & 1, b4 = i / (2 * DFF), blk = pm * 4 + b4; const bool first = (blk & 31) == 0;
        const float h0 = first ? 0.f : HALO[((size_t)(blk - 1) * 2 + 0) * DFF + ch], h1 = first ? 0.f : HALO[((size_t)(blk - 1) * 2 + 1) * DFF + ch];
        const float t0 = TOPA[((size_t)blk * 2 + 0) * DFF + ch], t1 = TOPA[((size_t)blk * 2 + 1) * DFF + ch];
        const float am2 = lr ? h1 : h0, am1 = lr ? t0 : h1, a0 = lr ? t1 : t0;
        const float cv = cbias[ch] + cw[ch] * am2 + cw[DFF + ch] * am1 + cw[2 * DFF + ch] * a0;
        const float o = fsilu(cv) * TOPB[((size_t)blk * 2 + lr) * DFF + ch];
        ACT[(size_t)(blk * 64 + lr) * DFF + ch] = (bf16_t)(pk2(o, 0.f) & 0xffffu); }
}

__global__ void __launch_bounds__(512, 2) hybrid_fwd(Args A) {
    extern __shared__ __attribute__((aligned(16))) unsigned char lds_raw[];
    LAS unsigned char* lds = (LAS unsigned char*)lds_raw;
    cg::grid_group grid = cg::this_grid();
    unsigned char* ws = A.ws; const int G = gridDim.x, c = blockIdx.x;
    bf16_t* WIN = (bf16_t*)(ws + WS_WIN); bf16_t* WKV = (bf16_t*)(ws + WS_WKV); bf16_t* WBR = (bf16_t*)(ws + WS_WBR); bf16_t* WO = (bf16_t*)(ws + WS_WO); bf16_t* WUP = (bf16_t*)(ws + WS_WUP); bf16_t* WD = (bf16_t*)(ws + WS_WD);
    float* RS1 = (float*)(ws + WS_RS1); float* RSM = (float*)(ws + WS_RSM); float* SSQ2 = (float*)(ws + WS_SSQ2); float* SSQ3 = (float*)(ws + WS_SSQ3); float* HD = (float*)(ws + WS_HD);
    bf16_t* XB = (bf16_t*)(ws + WS_XB); bf16_t* GS = XB; bf16_t* MERGED = XB; bf16_t* MEMB = (bf16_t*)(ws + WS_MEMB); bf16_t* KV = (bf16_t*)(ws + WS_KV);
    bf16_t* HI = (bf16_t*)(ws + WS_HI); bf16_t* HG = (bf16_t*)(ws + WS_HG); bf16_t* XQ = (bf16_t*)(ws + WS_XQ); bf16_t* X1B = HI;
    bf16_t* GATES = (bf16_t*)(ws + WS_GATES); bf16_t* ACT = GATES;
    bf16_t* AOUT = (bf16_t*)(ws + WS_AOUT); bf16_t* BOUT = (bf16_t*)(ws + WS_BOUT); bf16_t* COUT = (bf16_t*)(ws + WS_COUT);
    float* HALO = (float*)(ws + WS_AOUT); float* TOPA = HALO + (size_t)512 * 2 * DFF; float* TOPB = TOPA + (size_t)512 * 2 * DFF;
    bf16_t* U = (bf16_t*)A.out; bf16_t* V = U + (size_t)M * 512; bf16_t* HQ = V + (size_t)M * 512; bf16_t* HF = HQ + (size_t)M * 512;
    const int lo = A.ph_lo, hi = A.ph_hi;
#define IN(k) (lo <= (k) && (k) < hi)
#define SEAM(k) do { if (IN(k) && IN((k) + 1)) grid.sync(); } while (0)
    if (IN(0)) p0_prologue(A, lds);
    SEAM(0);
    if (IN(1)) { ProbP1 P{1024, 1024, 1024, XB, MEMB, WIN, WKV}; SchedP1 S{G, c}; EpiP1 E{RS1, RSM, A.in[I_LB], U, V, HQ, HF, HI, HG, XQ, GATES, KV}; pg8::gemm_phase(lds, P, S, E); }
    SEAM(1);
    if (IN(2)) {
        for (int it = c; it < 2048; it += G) hgrn1_item(it, HF, HI, GS, HD, lds);
        for (int it = c; it < 256; it += G) sgu_item(it, U, V, A.in[I_LNG], A.in[I_LNB], A.in[I_WSP], A.in[I_BSP], AOUT, lds);
        for (int it = c; it < 1024; it += G) attn_item(it, XQ, KV, COUT, lds);
    }
    SEAM(2);
    if (IN(3)) hgrn2_scan(GS, HD);
    SEAM(3);
    if (IN(4)) {
        if (!((DBG_ZERO_MASK >> 1) & 1)) for (int it = c; it < 2048; it += G) hgrn3_item(it, HQ, HF, HI, HG, GS, A.in[I_HNG], BOUT, lds);
        for (int z = 0; z < 3; ++z) if ((DBG_ZERO_MASK >> z) & 1) { u32x4* p = (u32x4*)(AOUT + (size_t)z * M * 512);
            for (size_t i = (size_t)c * 512 + threadIdx.x; i < (size_t)M * 512 / 8; i += (size_t)G * 512) p[i] = (u32x4){0u, 0u, 0u, 0u}; } }
    SEAM(4);
    if (IN(5)) { ProbP3 P{512, 512, 512, AOUT, WBR}; SchedP3 S{G, c}; EpiP3 E{GATES, MERGED}; pg8::gemm_phase(lds, P, S, E); }
    SEAM(5);
    if (IN(6)) { ProbN P{1024, 1024, 1024, MERGED, WO}; SchedN S{G, c, 128, 4}; EpiRes<true> E{A.in[I_X], A.out, X1B, SSQ2}; pg8::gemm_phase(lds, P, S, E); }
    SEAM(6);
    if (IN(7)) { ProbN P{1024, 1024, 1024, X1B, WUP}; SchedN S{G, c, 128, 22}; EpiP5 E{SSQ2, A.in[I_CW], A.in[I_CB], ACT, HALO, TOPA, TOPB}; pg8::gemm_phase(lds, P, S, E); }
    SEAM(7);
    if (IN(8)) {
        SchedN S{G, c, 128, 4}; Unit u;
        for (int i = 0; S.next(i, u); ++i) p6_fix_panel(u.pm, HALO, TOPA, TOPB, A.in[I_CW], A.in[I_CB], ACT);
        __threadfence(); __syncthreads();
        ProbN P{DFF, DFF, DFF, ACT, WD}; EpiRes<false> E{A.out, A.out, nullptr, SSQ3}; E.nofn = DBG_NO_FFN; pg8::gemm_phase(lds, P, S, E);
    }
    SEAM(8);
    if (IN(9)) {
        const int lane = threadIdx.x & 63, gw = c * 8 + (threadIdx.x >> 6), NGW = G * 8; const float* fg = A.in[I_FG];
        f32x4 gv[4];
#pragma unroll
        for (int j = 0; j < 4; ++j) gv[j] = *((const f32x4*)fg + lane + 64 * j);
        for (int m = gw; m < M; m += NGW) { const float r = 1.0f / sqrtf(SSQ3[m] * (1.0f / D) + EPS); f32x4* p = (f32x4*)(A.out + (size_t)m * D) + lane;
#pragma unroll
            for (int j = 0; j < 4; ++j) { f32x4 o = p[64 * j] * r * gv[j];
#if DBG_SANITIZE
                for (int e = 0; e < 4; ++e) if (!(fabsf(o[e]) < 1e30f)) o[e] = 0.f;
#endif
                p[64 * j] = o; } }
    }
#undef IN
#undef SEAM
}

constexpr int NPHASE = 10;
extern "C" void kernel_launch(void* const* d_in, const int* in_sizes, int n_in, void* d_out, int out_size, void* d_ws, size_t ws_size, hipStream_t stream) {
    static int grid = 0;
    if (grid == 0) {
        if (n_in != 20 || out_size != M * D || ws_size < WS_END) { fprintf(stderr, "kernel_launch: unexpected shapes (n_in %d out %d ws %zu)\n", n_in, out_size, ws_size); grid = -1; return; }
        int dev = 0, cus = 0, per_cu = 0;
        hipGetDevice(&dev); hipDeviceGetAttribute(&cus, hipDeviceAttributeMultiprocessorCount, dev);
        hipFuncSetAttribute((const void*)hybrid_fwd, hipFuncAttributeMaxDynamicSharedMemorySize, LDS_BYTES);
        hipOccupancyMaxActiveBlocksPerMultiprocessor(&per_cu, (const void*)hybrid_fwd, 512, LDS_BYTES);
        if (per_cu < 1) { fprintf(stderr, "kernel_launch: occupancy query says %d blocks per CU\n", per_cu); per_cu = 1; }
        (void)hipGetLastError();
        grid = cus * 1;
        if (grid > cus * per_cu) grid = cus * per_cu;
    }
    if (grid <= 0) return;
    Args a{};
    for (int i = 0; i < 20; ++i) a.in[i] = (const float*)d_in[i];
    a.out = (float*)d_out; a.ws = (unsigned char*)d_ws;
#if MK_PER_PHASE
    for (int p = 0; p < NPHASE; ++p) { a.ph_lo = p; a.ph_hi = p + 1; hipLaunchKernelGGL(hybrid_fwd, dim3(grid), dim3(512), LDS_BYTES, stream, a); }
#else
    a.ph_lo = 0; a.ph_hi = NPHASE;
    void* args[] = {&a};
    hipError_t e = hipLaunchCooperativeKernel((const void*)hybrid_fwd, dim3(grid), dim3(512), args, LDS_BYTES, stream);
    if (e != hipSuccess) fprintf(stderr, "cooperative launch failed: %s (grid %d)\n", hipGetErrorString(e), grid);
#endif
}
```

```cpp
#include <hip/hip_runtime.h>
#include <hip/hip_cooperative_groups.h>
#include <cstdio>
#include <cstdint>
namespace cg = cooperative_groups;

#define DBG_SANITIZE 0
#define DBG_ATTN_COPY 0
#define DBG_ZERO_MASK 0
#define DBG_NO_FFN 0
#define DBG_REP5 1
#define DBG_XSYNC 0
#define DBG_DUP 0
#ifndef MK_PER_PHASE
#define MK_PER_PHASE 0
#endif

#define LAS __attribute__((address_space(3)))
typedef unsigned short bf16_t;
typedef short bf16x8 __attribute__((ext_vector_type(8)));
typedef short s16x4 __attribute__((ext_vector_type(4)));
typedef _Float16 f16x8 __attribute__((ext_vector_type(8)));
typedef float f32x4 __attribute__((ext_vector_type(4)));
typedef float f32x2 __attribute__((ext_vector_type(2)));
typedef unsigned u32x4 __attribute__((ext_vector_type(4)));
typedef unsigned u32x2 __attribute__((ext_vector_type(2)));

constexpr int M = 32768, D = 1024, SEQ = 2048, INW = 6656, MEMROWS = 4096, MEML = 256, DFF = 2816, NUP = 5632;
constexpr float EPS = 1e-6f;
constexpr size_t MiB = 1u << 20;
constexpr size_t WS_WIN = 0, WS_WKV = 13 * MiB, WS_WBR = 15 * MiB, WS_WO = 18 * MiB, WS_WUP = 20 * MiB, WS_WD = 31 * MiB;
constexpr size_t WS_RS1 = 37 * MiB, WS_RSM = WS_RS1 + 128 * 1024, WS_SSQ2 = WS_RS1 + 256 * 1024, WS_SSQ3 = WS_RS1 + 384 * 1024, WS_HD = 38 * MiB;
constexpr size_t WS_BAR = 39 * MiB;
constexpr size_t WS_XB = 48 * MiB;
constexpr size_t WS_MEMB = 112 * MiB, WS_KV = 120 * MiB;
constexpr size_t WS_HI = 128 * MiB, WS_HG = 160 * MiB, WS_XQ = 192 * MiB;
constexpr size_t WS_GATES = 224 * MiB;
constexpr size_t WS_AOUT = 416 * MiB, WS_BOUT = 448 * MiB, WS_COUT = 480 * MiB;
constexpr size_t WS_END = 512 * MiB;
constexpr int LDS_BYTES = 159744;

typedef __bf16 bf16x2_t __attribute__((ext_vector_type(2)));
__device__ __forceinline__ unsigned pk2(float lo, float hi) { f32x2 v = {lo, hi}; bf16x2_t b = __builtin_convertvector(v, bf16x2_t); return __builtin_bit_cast(unsigned, b); }
__device__ __forceinline__ float bflo(unsigned w) { return __uint_as_float(w << 16); }
__device__ __forceinline__ float bfhi(unsigned w) { return __uint_as_float(w & 0xffff0000u); }
__device__ __forceinline__ float fexp(float x) { return __builtin_amdgcn_exp2f(x * 1.4426950408889634f); }
__device__ __forceinline__ float fsigmoid(float x) { return __builtin_amdgcn_rcpf(1.0f + fexp(-x)); }
__device__ __forceinline__ float fsilu(float x) { return x * fsigmoid(x); }
__device__ __forceinline__ float fgelu(float x) { return x * fsigmoid(1.5957691216057308f * (x + 0.044715f * x * x * x)); }
__device__ __forceinline__ unsigned pkh2(float lo, float hi) { _Float16 a = (_Float16)lo, b = (_Float16)hi; return (unsigned)__builtin_bit_cast(unsigned short, a) | ((unsigned)__builtin_bit_cast(unsigned short, b) << 16); }
__device__ __forceinline__ float wave_sum(float v) {
#pragma unroll
    for (int o = 1; o < 64; o <<= 1) v += __shfl_xor(v, o);
    return v;
}
typedef short v4i16_t __attribute__((ext_vector_type(4)));
__device__ __forceinline__ s16x4 tr4(const LAS bf16_t* p) { return __builtin_bit_cast(s16x4, __builtin_amdgcn_ds_read_tr16_b64_v4i16((LAS v4i16_t*)p)); }
__device__ __forceinline__ bf16x8 tr8(const LAS bf16_t* tile, int P, int k0, int c0, int lane) {
    const int g = lane >> 4, q = (lane & 15) >> 2, p = lane & 3;
    const LAS bf16_t* a = tile + (k0 + 4 * g + q) * P + c0 + 4 * p;
    const s16x4 lo = tr4(a), hi = tr4(a + 16 * P);
    return (bf16x8){lo[0], lo[1], lo[2], lo[3], hi[0], hi[1], hi[2], hi[3]};
}
#define MFMA_BF16(a, b, c) __builtin_amdgcn_mfma_f32_16x16x32_bf16((a), (b), (c), 0, 0, 0)

namespace pg8 {
constexpr int BM = 256, BK = 64, HALF = 128, HTB = HALF * BK * 2, STAGE_BYTES = 8 * HTB, NXCD = 8, WGM = 8;
__host__ __device__ __forceinline__ int lds_byte(int r, int c) { const int st = (r >> 4) * 2 + (c >> 5), rr = r & 15, cc = c & 31, ob = rr * 64 + cc * 2; return st * 1024 + (ob ^ (((ob >> 9) & 1) << 5)); }
__host__ __device__ __forceinline__ void stage_rc(int b, int& R, int& C) { const int st = b / 1024, sb = b % 1024, swz = sb ^ (((sb >> 9) & 1) << 5); R = (st >> 1) * 16 + swz / 64; C = (st & 1) * 32 + (swz % 64) / 2; }
__host__ __device__ __forceinline__ int perm32(int rho) { const int n = rho >> 4, i = rho & 15; return 8 * (i >> 2) + 4 * n + (i & 3); }
struct Unit { int pm, pn, z; };
__device__ __forceinline__ void tile_map(int wgid, int nM, int nN, Unit& u) {
    const int nwg = nM * nN;
    { const int q = nwg / NXCD, r = nwg % NXCD, xcd = wgid % NXCD, off = wgid / NXCD; wgid = (xcd < r ? xcd * (q + 1) : r * (q + 1) + (xcd - r) * q) + off; }
    const int nig = WGM * nN, gid = wgid / nig, fm = gid * WGM, gsz = (nM - fm) < WGM ? (nM - fm) : WGM;
    u.pm = fm + ((wgid % nig) % gsz); u.pn = (wgid % nig) / gsz;
}
template <class Prob, class Epi, class Sched>
__device__ __forceinline__ void gemm_phase(LAS unsigned char* lds, const Prob& Pb, const Sched& S, const Epi& E, unsigned delay = 0) {
    if (delay) { const unsigned long long t0 = __builtin_amdgcn_s_memrealtime(); while (__builtin_amdgcn_s_memrealtime() - t0 < delay) __builtin_amdgcn_s_sleep(8); }
    const int tid = threadIdx.x, wid = __builtin_amdgcn_readfirstlane(tid >> 6), lane = tid & 63, wr = wid >> 2, wc = wid & 3, fr = lane & 15, fq = lane >> 4;
    const int K = Pb.K, nt = K / BK;
    unsigned voffA[2], voffB[2];
#pragma unroll
    for (int i = 0; i < 2; ++i) { int R, C; stage_rc(tid * 16 + i * 8192, R, C); const int Rb = Epi::PERM ? ((R & ~31) + perm32(R & 31)) : R;
        voffA[i] = (unsigned)(R * Pb.lda + C) * 2u; voffB[i] = (unsigned)(Rb * Pb.ldb + C) * 2u; }
    const size_t kstep = (size_t)(BK * 2);
    const size_t hsA = (size_t)HALF * Pb.lda * 2, hsB = (size_t)HALF * Pb.ldb * 2;
    const unsigned ldsw = (unsigned)wid * 1024u;
    const int aoff = lds_byte(wr * 64 + fr, fq * 8), boff = lds_byte(wc * 32 + fr, fq * 8);
#define PG8_SA(b, h) (((b) * 2 + (h)) * HTB)
#define PG8_SB(b, h) ((4 + (b) * 2 + (h)) * HTB)
#define PG8_STAGE(bufoff, gbase, voff) do { _Pragma("unroll") for (int _i = 0; _i < 2; ++_i) \
        __builtin_amdgcn_global_load_lds((const unsigned*)((const char*)(gbase) + (voff)[_i]), (LAS unsigned*)(lds + (bufoff) + ldsw + _i * 8192), 16, 0, 0); } while (0)
#define PG8_LDA(dst, b, h) do { _Pragma("unroll") for (int m = 0; m < 4; ++m) _Pragma("unroll") for (int k = 0; k < 2; ++k) dst[m][k] = *(const LAS bf16x8*)(lds + PG8_SA(b, h) + aoff + m * 2048 + k * 1024); } while (0)
#define PG8_LDB(dst, b, h) do { _Pragma("unroll") for (int n = 0; n < 2; ++n) _Pragma("unroll") for (int k = 0; k < 2; ++k) dst[n][k] = *(const LAS bf16x8*)(lds + PG8_SB(b, h) + boff + n * 2048 + k * 1024); } while (0)
#define PG8_MMA(ai, bj, At, Bt) do { __builtin_amdgcn_s_setprio(1); _Pragma("unroll") for (int m = 0; m < 4; ++m) _Pragma("unroll") for (int n = 0; n < 2; ++n) _Pragma("unroll") for (int k = 0; k < 2; ++k) \
        acc[ai][bj][m][n] = __builtin_amdgcn_mfma_f32_16x16x32_bf16(Bt[n][k], At[m][k], acc[ai][bj][m][n], 0, 0, 0); __builtin_amdgcn_s_setprio(0); } while (0)
#define PG8_WAIT_V(n) asm volatile("s_waitcnt vmcnt(" #n ")" ::: "memory")
#define PG8_WAIT_L(n) asm volatile("s_waitcnt lgkmcnt(" #n ")" ::: "memory")
#define PG8_BAR __builtin_amdgcn_s_barrier()
#define PG8_SCHED __builtin_amdgcn_sched_barrier(0)
    Unit cur, nxt; int ui = 0;
    if (!S.next(0, cur)) return;
    f32x4 acc[2][2][4][2];
#pragma unroll
    for (int a = 0; a < 2; ++a)
#pragma unroll
        for (int b = 0; b < 2; ++b)
#pragma unroll
            for (int m = 0; m < 4; ++m)
#pragma unroll
                for (int n = 0; n < 2; ++n) acc[a][b][m][n] = (f32x4){0.f, 0.f, 0.f, 0.f};
    bf16x8 At[4][2], B0[2][2], B1[2][2];
    const char* cA = Pb.a(cur); const char* cB = Pb.b(cur);
    PG8_STAGE(PG8_SB(0, 0), cB, voffB); PG8_STAGE(PG8_SB(0, 1), cB + hsB, voffB); PG8_STAGE(PG8_SA(0, 0), cA, voffA); PG8_STAGE(PG8_SA(0, 1), cA + hsA, voffA);
    if (wr == 1) PG8_BAR;
    PG8_WAIT_V(2); PG8_BAR;
    PG8_STAGE(PG8_SB(1, 0), cB + kstep, voffB); PG8_STAGE(PG8_SA(1, 0), cA + kstep, voffA); PG8_STAGE(PG8_SB(1, 1), cB + hsB + kstep, voffB);
    PG8_WAIT_V(6); PG8_BAR;
    for (;;) {
        const bool has_next = S.next(ui + 1, nxt);
        const char* nA = has_next ? Pb.a(nxt) : cA; const char* nB = has_next ? Pb.b(nxt) : cB;
        for (int t = 0; t < nt; t += 2) {
            const bool last = (t == nt - 2);
            const char* a1 = cA + (size_t)(t + 1) * kstep;
            const char* a2 = last ? nA : cA + (size_t)(t + 2) * kstep; const char* b2 = last ? nB : cB + (size_t)(t + 2) * kstep;
            const char* a3 = a2 + kstep; const char* b3 = b2 + kstep;
            PG8_LDB(B0, 0, 0); PG8_LDB(B1, 0, 1); PG8_SCHED; PG8_LDA(At, 0, 0); PG8_STAGE(PG8_SA(1, 1), a1 + hsA, voffA);
            PG8_WAIT_V(8); PG8_WAIT_L(0); PG8_BAR; PG8_MMA(0, 0, At, B0); PG8_MMA(0, 1, At, B1); PG8_BAR; PG8_SCHED;
            PG8_LDA(At, 0, 1); PG8_STAGE(PG8_SB(0, 0), b2, voffB); PG8_STAGE(PG8_SB(0, 1), b2 + hsB, voffB); PG8_STAGE(PG8_SA(0, 0), a2, voffA);
            PG8_WAIT_V(8); PG8_WAIT_L(0); PG8_BAR; PG8_MMA(1, 0, At, B0); PG8_MMA(1, 1, At, B1); PG8_BAR; PG8_SCHED;
            PG8_LDB(B0, 1, 0); PG8_LDB(B1, 1, 1); PG8_SCHED; PG8_LDA(At, 1, 0); PG8_STAGE(PG8_SA(0, 1), a2 + hsA, voffA);
            PG8_WAIT_V(8); PG8_WAIT_L(0); PG8_BAR; PG8_MMA(0, 0, At, B0); PG8_MMA(0, 1, At, B1); PG8_BAR; PG8_SCHED;
            PG8_LDA(At, 1, 1); PG8_STAGE(PG8_SB(1, 0), b3, voffB); PG8_STAGE(PG8_SB(1, 1), b3 + hsB, voffB); PG8_STAGE(PG8_SA(1, 0), a3, voffA);
            PG8_WAIT_V(8); PG8_WAIT_L(0); PG8_BAR; PG8_MMA(1, 0, At, B0); PG8_MMA(1, 1, At, B1); PG8_BAR; PG8_SCHED;
        }
        if (wr == 0) PG8_BAR;
        const bool keep = E(acc, cur, wr, wc, fr, fq);
        if (!has_next) break;
        if (!keep) {
#pragma unroll
        for (int a = 0; a < 2; ++a)
#pragma unroll
            for (int b = 0; b < 2; ++b)
#pragma unroll
                for (int m = 0; m < 4; ++m)
#pragma unroll
                    for (int n = 0; n < 2; ++n) acc[a][b][m][n] = (f32x4){0.f, 0.f, 0.f, 0.f};
        }
        cur = nxt; cA = nA; cB = nB; ++ui;
        if (wr == 1) PG8_BAR;
    }
    PG8_WAIT_V(0);
    PG8_BAR;
#undef PG8_SA
#undef PG8_SB
#undef PG8_STAGE
#undef PG8_LDA
#undef PG8_LDB
#undef PG8_MMA
#undef PG8_WAIT_V
#undef PG8_WAIT_L
#undef PG8_BAR
#undef PG8_SCHED
}
}
using pg8::Unit;

#define XB_TMO      128
#define XB_XCNT(j)  (256  + 64 * (j))
#define XB_XSUB(j)  (1280 + 64 * (j))
#define XB_XGEN(j)  (2304 + 64 * (j))
#define XB_TOP      3328
#define XB_TOPGEN   3392
#define XCD_BAR_WORDS 3456
#define XB_SPIN_CAP (1u << 18)
__device__ __forceinline__ unsigned xb_ld(unsigned* p)              { return __hip_atomic_load(p, __ATOMIC_RELAXED, __HIP_MEMORY_SCOPE_AGENT); }
__device__ __forceinline__ unsigned xb_add(unsigned* p, unsigned v) { return __hip_atomic_fetch_add(p, v, __ATOMIC_RELAXED, __HIP_MEMORY_SCOPE_AGENT); }
__device__ __forceinline__ unsigned xb_xcc_id() { return (unsigned)__builtin_amdgcn_s_getreg((3 << 11) | 20) & 0xFu; }
#define XB_SPIN(cond, bar) do { unsigned _sp = 0; while (cond) { __builtin_amdgcn_s_sleep(1); \
    if ((++_sp & 255u) == 0u) { if (xb_ld(&(bar)[XB_TMO])) break; if (_sp > XB_SPIN_CAP) { atomicAdd(&(bar)[XB_TMO], 1u); break; } } } } while (0)
struct XcdBarrier { unsigned* bar; unsigned x; volatile LAS unsigned* st; };
__device__ __forceinline__ XcdBarrier xcd_barrier_post(unsigned* bar, volatile LAS unsigned* st) {
    XcdBarrier b; b.bar = bar; b.x = xb_xcc_id(); b.st = st;
    if (threadIdx.x == 0) (void)xb_add(&bar[XB_XCNT(b.x)], 1u);
    return b;
}
__device__ __forceinline__ void xcd_barrier_complete(unsigned* bar, unsigned x, unsigned& nloc, unsigned& nx) {
    const unsigned G = gridDim.x * gridDim.y * gridDim.z;
    unsigned sum, cnt, mine, sp = 0u;
    for (;;) {
        sum = 0u; cnt = 0u; mine = 0u;
#pragma unroll
        for (unsigned j = 0; j < 16; ++j) { const unsigned c = xb_ld(&bar[XB_XCNT(j)]); sum += c; cnt += (c > 0u) ? 1u : 0u; mine = (j == x) ? c : mine; }
        if (sum == G) break;
        __builtin_amdgcn_s_sleep(1);
        if ((++sp & 255u) == 0u) { if (xb_ld(&bar[XB_TMO])) break; if (sp > XB_SPIN_CAP) { atomicAdd(&bar[XB_TMO], 1u); break; } }
    }
    nloc = mine > 0u ? mine : 1u; nx = cnt > 0u ? cnt : 1u;
}
__device__ __forceinline__ void xcd_barrier(const XcdBarrier& b) {
    asm volatile("s_waitcnt vmcnt(0)" ::: "memory");
    __syncthreads();
    if (threadIdx.x == 0) {
        unsigned* bar = b.bar;
        __builtin_amdgcn_s_waitcnt(0);
        unsigned nloc = b.st[0], nx = b.st[1];
        if (nloc == 0u) { xcd_barrier_complete(bar, b.x, nloc, nx); b.st[0] = nloc; b.st[1] = nx; }
        const unsigned old = xb_add(&bar[XB_XSUB(b.x)], 1u);
        const unsigned gen = old / nloc;
        if (old + 1u == (gen + 1u) * nloc) {
            __builtin_amdgcn_fence(__ATOMIC_RELEASE, "agent");
            asm volatile("s_waitcnt vmcnt(0)" ::: "memory");
            const unsigned og = xb_add(&bar[XB_TOP], 1u);
            const unsigned tg = og / nx;
            if (og + 1u == (tg + 1u) * nx) xb_add(&bar[XB_TOPGEN], 1u);
            else XB_SPIN(xb_ld(&bar[XB_TOPGEN]) == tg, bar);
            __builtin_amdgcn_fence(__ATOMIC_ACQUIRE, "agent");
            xb_add(&bar[XB_XGEN(b.x)], 1u);
            asm volatile("s_waitcnt vmcnt(0)" ::: "memory");
        } else {
            XB_SPIN(xb_ld(&bar[XB_XGEN(b.x)]) == gen, bar);
            __builtin_amdgcn_fence(__ATOMIC_ACQUIRE, "agent");
            asm volatile("s_waitcnt vmcnt(0)" ::: "memory");
        }
    }
    __syncthreads();
}

constexpr int NPHASE_K = 10;
struct Args { const float* in[20]; float* out; unsigned char* ws; int ph_lo, ph_hi; };
enum { I_X = 0, I_MEM, I_N1G, I_WIN, I_LNG, I_LNB, I_WSP, I_BSP, I_LB, I_HNG, I_MNG, I_WKV, I_WBR, I_WOUT, I_N2G, I_WUP, I_CW, I_CB, I_WDN, I_FG };

template <int MAP> __device__ __forceinline__ void transpose_item(const float* W, int K, int N, bf16_t* WT, const float* sk, LAS float* scr, int item, int lane) {
    const int nblk = N / 64, kb = item / nblk, nb = item % nblk, k0 = 64 * kb, n0 = 64 * nb;
    f32x4 v[16];
#pragma unroll
    for (int i = 0; i < 16; ++i) v[i] = *(const f32x4*)(W + (size_t)(k0 + 4 * i + (lane >> 4)) * N + n0 + 4 * (lane & 15));
#pragma unroll
    for (int i = 0; i < 16; ++i) { const int kk = 4 * i + (lane >> 4); f32x4 x = v[i]; if (sk) x = x * sk[k0 + kk]; LAS float* d = scr + kk * 65 + 4 * (lane & 15); d[0] = x[0]; d[1] = x[1]; d[2] = x[2]; d[3] = x[3]; }
    asm volatile("s_waitcnt lgkmcnt(0)" ::: "memory");
    const int c = lane & 7;
    int r0 = n0;
    if (MAP == 1) { const int half = n0 >= DFF, ch = n0 - half * DFF; r0 = 256 * (ch >> 7) + 128 * half + (ch & 127); }
#pragma unroll
    for (int j = 0; j < 8; ++j) { const int n = (lane >> 3) + 8 * j; const LAS float* p = scr + (8 * c) * 65 + n;
        u32x4 o; o.x = pk2(p[0 * 65], p[1 * 65]); o.y = pk2(p[2 * 65], p[3 * 65]); o.z = pk2(p[4 * 65], p[5 * 65]); o.w = pk2(p[6 * 65], p[7 * 65]);
        *(u32x4*)(WT + (size_t)(r0 + n) * K + k0 + 8 * c) = o; }
    asm volatile("s_waitcnt lgkmcnt(0)" ::: "memory");
}
__device__ __forceinline__ void rows4_to_bf16(const float* x, bf16_t* o, float* rs, int m0, int lane) {
    f32x4 v[4][4];
#pragma unroll
    for (int r = 0; r < 4; ++r)
#pragma unroll
        for (int j = 0; j < 4; ++j) v[r][j] = *((const f32x4*)(x + (size_t)(m0 + r) * D) + lane + 64 * j);
#pragma unroll
    for (int r = 0; r < 4; ++r) { float q = 0.f;
#pragma unroll
        for (int j = 0; j < 4; ++j) q += (v[r][j].x * v[r][j].x + v[r][j].y * v[r][j].y) + (v[r][j].z * v[r][j].z + v[r][j].w * v[r][j].w);
        q = wave_sum(q);
        if (lane == 0) rs[m0 + r] = 1.0f / sqrtf(q * (1.0f / D) + EPS);
        u32x2* o8 = (u32x2*)(o + (size_t)(m0 + r) * D) + lane;
#pragma unroll
        for (int j = 0; j < 4; ++j) o8[64 * j] = (u32x2){pk2(v[r][j].x, v[r][j].y), pk2(v[r][j].z, v[r][j].w)}; }
}
__device__ __forceinline__ void p0_prologue(const Args& A, LAS unsigned char* lds) {
    const int tid = threadIdx.x, lane = tid & 63, wave = tid >> 6;
    LAS float* scr = (LAS float*)(lds + wave * 16896);
    const int gw = blockIdx.x * 8 + wave, NGW = gridDim.x * 8;
    unsigned char* ws = A.ws;
    constexpr int I0 = 16 * (INW / 64), I1 = 16 * 16, I2 = 8 * 16, I3 = 16 * 16, I4 = 16 * (NUP / 64), I5 = (DFF / 64) * 16;
    constexpr int NITEMS = I0 + I1 + 3 * I2 + I3 + I4 + I5;
    for (int it = gw; it < NITEMS; it += NGW) {
        int r = it;
        if (r < I0) { transpose_item<0>(A.in[I_WIN], D, INW, (bf16_t*)(ws + WS_WIN), A.in[I_N1G], scr, r, lane); continue; } r -= I0;
        if (r < I1) { transpose_item<0>(A.in[I_WKV], D, 1024, (bf16_t*)(ws + WS_WKV), A.in[I_MNG], scr, r, lane); continue; } r -= I1;
        if (r < 3 * I2) { const int z = r / I2; transpose_item<0>(A.in[I_WBR] + (size_t)z * 512 * 1024, 512, 1024, (bf16_t*)(ws + WS_WBR) + (size_t)z * 1024 * 512, nullptr, scr, r % I2, lane); continue; } r -= 3 * I2;
        if (r < I3) { transpose_item<0>(A.in[I_WOUT], D, D, (bf16_t*)(ws + WS_WO), nullptr, scr, r, lane); continue; } r -= I3;
        if (r < I4) { transpose_item<1>(A.in[I_WUP], D, NUP, (bf16_t*)(ws + WS_WUP), A.in[I_N2G], scr, r, lane); continue; } r -= I4;
        transpose_item<0>(A.in[I_WDN], DFF, D, (bf16_t*)(ws + WS_WD), nullptr, scr, r, lane);
    }
    for (int m = 4 * gw; m < M; m += 4 * NGW) rows4_to_bf16(A.in[I_X], (bf16_t*)(ws + WS_XB), (float*)(ws + WS_RS1), m, lane);
    for (int m = 4 * gw; m < MEMROWS; m += 4 * NGW) rows4_to_bf16(A.in[I_MEM], (bf16_t*)(ws + WS_MEMB), (float*)(ws + WS_RSM), m, lane);
    for (int i = blockIdx.x * 512 + tid; i < 2 * M; i += gridDim.x * 512) ((float*)(ws + WS_SSQ2))[i] = 0.f;
}

struct ProbP1 { int K, lda, ldb; const bf16_t *xb, *memb, *win, *wkv;
    __device__ __forceinline__ const char* a(const Unit& u) const { return (const char*)((u.z ? memb : xb) + (size_t)u.pm * 256 * 1024); }
    __device__ __forceinline__ const char* b(const Unit& u) const { return (const char*)((u.z ? wkv : win) + (size_t)u.pn * 256 * 1024); } };
struct SchedP1 { int G, c;
    __device__ __forceinline__ bool next(int i, Unit& u) const { int L = i * G + c; if (L < 3328) { pg8::tile_map(L, 128, 26, u); u.z = 0; return true; } L -= 3328; if (L >= 64) return false; u.pm = L & 15; u.pn = L >> 4; u.z = 1; return true; } };
template <int MODE> __device__ __forceinline__ void p1_store(const f32x4 (&acc)[2][2][4][2], const float* rs, int row0, bf16_t* dst, int ldc, int col0, float sc, const float* lbl, int lcol0) {
    float lb[2][8];
    if (MODE == 4) {
#pragma unroll
        for (int bj = 0; bj < 2; ++bj)
#pragma unroll
            for (int j = 0; j < 8; ++j) { const int c = lcol0 + bj * 128 + j; lb[bj][j] = fsigmoid(lbl[c] - lbl[512 + c]); }
    }
#pragma unroll
    for (int ai = 0; ai < 2; ++ai)
#pragma unroll
        for (int m = 0; m < 4; ++m) { const int row = row0 + ai * 128 + m * 16; const float r = rs[row]; bf16_t* rowp = dst + (size_t)row * ldc + col0;
#pragma unroll
            for (int bj = 0; bj < 2; ++bj) { float v[8];
#pragma unroll
                for (int j = 0; j < 8; ++j) { float x = acc[ai][bj][m][j >> 2][j & 3] * r;
                    if (MODE == 0) x *= sc; if (MODE == 1) x = fgelu(x); if (MODE == 2) x = fsilu(x); if (MODE == 3) x = fsigmoid(x);
                    if (MODE == 4) { const float fg = lb[bj][j] + (1.0f - lb[bj][j]) * fsigmoid(x); x = __logf(fg); }
                    v[j] = x; }
                u32x4 w;
                if (MODE == 4) { w.x = pkh2(v[0], v[1]); w.y = pkh2(v[2], v[3]); w.z = pkh2(v[4], v[5]); w.w = pkh2(v[6], v[7]); }
                else { w.x = pk2(v[0], v[1]); w.y = pk2(v[2], v[3]); w.z = pk2(v[4], v[5]); w.w = pk2(v[6], v[7]); }
                *(u32x4*)(rowp + bj * 128) = w; } }
}
struct EpiP1 { static constexpr bool PERM = true;
    const float *rs1, *rsm, *lbl; bf16_t *U, *V, *HQ, *HF, *HI, *HG, *XQ, *GATES, *KV;
    __device__ __forceinline__ bool operator()(f32x4 (&acc)[2][2][4][2], const Unit& u, int wr, int wc, int fr, int fq) const {
        const int row0 = u.pm * 256 + wr * 64 + fr, cw = wc * 32 + 8 * fq;
        if (u.z) { p1_store<0>(acc, rsm, row0, KV, 1024, u.pn * 256 + cw, 1.0f, nullptr, 0); return false; }
        const int seg = u.pn >> 1, col0 = (u.pn & 1) * 256 + cw;
        if (u.pn >= 14) { p1_store<3>(acc, rs1, row0, GATES, 3072, (u.pn - 14) * 256 + cw, 1.f, nullptr, 0); return false; }
        switch (seg) {
            case 0: p1_store<1>(acc, rs1, row0, U, 512, col0, 1.f, nullptr, 0); break;
            case 1: p1_store<1>(acc, rs1, row0, V, 512, col0, 1.f, nullptr, 0); break;
            case 2: p1_store<2>(acc, rs1, row0, HQ, 512, col0, 1.f, nullptr, 0); break;
            case 3: p1_store<4>(acc, rs1, row0, HF, 512, col0, 1.f, lbl, col0); break;
            case 4: p1_store<0>(acc, rs1, row0, HI, 512, col0, 1.f, nullptr, 0); break;
            case 5: p1_store<2>(acc, rs1, row0, HG, 512, col0, 1.f, nullptr, 0); break;
            default: p1_store<0>(acc, rs1, row0, XQ, 512, col0, 0.08838834764831845f * 1.4426950408889634f, nullptr, 0); break;
        }
        return false;
    }
};

__device__ __forceinline__ void attn_item(int item, const bf16_t* XQ, const bf16_t* KV, bf16_t* COUT, LAS unsigned char* lds) {
    const int tid = threadIdx.x, lane = tid & 63, wave = tid >> 6, g = lane >> 4, l15 = lane & 15;
    const int qt = item & 15, h = (item >> 4) & 3, b = item >> 6;
    LAS bf16_t* Ks = (LAS bf16_t*)lds; LAS bf16_t* Vs = Ks + 256 * 144;
#pragma unroll
    for (int i = 0; i < 8; ++i) { const int idx = tid + 512 * i, row = idx >> 4, ch = idx & 15;
        const bf16_t* src = KV + (size_t)(b * 256 + row) * 1024 + h * 128 + ch * 8;
        *(LAS u32x4*)(Ks + row * 144 + ch * 8) = *(const u32x4*)src; *(LAS u32x4*)(Vs + row * 144 + ch * 8) = *(const u32x4*)(src + 512); }
    const int t = b * SEQ + qt * 128 + wave * 16 + l15;
#if DBG_ATTN_COPY
    { __syncthreads(); const int rr = tid >> 2, cc = (tid & 3) * 32; const size_t o = (size_t)(b * SEQ + qt * 128 + rr) * 512 + h * 128 + cc;
      for (int e = 0; e < 4; ++e) *(u32x4*)(COUT + o + 8 * e) = *(const u32x4*)(KV + (size_t)((b * 256 + ((qt * 128 + rr) & 255))) * 1024 + (qt & 1) * 512 + h * 128 + cc + 8 * e);
      __syncthreads(); return; }
#endif
    bf16x8 Qf[4];
#pragma unroll
    for (int ks = 0; ks < 4; ++ks) Qf[ks] = *(const bf16x8*)(XQ + (size_t)t * 512 + h * 128 + 32 * ks + 8 * g);
    __syncthreads();
    f32x4 s[16];
#pragma unroll
    for (int i = 0; i < 16; ++i) { s[i] = (f32x4){0.f, 0.f, 0.f, 0.f};
#pragma unroll
        for (int ks = 0; ks < 4; ++ks) { const bf16x8 a = *(const LAS bf16x8*)(Ks + (16 * i + l15) * 144 + 32 * ks + 8 * g); s[i] = MFMA_BF16(a, Qf[ks], s[i]); } }
    float mx = -3.0e38f;
#pragma unroll
    for (int i = 0; i < 16; ++i) mx = fmaxf(fmaxf(fmaxf(s[i][0], s[i][1]), fmaxf(s[i][2], s[i][3])), mx);
    mx = fmaxf(mx, __shfl_xor(mx, 16)); mx = fmaxf(mx, __shfl_xor(mx, 32));
    float sum = 0.f;
#pragma unroll
    for (int i = 0; i < 16; ++i)
#pragma unroll
        for (int r = 0; r < 4; ++r) { const float p = __builtin_amdgcn_exp2f(s[i][r] - mx); s[i][r] = p; sum += p; }
    sum += __shfl_xor(sum, 16); sum += __shfl_xor(sum, 32);
    const float inv = 1.0f / sum;
    bf16x8 Pf[8];
#pragma unroll
    for (int kk = 0; kk < 8; ++kk) { u32x4 w; w.x = pk2(s[2 * kk][0] * inv, s[2 * kk][1] * inv); w.y = pk2(s[2 * kk][2] * inv, s[2 * kk][3] * inv);
        w.z = pk2(s[2 * kk + 1][0] * inv, s[2 * kk + 1][1] * inv); w.w = pk2(s[2 * kk + 1][2] * inv, s[2 * kk + 1][3] * inv); Pf[kk] = __builtin_bit_cast(bf16x8, w); }
    bf16_t* orow = COUT + (size_t)t * 512 + h * 128 + 4 * g;
#pragma unroll
    for (int dt = 0; dt < 8; ++dt) { f32x4 o = (f32x4){0.f, 0.f, 0.f, 0.f};
#pragma unroll
        for (int kk = 0; kk < 8; ++kk) { const bf16x8 a = tr8(Vs, 144, 32 * kk, 16 * dt, lane); o = MFMA_BF16(a, Pf[kk], o); }
        *(u32x2*)(orow + 16 * dt) = (u32x2){pk2(o[0], o[1]), pk2(o[2], o[3])}; }
    __syncthreads();
}
__device__ __forceinline__ void sgu_item(int item, const bf16_t* U, const bf16_t* V, const float* lng, const float* lnb, const float* wsp, const float* bsp, bf16_t* AOUT, LAS unsigned char* lds) {
    const int tid = threadIdx.x, lane = tid & 63, wave = tid >> 6, g = lane >> 4, l15 = lane & 15;
    const int t0 = item * 128;
    LAS bf16_t* vn = (LAS bf16_t*)lds;
    { float gg[8], bb[8];
#pragma unroll
      for (int j = 0; j < 8; ++j) { gg[j] = lng[8 * lane + j]; bb[j] = lnb[8 * lane + j]; }
#pragma unroll 4
      for (int i = 0; i < 16; ++i) { const int srow = wave * 16 + i; const u32x4 w = *(const u32x4*)(V + (size_t)(t0 + srow) * 512 + 8 * lane);
        float v[8] = {bflo(w.x), bfhi(w.x), bflo(w.y), bfhi(w.y), bflo(w.z), bfhi(w.z), bflo(w.w), bfhi(w.w)};
        float s = 0.f;
#pragma unroll
        for (int j = 0; j < 8; ++j) s += v[j];
        const float mu = wave_sum(s) * (1.0f / 512.0f); float q = 0.f;
#pragma unroll
        for (int j = 0; j < 8; ++j) { v[j] -= mu; q += v[j] * v[j]; }
        const float rstd = 1.0f / sqrtf(wave_sum(q) * (1.0f / 512.0f) + EPS);
#pragma unroll
        for (int j = 0; j < 8; ++j) v[j] = v[j] * rstd * gg[j] + bb[j];
        *(LAS u32x4*)(vn + srow * 528 + 8 * lane) = (u32x4){pk2(v[0], v[1]), pk2(v[2], v[3]), pk2(v[4], v[5]), pk2(v[6], v[7])}; } }
    __syncthreads();
    const int tl = wave * 16 + l15, nks = (wave >> 1) + 1;
#pragma unroll 1
    for (int g4 = 0; g4 < 4; ++g4) {
        bf16x8 Wf[4];
#pragma unroll
        for (int ks = 0; ks < 4; ++ks) { Wf[ks] = (bf16x8){0, 0, 0, 0, 0, 0, 0, 0};
            if (ks < nks) { const float* wp = wsp + (size_t)(g4 * 128 + tl) * 128 + 32 * ks + 4 * g; const f32x4 w0 = *(const f32x4*)wp, w1 = *(const f32x4*)(wp + 16);
                const int s0 = 32 * ks + 4 * g, s1 = s0 + 16; float e[8];
#pragma unroll
                for (int j = 0; j < 4; ++j) { e[j] = (s0 + j <= tl) ? w0[j] : 0.f; e[4 + j] = (s1 + j <= tl) ? w1[j] : 0.f; }
                const u32x4 w = (u32x4){pk2(e[0], e[1]), pk2(e[2], e[3]), pk2(e[4], e[5]), pk2(e[6], e[7])}; Wf[ks] = __builtin_bit_cast(bf16x8, w); } }
        const float bias = bsp[g4 * 128 + tl];
#pragma unroll
        for (int ct = 0; ct < 8; ++ct) { const int c0 = g4 * 128 + 16 * ct; f32x4 acc = (f32x4){0.f, 0.f, 0.f, 0.f};
#pragma unroll
            for (int ks = 0; ks < 4; ++ks) if (ks < nks) { const bf16x8 a = tr8(vn, 528, 32 * ks, c0, lane); acc = MFMA_BF16(a, Wf[ks], acc); }
            const size_t o = (size_t)(t0 + tl) * 512 + c0 + 4 * g; const u32x2 uw = *(const u32x2*)(U + o);
            *(u32x2*)(AOUT + o) = (u32x2){pk2(bflo(uw.x) * (acc[0] + bias), bfhi(uw.x) * (acc[1] + bias)), pk2(bflo(uw.y) * (acc[2] + bias), bfhi(uw.y) * (acc[3] + bias))}; }
    }
    __syncthreads();
}
constexpr int H_LF = 0, H_A = 18432, H_T0 = 52224, H_T1 = 70656, H_T2 = 89088, H_VS = 107520, H_RED = 125952;
__device__ __forceinline__ void hgrn_load_cumsum(int t0, int cb, const bf16_t* HF, const bf16_t* HI, LAS unsigned char* lds) {
    const int tid = threadIdx.x, lane = tid & 63, wave = tid >> 6, g = lane >> 4, l15 = lane & 15;
    LAS bf16_t* LF = (LAS bf16_t*)(lds + H_LF); LAS bf16_t* VS = (LAS bf16_t*)(lds + H_VS); LAS float* A_ = (LAS float*)(lds + H_A);
#pragma unroll
    for (int i = 0; i < 2; ++i) { const int idx = tid + 512 * i, row = idx >> 4, ch = idx & 15; const size_t o = (size_t)(t0 + row) * 512 + cb + ch * 8;
        *(LAS u32x4*)(LF + row * 144 + ch * 8) = *(const u32x4*)(HF + o); *(LAS u32x4*)(VS + row * 144 + ch * 8) = *(const u32x4*)(HI + o); }
    __syncthreads();
    f16x8 Bf[2];
#pragma unroll
    for (int ks = 0; ks < 2; ++ks) Bf[ks] = __builtin_bit_cast(f16x8, tr8(LF, 144, 32 * ks, 16 * wave, lane));
#pragma unroll
    for (int tt = 0; tt < 4; ++tt) { f32x4 acc = (f32x4){0.f, 0.f, 0.f, 0.f}; const int t = 16 * tt + l15;
#pragma unroll
        for (int ks = 0; ks < 2; ++ks) { f16x8 a;
#pragma unroll
            for (int j = 0; j < 8; ++j) { const int s = 32 * ks + 4 * g + (j & 3) + 16 * (j >> 2); a[j] = (s <= t) ? (_Float16)1.0f : (_Float16)0.0f; }
            acc = __builtin_amdgcn_mfma_f32_16x16x32_f16(a, Bf[ks], acc, 0, 0, 0); }
#pragma unroll
        for (int r = 0; r < 4; ++r) A_[(16 * tt + 4 * g + r) * 132 + 16 * wave + l15] = acc[r]; }
    __syncthreads();
}
__device__ __forceinline__ float h2f(unsigned short h) { return (float)__builtin_bit_cast(_Float16, h); }
__device__ __forceinline__ void hgrn1_item(int item, const bf16_t* HF, const bf16_t* HI, bf16_t* GS, float* HD, LAS unsigned char* lds) {
    const int tid = threadIdx.x, lane = tid & 63, wave = tid >> 6, g = lane >> 4, l15 = lane & 15;
    const int n = item & 31, bh = item >> 5, h = bh & 3, b = bh >> 2, t0 = b * SEQ + n * 64, cb = h * 128;
    hgrn_load_cumsum(t0, cb, HF, HI, lds);
    LAS bf16_t* LF = (LAS bf16_t*)(lds + H_LF); LAS bf16_t* VS = (LAS bf16_t*)(lds + H_VS); LAS float* A_ = (LAS float*)(lds + H_A); LAS bf16_t* KD = (LAS bf16_t*)(lds + H_T0);
    { const int t = tid >> 3, kc = (tid & 7) * 16; unsigned w[8];
#pragma unroll
      for (int e = 0; e < 16; e += 2) { float o[2];
#pragma unroll
        for (int d = 0; d < 2; ++d) { const int kk = kc + e + d; const float a = A_[t * 132 + kk], al = A_[63 * 132 + kk], lf = h2f(LF[t * 144 + kk]); o[d] = (1.0f - fexp(lf)) * fexp(al - a); }
        w[e >> 1] = pk2(o[0], o[1]); }
      *(LAS u32x4*)(KD + t * 144 + kc) = (u32x4){w[0], w[1], w[2], w[3]}; *(LAS u32x4*)(KD + t * 144 + kc + 8) = (u32x4){w[4], w[5], w[6], w[7]};
      if (tid < 128) HD[(size_t)item * 128 + tid] = fexp(A_[63 * 132 + tid]); }
    __syncthreads();
    bf16x8 Af[2];
#pragma unroll
    for (int ks = 0; ks < 2; ++ks) Af[ks] = tr8(KD, 144, 32 * ks, 16 * wave, lane);
    bf16_t* gp = GS + (size_t)item * 16384 + 16 * wave + 4 * g;
#pragma unroll
    for (int vt = 0; vt < 8; ++vt) { f32x4 acc = (f32x4){0.f, 0.f, 0.f, 0.f};
#pragma unroll
        for (int ks = 0; ks < 2; ++ks) { const bf16x8 bb = tr8(VS, 144, 32 * ks, 16 * vt, lane); acc = MFMA_BF16(Af[ks], bb, acc); }
        *(u32x2*)(gp + (size_t)(16 * vt + l15) * 128) = (u32x2){pk2(acc[0], acc[1]), pk2(acc[2], acc[3])}; }
    __syncthreads();
}
__device__ __forceinline__ void hgrn2_scan(bf16_t* GS, const float* HD) {
    for (int gid = blockIdx.x * 512 + threadIdx.x; gid < 64 * 2048; gid += gridDim.x * 512) {
        const int bh = gid >> 11, e8 = gid & 2047, kk0 = (8 * e8) & 127;
        float S[8] = {0.f, 0.f, 0.f, 0.f, 0.f, 0.f, 0.f, 0.f};
#pragma unroll 4
        for (int n = 0; n < 32; ++n) { const int item = bh * 32 + n; u32x4* p = (u32x4*)(GS + (size_t)item * 16384 + 8 * e8);
            const u32x4 gw = *p; const f32x4 d0 = *(const f32x4*)(HD + (size_t)item * 128 + kk0), d1 = *(const f32x4*)(HD + (size_t)item * 128 + kk0 + 4);
            *p = (u32x4){pk2(S[0], S[1]), pk2(S[2], S[3]), pk2(S[4], S[5]), pk2(S[6], S[7])};
            S[0] = d0[0] * S[0] + bflo(gw.x); S[1] = d0[1] * S[1] + bfhi(gw.x); S[2] = d0[2] * S[2] + bflo(gw.y); S[3] = d0[3] * S[3] + bfhi(gw.y);
            S[4] = d1[0] * S[4] + bflo(gw.z); S[5] = d1[1] * S[5] + bfhi(gw.z); S[6] = d1[2] * S[6] + bflo(gw.w); S[7] = d1[3] * S[7] + bfhi(gw.w); }
    }
}
__device__ __forceinline__ void hgrn3_item(int item, const bf16_t* HQ, const bf16_t* HF, const bf16_t* HI, const bf16_t* HG, const bf16_t* GS, const float* ng, bf16_t* BOUT, LAS unsigned char* lds) {
    const int tid = threadIdx.x, lane = tid & 63, wave = tid >> 6, g = lane >> 4, l15 = lane & 15;
    const int n = item & 31, bh = item >> 5, h = bh & 3, b = bh >> 2, t0 = b * SEQ + n * 64, cb = h * 128;
    hgrn_load_cumsum(t0, cb, HF, HI, lds);
    LAS bf16_t* LF = (LAS bf16_t*)(lds + H_LF); LAS bf16_t* VS = (LAS bf16_t*)(lds + H_VS); LAS float* A_ = (LAS float*)(lds + H_A);
    LAS bf16_t* QI = (LAS bf16_t*)(lds + H_T0); LAS bf16_t* QE = (LAS bf16_t*)(lds + H_T1); LAS bf16_t* KE = (LAS bf16_t*)(lds + H_T2); LAS float* RED = (LAS float*)(lds + H_RED);
    { const int t = tid >> 3, kc = (tid & 7) * 16; unsigned wi[8], we[8], wk[8];
      const u32x4 q0 = *(const u32x4*)(HQ + (size_t)(t0 + t) * 512 + cb + kc), q1 = *(const u32x4*)(HQ + (size_t)(t0 + t) * 512 + cb + kc + 8);
      const unsigned qw[8] = {q0.x, q0.y, q0.z, q0.w, q1.x, q1.y, q1.z, q1.w};
#pragma unroll
      for (int e = 0; e < 16; e += 2) { float oi[2], oe[2], ok[2];
#pragma unroll
        for (int d = 0; d < 2; ++d) { const int kk = kc + e + d; const float a = A_[t * 132 + kk], am = A_[31 * 132 + kk], lf = h2f(LF[t * 144 + kk]);
            const float q = d ? bfhi(qw[e >> 1]) : bflo(qw[e >> 1]);
            oi[d] = q * fexp(a); oe[d] = q * fexp(a - am); ok[d] = (1.0f - fexp(lf)) * fexp(am - a); }
        wi[e >> 1] = pk2(oi[0], oi[1]); we[e >> 1] = pk2(oe[0], oe[1]); wk[e >> 1] = pk2(ok[0], ok[1]); }
      *(LAS u32x4*)(QI + t * 144 + kc) = (u32x4){wi[0], wi[1], wi[2], wi[3]}; *(LAS u32x4*)(QI + t * 144 + kc + 8) = (u32x4){wi[4], wi[5], wi[6], wi[7]};
      *(LAS u32x4*)(QE + t * 144 + kc) = (u32x4){we[0], we[1], we[2], we[3]}; *(LAS u32x4*)(QE + t * 144 + kc + 8) = (u32x4){we[4], we[5], we[6], we[7]};
      *(LAS u32x4*)(KE + t * 144 + kc) = (u32x4){wk[0], wk[1], wk[2], wk[3]}; *(LAS u32x4*)(KE + t * 144 + kc + 8) = (u32x4){wk[4], wk[5], wk[6], wk[7]}; }
    __syncthreads();
    const int tt = wave & 3, vh = wave >> 2, tl = 16 * tt + l15;
    f32x4 P[4];
#pragma unroll
    for (int si = 0; si < 4; ++si) { P[si] = (f32x4){0.f, 0.f, 0.f, 0.f};
        if (si <= tt) {
#pragma unroll
            for (int ks = 0; ks < 4; ++ks) { const bf16x8 a = *(const LAS bf16x8*)(KE + (16 * si + l15) * 144 + 32 * ks + 8 * g), bb = *(const LAS bf16x8*)(QE + tl * 144 + 32 * ks + 8 * g); P[si] = MFMA_BF16(a, bb, P[si]); }
            if (si == tt) {
#pragma unroll
                for (int r = 0; r < 4; ++r) if (4 * g + r > l15) P[si][r] = 0.f; } } }
    bf16x8 Pf[2];
#pragma unroll
    for (int k2 = 0; k2 < 2; ++k2) { const u32x4 w = (u32x4){pk2(P[2 * k2][0], P[2 * k2][1]), pk2(P[2 * k2][2], P[2 * k2][3]), pk2(P[2 * k2 + 1][0], P[2 * k2 + 1][1]), pk2(P[2 * k2 + 1][2], P[2 * k2 + 1][3])}; Pf[k2] = __builtin_bit_cast(bf16x8, w); }
    bf16x8 Qf[4];
#pragma unroll
    for (int ks = 0; ks < 4; ++ks) Qf[ks] = *(const LAS bf16x8*)(QI + tl * 144 + 32 * ks + 8 * g);
    const bf16_t* ST = GS + (size_t)item * 16384;
    f32x4 o[4]; float ssq = 0.f;
#pragma unroll
    for (int vt = 0; vt < 4; ++vt) { const int vd0 = 64 * vh + 16 * vt; o[vt] = (f32x4){0.f, 0.f, 0.f, 0.f};
#pragma unroll
        for (int k2 = 0; k2 < 2; ++k2) if (2 * k2 <= tt) { const bf16x8 a = tr8(VS, 144, 32 * k2, vd0, lane); o[vt] = MFMA_BF16(a, Pf[k2], o[vt]); }
#pragma unroll
        for (int ks = 0; ks < 4; ++ks) { const bf16x8 a = *(const bf16x8*)(ST + (size_t)(vd0 + l15) * 128 + 32 * ks + 8 * g); o[vt] = MFMA_BF16(a, Qf[ks], o[vt]); }
        ssq += (o[vt][0] * o[vt][0] + o[vt][1] * o[vt][1]) + (o[vt][2] * o[vt][2] + o[vt][3] * o[vt][3]); }
    ssq += __shfl_xor(ssq, 16); ssq += __shfl_xor(ssq, 32);
    if (g == 0) RED[vh * 64 + tl] = ssq;
    __syncthreads();
    const float rstd = 1.0f / sqrtf((RED[tl] + RED[64 + tl]) * (1.0f / 128.0f) + EPS);
#pragma unroll
    for (int vt = 0; vt < 4; ++vt) { const int vd = 64 * vh + 16 * vt + 4 * g; const size_t off = (size_t)(t0 + tl) * 512 + cb + vd;
        const u32x2 gw = *(const u32x2*)(HG + off); const f32x4 nw = *(const f32x4*)(ng + vd);
        *(u32x2*)(BOUT + off) = (u32x2){pk2(o[vt][0] * rstd * nw[0] * bflo(gw.x), o[vt][1] * rstd * nw[1] * bfhi(gw.x)), pk2(o[vt][2] * rstd * nw[2] * bflo(gw.y), o[vt][3] * rstd * nw[3] * bfhi(gw.y))}; }
    __syncthreads();
}

struct ProbP3 { int K, lda, ldb; const bf16_t *br, *wbr;
    __device__ __forceinline__ const char* a(const Unit& u) const { return (const char*)(br + (size_t)u.z * M * 512 + (size_t)u.pm * 256 * 512); }
    __device__ __forceinline__ const char* b(const Unit& u) const { return (const char*)(wbr + (size_t)u.z * 1024 * 512 + (size_t)u.pn * 256 * 512); } };
struct SchedP3 { int G, c;
    __device__ __forceinline__ bool next(int i, Unit& u) const { const int L = (i / 3) * G + c; if (L >= 512) return false; pg8::tile_map(L, 128, 4, u); u.z = i % 3; return true; } };
struct EpiP3 { static constexpr bool PERM = true; const bf16_t* GATES; bf16_t* MERGED;
    __device__ __forceinline__ bool operator()(f32x4 (&acc)[2][2][4][2], const Unit& u, int wr, int wc, int fr, int fq) const {
        const int row0 = u.pm * 256 + wr * 64 + fr, col0 = u.pn * 256 + wc * 32 + 8 * fq;
#pragma unroll
        for (int ai = 0; ai < 2; ++ai)
#pragma unroll
            for (int m = 0; m < 4; ++m) { const int row = row0 + ai * 128 + m * 16;
#pragma unroll
                for (int bj = 0; bj < 2; ++bj) { const bf16_t* gp = GATES + (size_t)row * 3072 + u.z * 1024 + col0 + bj * 128;
                    const u32x4 g0 = *(const u32x4*)gp; float f[8] = {bflo(g0.x), bfhi(g0.x), bflo(g0.y), bfhi(g0.y), bflo(g0.z), bfhi(g0.z), bflo(g0.w), bfhi(g0.w)};
                    if (u.z < 2) { const u32x4 g1 = *(const u32x4*)(gp + 1024); const float d[8] = {bflo(g1.x), bfhi(g1.x), bflo(g1.y), bfhi(g1.y), bflo(g1.z), bfhi(g1.z), bflo(g1.w), bfhi(g1.w)};
#pragma unroll
                        for (int j = 0; j < 8; ++j) f[j] = f[j] / fmaxf(d[j], 1e-30f); }
#pragma unroll
                    for (int j = 0; j < 8; ++j) acc[ai][bj][m][j >> 2][j & 3] *= f[j];
                    if (u.z == 2) { const f32x4 v0 = acc[ai][bj][m][0], v1 = acc[ai][bj][m][1];
                        *(u32x4*)(MERGED + (size_t)row * 1024 + col0 + bj * 128) = (u32x4){pk2(v0[0], v0[1]), pk2(v0[2], v0[3]), pk2(v1[0], v1[1]), pk2(v1[2], v1[3])}; } } }
        return u.z < 2;
    }
};

struct ProbN { int K, lda, ldb; const bf16_t *A_, *B_;
    __device__ __forceinline__ const char* a(const Unit& u) const { return (const char*)(A_ + (size_t)u.pm * 256 * lda); }
    __device__ __forceinline__ const char* b(const Unit& u) const { return (const char*)(B_ + (size_t)u.pn * 256 * ldb); } };
struct SchedN { int G, c, nM, nN, rep = 1;
    __device__ __forceinline__ bool next(int i, Unit& u) const { const int nwg = nM * nN, cnt = (nwg - c + G - 1) / G; if (i >= rep * cnt) return false; const int L = (i % cnt) * G + c; pg8::tile_map(L, nM, nN, u); u.z = 0; return true; } };
template <bool WB> struct EpiRes { static constexpr bool PERM = false; const float* base; float* out; bf16_t* ob; float* ssq; int nofn = 0;
    __device__ __forceinline__ bool operator()(f32x4 (&acc)[2][2][4][2], const Unit& u, int wr, int wc, int fr, int fq) const {
        const int row0 = u.pm * 256 + wr * 64 + fr, col0 = u.pn * 256 + wc * 32 + 4 * fq;
#pragma unroll
        for (int ai = 0; ai < 2; ++ai)
#pragma unroll
            for (int m = 0; m < 4; ++m) { const int row = row0 + ai * 128 + m * 16; const size_t off = (size_t)row * 1024 + col0; float s = 0.f;
#pragma unroll
                for (int bj = 0; bj < 2; ++bj)
#pragma unroll
                    for (int n = 0; n < 2; ++n) { f32x4 v = *(const f32x4*)(base + off + bj * 128 + n * 16); if (!nofn) v = v + acc[ai][bj][m][n];
                        *(f32x4*)(out + off + bj * 128 + n * 16) = v; s += (v[0] * v[0] + v[1] * v[1]) + (v[2] * v[2] + v[3] * v[3]);
                        if (WB) *(u32x2*)(ob + off + bj * 128 + n * 16) = (u32x2){pk2(v[0], v[1]), pk2(v[2], v[3])}; }
                s += __shfl_xor(s, 16); s += __shfl_xor(s, 32);
                if (fq == 0) atomicAdd(ssq + row, s); }
        return false;
    }
};

struct EpiP5 { static constexpr bool PERM = true; const float *ssq2, *cw, *cbias; bf16_t* ACT; float *HALO, *TOPA, *TOPB;
    __device__ __forceinline__ bool operator()(f32x4 (&acc)[2][2][4][2], const Unit& u, int wr, int wc, int fr, int fq) const {
        const int lane = threadIdx.x & 63;
        const int ch0 = u.pn * 128 + wc * 32 + 8 * fq;
        float w0[8], w1[8], w2[8], cb[8];
#pragma unroll
        for (int j = 0; j < 8; ++j) { w0[j] = cw[ch0 + j]; w1[j] = cw[DFF + ch0 + j]; w2[j] = cw[2 * DFF + ch0 + j]; cb[j] = cbias[ch0 + j]; }
        const int src1 = (lane & 48) | ((fr + 15) & 15), src2 = (lane & 48) | ((fr + 14) & 15);
#pragma unroll
        for (int ai = 0; ai < 2; ++ai) {
            const int blk = u.pm * 4 + ai * 2 + wr, rowb = blk * 64;
            float p1[8], p2[8];
#pragma unroll
            for (int j = 0; j < 8; ++j) { p1[j] = 0.f; p2[j] = 0.f; }
#pragma unroll
            for (int m = 0; m < 4; ++m) { const int row = rowb + m * 16 + fr; const float r = 1.0f / sqrtf(ssq2[row] * (1.0f / D) + EPS);
                float a[8], bv[8], r1[8], r2[8];
#pragma unroll
                for (int j = 0; j < 8; ++j) { a[j] = acc[ai][0][m][j >> 2][j & 3] * r; bv[j] = acc[ai][1][m][j >> 2][j & 3] * r; r1[j] = __shfl(a[j], src1); r2[j] = __shfl(a[j], src2); }
                float o[8];
#pragma unroll
                for (int j = 0; j < 8; ++j) { const float am1 = fr >= 1 ? r1[j] : p1[j], am2 = fr >= 2 ? r2[j] : p2[j]; const float cv = cb[j] + w0[j] * am2 + w1[j] * am1 + w2[j] * a[j]; o[j] = fsilu(cv) * bv[j]; p1[j] = r1[j]; p2[j] = r2[j]; }
                if (m > 0 || fr >= 2) *(u32x4*)(ACT + (size_t)row * DFF + ch0) = (u32x4){pk2(o[0], o[1]), pk2(o[2], o[3]), pk2(o[4], o[5]), pk2(o[6], o[7])};
                else { float* ta = TOPA + ((size_t)blk * 2 + fr) * DFF + ch0; float* tb = TOPB + ((size_t)blk * 2 + fr) * DFF + ch0;
                    *(f32x4*)ta = (f32x4){a[0], a[1], a[2], a[3]}; *(f32x4*)(ta + 4) = (f32x4){a[4], a[5], a[6], a[7]}; *(f32x4*)tb = (f32x4){bv[0], bv[1], bv[2], bv[3]}; *(f32x4*)(tb + 4) = (f32x4){bv[4], bv[5], bv[6], bv[7]}; }
                if (m == 3 && fr >= 14) { float* hp = HALO + ((size_t)blk * 2 + (fr - 14)) * DFF + ch0; *(f32x4*)hp = (f32x4){a[0], a[1], a[2], a[3]}; *(f32x4*)(hp + 4) = (f32x4){a[4], a[5], a[6], a[7]}; }
            }
        }
        return false;
    }
};
__device__ __forceinline__ void p6_fix_panel(int pm, const float* HALO, const float* TOPA, const float* TOPB, const float* cw, const float* cbias, bf16_t* ACT) {
    for (int i = threadIdx.x; i < 4 * 2 * DFF; i += 512) { const int ch = i % DFF, lr = (i / DFF) & 1, b4 = i / (2 * DFF), blk = pm * 4 + b4; const bool first = (blk & 31) == 0;
        const float h0 = first ? 0.f : HALO[((size_t)(blk - 1) * 2 + 0) * DFF + ch], h1 = first ? 0.f : HALO[((size_t)(blk - 1) * 2 + 1) * DFF + ch];
        const float t0 = TOPA[((size_t)blk * 2 + 0) * DFF + ch], t1 = TOPA[((size_t)blk * 2 + 1) * DFF + ch];
        const float am2 = lr ? h1 : h0, am1 = lr ? t0 : h1, a0 = lr ? t1 : t0;
        const float cv = cbias[ch] + cw[ch] * am2 + cw[DFF + ch] * am1 + cw[2 * DFF + ch] * a0;
        const float o = fsilu(cv) * TOPB[((size_t)blk * 2 + lr) * DFF + ch];
        ACT[(size_t)(blk * 64 + lr) * DFF + ch] = (bf16_t)(pk2(o, 0.f) & 0xffffu); }
}

__global__ void __launch_bounds__(512, 2) hybrid_fwd(Args A) {
    extern __shared__ __attribute__((aligned(16))) unsigned char lds_raw[];
    LAS unsigned char* lds = (LAS unsigned char*)lds_raw;
    cg::grid_group grid = cg::this_grid();
    unsigned char* ws = A.ws; const int G = gridDim.x, c = blockIdx.x;
    bf16_t* WIN = (bf16_t*)(ws + WS_WIN); bf16_t* WKV = (bf16_t*)(ws + WS_WKV); bf16_t* WBR = (bf16_t*)(ws + WS_WBR); bf16_t* WO = (bf16_t*)(ws + WS_WO); bf16_t* WUP = (bf16_t*)(ws + WS_WUP); bf16_t* WD = (bf16_t*)(ws + WS_WD);
    float* RS1 = (float*)(ws + WS_RS1); float* RSM = (float*)(ws + WS_RSM); float* SSQ2 = (float*)(ws + WS_SSQ2); float* SSQ3 = (float*)(ws + WS_SSQ3); float* HD = (float*)(ws + WS_HD);
    bf16_t* XB = (bf16_t*)(ws + WS_XB); bf16_t* GS = XB; bf16_t* MERGED = XB; bf16_t* MEMB = (bf16_t*)(ws + WS_MEMB); bf16_t* KV = (bf16_t*)(ws + WS_KV);
    bf16_t* HI = (bf16_t*)(ws + WS_HI); bf16_t* HG = (bf16_t*)(ws + WS_HG); bf16_t* XQ = (bf16_t*)(ws + WS_XQ); bf16_t* X1B = HI;
    bf16_t* GATES = (bf16_t*)(ws + WS_GATES); bf16_t* ACT = GATES;
    bf16_t* AOUT = (bf16_t*)(ws + WS_AOUT); bf16_t* BOUT = (bf16_t*)(ws + WS_BOUT); bf16_t* COUT = (bf16_t*)(ws + WS_COUT);
    float* HALO = (float*)(ws + WS_AOUT); float* TOPA = HALO + (size_t)512 * 2 * DFF; float* TOPB = TOPA + (size_t)512 * 2 * DFF;
    bf16_t* U = (bf16_t*)A.out; bf16_t* V = U + (size_t)M * 512; bf16_t* HQ = V + (size_t)M * 512; bf16_t* HF = HQ + (size_t)M * 512;
    const int lo = A.ph_lo, hi = A.ph_hi;
    const unsigned stg = 0u;
#define IN(k) (lo <= (k) && (k) < hi)
#define SEAM(k) do { if (IN(k) && IN((k) + 1)) { if ((k) == 0) grid.sync(); else xcd_barrier(xbar); } } while (0)
    volatile LAS unsigned* xst = (volatile LAS unsigned*)(lds + LDS_BYTES - 16);
    if (threadIdx.x < 4) xst[threadIdx.x] = 0u;
    __syncthreads();
    XcdBarrier xbar; xbar.bar = (unsigned*)(ws + WS_BAR); xbar.x = 0; xbar.st = xst;
    if (hi - lo > 1) xbar = xcd_barrier_post((unsigned*)(ws + WS_BAR), xst);
    if (hi - lo == NPHASE_K) for (int q = 0; q < DBG_XSYNC; ++q) grid.sync();
    if (IN(0)) { p0_prologue(A, lds); if (DBG_DUP == 100) { __syncthreads(); p0_prologue(A, lds); } }
    SEAM(0);
    for (int rep = 0; rep < 1 + (DBG_DUP == 1); ++rep) if (IN(1)) { ProbP1 P{1024, 1024, 1024, XB, MEMB, WIN, WKV}; SchedP1 S{G, c}; EpiP1 E{RS1, RSM, A.in[I_LB], U, V, HQ, HF, HI, HG, XQ, GATES, KV}; pg8::gemm_phase(lds, P, S, E, stg * 650u); }
    SEAM(1);
    for (int rep = 0; rep < 1 + (DBG_DUP == 2); ++rep) if (IN(2)) {
        for (int it = c; it < 2048; it += G) hgrn1_item(it, HF, HI, GS, HD, lds);
        for (int it = c; it < 256; it += G) sgu_item(it, U, V, A.in[I_LNG], A.in[I_LNB], A.in[I_WSP], A.in[I_BSP], AOUT, lds);
        for (int it = c; it < 1024; it += G) attn_item(it, XQ, KV, COUT, lds);
    }
    SEAM(2);
    if (IN(3)) hgrn2_scan(GS, HD);
    SEAM(3);
    for (int rep = 0; rep < 1 + (DBG_DUP == 4); ++rep) if (IN(4)) {
        if (!((DBG_ZERO_MASK >> 1) & 1)) for (int it = c; it < 2048; it += G) hgrn3_item(it, HQ, HF, HI, HG, GS, A.in[I_HNG], BOUT, lds);
        for (int z = 0; z < 3; ++z) if ((DBG_ZERO_MASK >> z) & 1) { u32x4* p = (u32x4*)(AOUT + (size_t)z * M * 512);
            for (size_t i = (size_t)c * 512 + threadIdx.x; i < (size_t)M * 512 / 8; i += (size_t)G * 512) p[i] = (u32x4){0u, 0u, 0u, 0u}; } }
    SEAM(4);
    for (int rep = 0; rep < 1 + (DBG_DUP == 5); ++rep) if (IN(5)) { ProbP3 P{512, 512, 512, AOUT, WBR}; SchedP3 S{G, c}; EpiP3 E{GATES, MERGED}; pg8::gemm_phase(lds, P, S, E, stg * 300u); }
    SEAM(5);
    if (IN(6)) { ProbN P{1024, 1024, 1024, MERGED, WO}; SchedN S{G, c, 128, 4}; EpiRes<true> E{A.in[I_X], A.out, X1B, SSQ2}; pg8::gemm_phase(lds, P, S, E, stg * 400u); }
    SEAM(6);
    for (int rep = 0; rep < 1 + (DBG_DUP == 7); ++rep) if (IN(7)) { ProbN P{1024, 1024, 1024, X1B, WUP}; SchedN S{G, c, 128, 22, DBG_REP5}; EpiP5 E{SSQ2, A.in[I_CW], A.in[I_CB], ACT, HALO, TOPA, TOPB}; pg8::gemm_phase(lds, P, S, E, stg * 650u); }
    SEAM(7);
    if (IN(8)) {
        SchedN S{G, c, 128, 4}; Unit u;
        for (int i = 0; S.next(i, u); ++i) p6_fix_panel(u.pm, HALO, TOPA, TOPB, A.in[I_CW], A.in[I_CB], ACT);
        __threadfence(); __syncthreads();
        ProbN P{DFF, DFF, DFF, ACT, WD}; EpiRes<false> E{A.out, A.out, nullptr, SSQ3}; E.nofn = DBG_NO_FFN; pg8::gemm_phase(lds, P, S, E, stg * 600u);
    }
    SEAM(8);
    if (IN(9)) {
        const int lane = threadIdx.x & 63, gw = c * 8 + (threadIdx.x >> 6), NGW = G * 8; const float* fg = A.in[I_FG];
        f32x4 gv[4];
#pragma unroll
        for (int j = 0; j < 4; ++j) gv[j] = *((const f32x4*)fg + lane + 64 * j);
        for (int m = gw; m < M; m += NGW) { const float r = 1.0f / sqrtf(SSQ3[m] * (1.0f / D) + EPS); f32x4* p = (f32x4*)(A.out + (size_t)m * D) + lane;
#pragma unroll
            for (int j = 0; j < 4; ++j) { f32x4 o = p[64 * j] * r * gv[j];
#if DBG_SANITIZE
                for (int e = 0; e < 4; ++e) if (!(fabsf(o[e]) < 1e30f)) o[e] = 0.f;
#endif
                p[64 * j] = o; } }
    }
#undef IN
#undef SEAM
}

constexpr int NPHASE = 10;
extern "C" void kernel_launch(void* const* d_in, const int* in_sizes, int n_in, void* d_out, int out_size, void* d_ws, size_t ws_size, hipStream_t stream) {
    static int grid = 0;
    if (grid == 0) {
        if (n_in != 20 || out_size != M * D || ws_size < WS_END) { fprintf(stderr, "kernel_launch: unexpected shapes (n_in %d out %d ws %zu)\n", n_in, out_size, ws_size); grid = -1; return; }
        int dev = 0, cus = 0, per_cu = 0;
        hipGetDevice(&dev); hipDeviceGetAttribute(&cus, hipDeviceAttributeMultiprocessorCount, dev);
        hipFuncSetAttribute((const void*)hybrid_fwd, hipFuncAttributeMaxDynamicSharedMemorySize, LDS_BYTES);
        hipOccupancyMaxActiveBlocksPerMultiprocessor(&per_cu, (const void*)hybrid_fwd, 512, LDS_BYTES);
        if (per_cu < 1) { fprintf(stderr, "kernel_launch: occupancy query says %d blocks per CU\n", per_cu); per_cu = 1; }
        (void)hipGetLastError();
        grid = cus * 1;
        if (grid > cus * per_cu) grid = cus * per_cu;
    }
    if (grid <= 0) return;
    Args a{};
    for (int i = 0; i < 20; ++i) a.in[i] = (const float*)d_in[i];
    a.out = (float*)d_out; a.ws = (unsigned char*)d_ws;
#if MK_PER_PHASE
    for (int p = 0; p < NPHASE; ++p) { a.ph_lo = p; a.ph_hi = p + 1; hipLaunchKernelGGL(hybrid_fwd, dim3(grid), dim3(512), LDS_BYTES, stream, a); }
#else
    a.ph_lo = 0; a.ph_hi = NPHASE;
    (void)hipMemsetAsync((unsigned char*)d_ws + WS_BAR, 0, XCD_BAR_WORDS * 4, stream);
    void* args[] = {&a};
    hipError_t e = hipLaunchCooperativeKernel((const void*)hybrid_fwd, dim3(grid), dim3(512), args, LDS_BYTES, stream);
    if (e != hipSuccess) fprintf(stderr, "cooperative launch failed: %s (grid %d)\n", hipGetErrorString(e), grid);
#endif
}
```

```cpp
#include <hip/hip_runtime.h>
#include <hip/hip_cooperative_groups.h>
#include <cstdio>
#include <cstdint>
namespace cg = cooperative_groups;

#define DBG_SANITIZE 0
#define DBG_ATTN_COPY 0
#define DBG_ZERO_MASK 0
#define DBG_NO_FFN 0
#define DBG_REP5 1
#define DBG_XSYNC 0
#define DBG_DUP 0
#ifndef MK_PER_PHASE
#define MK_PER_PHASE 0
#endif

#define LAS __attribute__((address_space(3)))
typedef unsigned short bf16_t;
typedef short bf16x8 __attribute__((ext_vector_type(8)));
typedef short s16x4 __attribute__((ext_vector_type(4)));
typedef _Float16 f16x8 __attribute__((ext_vector_type(8)));
typedef float f32x4 __attribute__((ext_vector_type(4)));
typedef float f32x2 __attribute__((ext_vector_type(2)));
typedef unsigned u32x4 __attribute__((ext_vector_type(4)));
typedef unsigned u32x2 __attribute__((ext_vector_type(2)));

constexpr int M = 32768, D = 1024, SEQ = 2048, INW = 6656, MEMROWS = 4096, MEML = 256, DFF = 2816, NUP = 5632;
constexpr float EPS = 1e-6f;
constexpr size_t MiB = 1u << 20;
constexpr size_t WS_WIN = 0, WS_WKV = 13 * MiB, WS_WBR = 15 * MiB, WS_WO = 18 * MiB, WS_WUP = 20 * MiB, WS_WD = 31 * MiB;
constexpr size_t WS_RS1 = 37 * MiB, WS_RSM = WS_RS1 + 128 * 1024, WS_SSQ2 = WS_RS1 + 256 * 1024, WS_SSQ3 = WS_RS1 + 384 * 1024, WS_HD = 38 * MiB;
constexpr size_t WS_BAR = 39 * MiB;
constexpr size_t WS_XB = 48 * MiB;
constexpr size_t WS_MEMB = 112 * MiB, WS_KV = 120 * MiB;
constexpr size_t WS_HI = 128 * MiB, WS_HG = 160 * MiB, WS_XQ = 192 * MiB;
constexpr size_t WS_GATES = 224 * MiB;
constexpr size_t WS_AOUT = 416 * MiB, WS_BOUT = 448 * MiB, WS_COUT = 480 * MiB;
constexpr size_t WS_END = 512 * MiB;
constexpr int LDS_BYTES = 159744;

typedef __bf16 bf16x2_t __attribute__((ext_vector_type(2)));
__device__ __forceinline__ unsigned pk2(float lo, float hi) { f32x2 v = {lo, hi}; bf16x2_t b = __builtin_convertvector(v, bf16x2_t); return __builtin_bit_cast(unsigned, b); }
__device__ __forceinline__ float bflo(unsigned w) { return __uint_as_float(w << 16); }
__device__ __forceinline__ float bfhi(unsigned w) { return __uint_as_float(w & 0xffff0000u); }
__device__ __forceinline__ float fexp(float x) { return __builtin_amdgcn_exp2f(x * 1.4426950408889634f); }
__device__ __forceinline__ float fsigmoid(float x) { return __builtin_amdgcn_rcpf(1.0f + fexp(-x)); }
__device__ __forceinline__ float fsilu(float x) { return x * fsigmoid(x); }
__device__ __forceinline__ float fgelu(float x) { return x * fsigmoid(1.5957691216057308f * (x + 0.044715f * x * x * x)); }
__device__ __forceinline__ unsigned pkh2(float lo, float hi) { _Float16 a = (_Float16)lo, b = (_Float16)hi; return (unsigned)__builtin_bit_cast(unsigned short, a) | ((unsigned)__builtin_bit_cast(unsigned short, b) << 16); }
__device__ __forceinline__ float wave_sum(float v) {
#pragma unroll
    for (int o = 1; o < 64; o <<= 1) v += __shfl_xor(v, o);
    return v;
}
typedef short v4i16_t __attribute__((ext_vector_type(4)));
__device__ __forceinline__ s16x4 tr4(const LAS bf16_t* p) { return __builtin_bit_cast(s16x4, __builtin_amdgcn_ds_read_tr16_b64_v4i16((LAS v4i16_t*)p)); }
__device__ __forceinline__ bf16x8 tr8(const LAS bf16_t* tile, int P, int k0, int c0, int lane) {
    const int g = lane >> 4, q = (lane & 15) >> 2, p = lane & 3;
    const LAS bf16_t* a = tile + (k0 + 4 * g + q) * P + c0 + 4 * p;
    const s16x4 lo = tr4(a), hi = tr4(a + 16 * P);
    return (bf16x8){lo[0], lo[1], lo[2], lo[3], hi[0], hi[1], hi[2], hi[3]};
}
#define MFMA_BF16(a, b, c) __builtin_amdgcn_mfma_f32_16x16x32_bf16((a), (b), (c), 0, 0, 0)

namespace pg8 {
constexpr int BM = 256, BK = 64, HALF = 128, HTB = HALF * BK * 2, STAGE_BYTES = 8 * HTB, NXCD = 8, WGM = 8;
__host__ __device__ __forceinline__ int lds_byte(int r, int c) { const int st = (r >> 4) * 2 + (c >> 5), rr = r & 15, cc = c & 31, ob = rr * 64 + cc * 2; return st * 1024 + (ob ^ (((ob >> 9) & 1) << 5)); }
__host__ __device__ __forceinline__ void stage_rc(int b, int& R, int& C) { const int st = b / 1024, sb = b % 1024, swz = sb ^ (((sb >> 9) & 1) << 5); R = (st >> 1) * 16 + swz / 64; C = (st & 1) * 32 + (swz % 64) / 2; }
__host__ __device__ __forceinline__ int perm32(int rho) { const int n = rho >> 4, i = rho & 15; return 8 * (i >> 2) + 4 * n + (i & 3); }
struct Unit { int pm, pn, z; };
__device__ __forceinline__ void tile_map(int wgid, int nM, int nN, Unit& u) {
    const int nwg = nM * nN;
    { const int q = nwg / NXCD, r = nwg % NXCD, xcd = wgid % NXCD, off = wgid / NXCD; wgid = (xcd < r ? xcd * (q + 1) : r * (q + 1) + (xcd - r) * q) + off; }
    const int nig = WGM * nN, gid = wgid / nig, fm = gid * WGM, gsz = (nM - fm) < WGM ? (nM - fm) : WGM;
    u.pm = fm + ((wgid % nig) % gsz); u.pn = (wgid % nig) / gsz;
}
template <class Prob, class Epi, class Sched>
__device__ __forceinline__ void gemm_phase(LAS unsigned char* lds, const Prob& Pb, const Sched& S, const Epi& E, unsigned delay = 0) {
    if (delay) { const unsigned long long t0 = __builtin_amdgcn_s_memrealtime(); while (__builtin_amdgcn_s_memrealtime() - t0 < delay) __builtin_amdgcn_s_sleep(8); }
    const int tid = threadIdx.x, wid = __builtin_amdgcn_readfirstlane(tid >> 6), lane = tid & 63, wr = wid >> 2, wc = wid & 3, fr = lane & 15, fq = lane >> 4;
    const int K = Pb.K, nt = K / BK;
    unsigned voffA[2], voffB[2];
#pragma unroll
    for (int i = 0; i < 2; ++i) { int R, C; stage_rc(tid * 16 + i * 8192, R, C); const int Rb = Epi::PERM ? ((R & ~31) + perm32(R & 31)) : R;
        voffA[i] = (unsigned)(R * Pb.lda + C) * 2u; voffB[i] = (unsigned)(Rb * Pb.ldb + C) * 2u; }
    const size_t kstep = (size_t)(BK * 2);
    const size_t hsA = (size_t)HALF * Pb.lda * 2, hsB = (size_t)HALF * Pb.ldb * 2;
    const unsigned ldsw = (unsigned)wid * 1024u;
    const int aoff = lds_byte(wr * 64 + fr, fq * 8), boff = lds_byte(wc * 32 + fr, fq * 8);
#define PG8_SA(b, h) (((b) * 2 + (h)) * HTB)
#define PG8_SB(b, h) ((4 + (b) * 2 + (h)) * HTB)
#define PG8_STAGE(bufoff, gbase, voff) do { _Pragma("unroll") for (int _i = 0; _i < 2; ++_i) \
        __builtin_amdgcn_global_load_lds((const unsigned*)((const char*)(gbase) + (voff)[_i]), (LAS unsigned*)(lds + (bufoff) + ldsw + _i * 8192), 16, 0, 0); } while (0)
#define PG8_LDA(dst, b, h) do { _Pragma("unroll") for (int m = 0; m < 4; ++m) _Pragma("unroll") for (int k = 0; k < 2; ++k) dst[m][k] = *(const LAS bf16x8*)(lds + PG8_SA(b, h) + aoff + m * 2048 + k * 1024); } while (0)
#define PG8_LDB(dst, b, h) do { _Pragma("unroll") for (int n = 0; n < 2; ++n) _Pragma("unroll") for (int k = 0; k < 2; ++k) dst[n][k] = *(const LAS bf16x8*)(lds + PG8_SB(b, h) + boff + n * 2048 + k * 1024); } while (0)
#define PG8_MMA(ai, bj, At, Bt) do { __builtin_amdgcn_s_setprio(1); _Pragma("unroll") for (int m = 0; m < 4; ++m) _Pragma("unroll") for (int n = 0; n < 2; ++n) _Pragma("unroll") for (int k = 0; k < 2; ++k) \
        acc[ai][bj][m][n] = __builtin_amdgcn_mfma_f32_16x16x32_bf16(Bt[n][k], At[m][k], acc[ai][bj][m][n], 0, 0, 0); __builtin_amdgcn_s_setprio(0); } while (0)
#define PG8_WAIT_V(n) asm volatile("s_waitcnt vmcnt(" #n ")" ::: "memory")
#define PG8_WAIT_L(n) asm volatile("s_waitcnt lgkmcnt(" #n ")" ::: "memory")
#define PG8_BAR __builtin_amdgcn_s_barrier()
#define PG8_SCHED __builtin_amdgcn_sched_barrier(0)
    Unit cur, nxt; int ui = 0;
    if (!S.next(0, cur)) return;
    f32x4 acc[2][2][4][2];
#pragma unroll
    for (int a = 0; a < 2; ++a)
#pragma unroll
        for (int b = 0; b < 2; ++b)
#pragma unroll
            for (int m = 0; m < 4; ++m)
#pragma unroll
                for (int n = 0; n < 2; ++n) acc[a][b][m][n] = (f32x4){0.f, 0.f, 0.f, 0.f};
    bf16x8 At[4][2], B0[2][2], B1[2][2];
    const char* cA = Pb.a(cur); const char* cB = Pb.b(cur);
    PG8_STAGE(PG8_SB(0, 0), cB, voffB); PG8_STAGE(PG8_SB(0, 1), cB + hsB, voffB); PG8_STAGE(PG8_SA(0, 0), cA, voffA); PG8_STAGE(PG8_SA(0, 1), cA + hsA, voffA);
    if (wr == 1) PG8_BAR;
    PG8_WAIT_V(2); PG8_BAR;
    PG8_STAGE(PG8_SB(1, 0), cB + kstep, voffB); PG8_STAGE(PG8_SA(1, 0), cA + kstep, voffA); PG8_STAGE(PG8_SB(1, 1), cB + hsB + kstep, voffB);
    PG8_WAIT_V(6); PG8_BAR;
    for (;;) {
        const bool has_next = S.next(ui + 1, nxt);
        const char* nA = has_next ? Pb.a(nxt) : cA; const char* nB = has_next ? Pb.b(nxt) : cB;
        for (int t = 0; t < nt; t += 2) {
            const bool last = (t == nt - 2);
            const char* a1 = cA + (size_t)(t + 1) * kstep;
            const char* a2 = last ? nA : cA + (size_t)(t + 2) * kstep; const char* b2 = last ? nB : cB + (size_t)(t + 2) * kstep;
            const char* a3 = a2 + kstep; const char* b3 = b2 + kstep;
            PG8_LDB(B0, 0, 0); PG8_LDB(B1, 0, 1); PG8_SCHED; PG8_LDA(At, 0, 0); PG8_STAGE(PG8_SA(1, 1), a1 + hsA, voffA);
            PG8_WAIT_V(8); PG8_WAIT_L(0); PG8_BAR; PG8_MMA(0, 0, At, B0); PG8_MMA(0, 1, At, B1); PG8_BAR; PG8_SCHED;
            PG8_LDA(At, 0, 1); PG8_STAGE(PG8_SB(0, 0), b2, voffB); PG8_STAGE(PG8_SB(0, 1), b2 + hsB, voffB); PG8_STAGE(PG8_SA(0, 0), a2, voffA);
            PG8_WAIT_V(8); PG8_WAIT_L(0); PG8_BAR; PG8_MMA(1, 0, At, B0); PG8_MMA(1, 1, At, B1); PG8_BAR; PG8_SCHED;
            PG8_LDB(B0, 1, 0); PG8_LDB(B1, 1, 1); PG8_SCHED; PG8_LDA(At, 1, 0); PG8_STAGE(PG8_SA(0, 1), a2 + hsA, voffA);
            PG8_WAIT_V(8); PG8_WAIT_L(0); PG8_BAR; PG8_MMA(0, 0, At, B0); PG8_MMA(0, 1, At, B1); PG8_BAR; PG8_SCHED;
            PG8_LDA(At, 1, 1); PG8_STAGE(PG8_SB(1, 0), b3, voffB); PG8_STAGE(PG8_SB(1, 1), b3 + hsB, voffB); PG8_STAGE(PG8_SA(1, 0), a3, voffA);
            PG8_WAIT_V(8); PG8_WAIT_L(0); PG8_BAR; PG8_MMA(1, 0, At, B0); PG8_MMA(1, 1, At, B1); PG8_BAR; PG8_SCHED;
        }
        if (wr == 0) PG8_BAR;
        const bool keep = E(acc, cur, wr, wc, fr, fq);
        if (!has_next) break;
        if (!keep) {
#pragma unroll
        for (int a = 0; a < 2; ++a)
#pragma unroll
            for (int b = 0; b < 2; ++b)
#pragma unroll
                for (int m = 0; m < 4; ++m)
#pragma unroll
                    for (int n = 0; n < 2; ++n) acc[a][b][m][n] = (f32x4){0.f, 0.f, 0.f, 0.f};
        }
        cur = nxt; cA = nA; cB = nB; ++ui;
        if (wr == 1) PG8_BAR;
    }
    PG8_WAIT_V(0);
    PG8_BAR;
#undef PG8_SA
#undef PG8_SB
#undef PG8_STAGE
#undef PG8_LDA
#undef PG8_LDB
#undef PG8_MMA
#undef PG8_WAIT_V
#undef PG8_WAIT_L
#undef PG8_BAR
#undef PG8_SCHED
}
}
using pg8::Unit;

#define XB_TMO      128
#define XB_XCNT(j)  (256  + 64 * (j))
#define XB_XSUB(j)  (1280 + 64 * (j))
#define XB_XGEN(j)  (2304 + 64 * (j))
#define XB_TOP      3328
#define XB_TOPGEN   3392
#define XCD_BAR_WORDS 3456
#define XB_SPIN_CAP (1u << 18)
__device__ __forceinline__ unsigned xb_ld(unsigned* p)              { return __hip_atomic_load(p, __ATOMIC_RELAXED, __HIP_MEMORY_SCOPE_AGENT); }
__device__ __forceinline__ unsigned xb_add(unsigned* p, unsigned v) { return __hip_atomic_fetch_add(p, v, __ATOMIC_RELAXED, __HIP_MEMORY_SCOPE_AGENT); }
__device__ __forceinline__ unsigned xb_xcc_id() { return (unsigned)__builtin_amdgcn_s_getreg((3 << 11) | 20) & 0xFu; }
#define XB_SPIN(cond, bar) do { unsigned _sp = 0; while (cond) { __builtin_amdgcn_s_sleep(1); \
    if ((++_sp & 255u) == 0u) { if (xb_ld(&(bar)[XB_TMO])) break; if (_sp > XB_SPIN_CAP) { atomicAdd(&(bar)[XB_TMO], 1u); break; } } } } while (0)
struct XcdBarrier { unsigned* bar; unsigned x; volatile LAS unsigned* st; };
__device__ __forceinline__ XcdBarrier xcd_barrier_post(unsigned* bar, volatile LAS unsigned* st) {
    XcdBarrier b; b.bar = bar; b.x = xb_xcc_id(); b.st = st;
    if (threadIdx.x == 0) (void)xb_add(&bar[XB_XCNT(b.x)], 1u);
    return b;
}
__device__ __forceinline__ void xcd_barrier_complete(unsigned* bar, unsigned x, unsigned& nloc, unsigned& nx) {
    const unsigned G = gridDim.x * gridDim.y * gridDim.z;
    unsigned sum, cnt, mine, sp = 0u;
    for (;;) {
        sum = 0u; cnt = 0u; mine = 0u;
#pragma unroll
        for (unsigned j = 0; j < 16; ++j) { const unsigned c = xb_ld(&bar[XB_XCNT(j)]); sum += c; cnt += (c > 0u) ? 1u : 0u; mine = (j == x) ? c : mine; }
        if (sum == G) break;
        __builtin_amdgcn_s_sleep(1);
        if ((++sp & 255u) == 0u) { if (xb_ld(&bar[XB_TMO])) break; if (sp > XB_SPIN_CAP) { atomicAdd(&bar[XB_TMO], 1u); break; } }
    }
    nloc = mine > 0u ? mine : 1u; nx = cnt > 0u ? cnt : 1u;
}
__device__ __forceinline__ void xcd_barrier(const XcdBarrier& b) {
    asm volatile("s_waitcnt vmcnt(0)" ::: "memory");
    __syncthreads();
    if (threadIdx.x == 0) {
        unsigned* bar = b.bar;
        __builtin_amdgcn_s_waitcnt(0);
        unsigned nloc = b.st[0], nx = b.st[1];
        if (nloc == 0u) { xcd_barrier_complete(bar, b.x, nloc, nx); b.st[0] = nloc; b.st[1] = nx; }
        const unsigned old = xb_add(&bar[XB_XSUB(b.x)], 1u);
        const unsigned gen = old / nloc;
        if (old + 1u == (gen + 1u) * nloc) {
            __builtin_amdgcn_fence(__ATOMIC_RELEASE, "agent");
            asm volatile("s_waitcnt vmcnt(0)" ::: "memory");
            const unsigned og = xb_add(&bar[XB_TOP], 1u);
            const unsigned tg = og / nx;
            if (og + 1u == (tg + 1u) * nx) xb_add(&bar[XB_TOPGEN], 1u);
            else XB_SPIN(xb_ld(&bar[XB_TOPGEN]) == tg, bar);
            __builtin_amdgcn_fence(__ATOMIC_ACQUIRE, "agent");
            xb_add(&bar[XB_XGEN(b.x)], 1u);
            asm volatile("s_waitcnt vmcnt(0)" ::: "memory");
        } else {
            XB_SPIN(xb_ld(&bar[XB_XGEN(b.x)]) == gen, bar);
            __builtin_amdgcn_fence(__ATOMIC_ACQUIRE, "agent");
            asm volatile("s_waitcnt vmcnt(0)" ::: "memory");
        }
    }
    __syncthreads();
}

constexpr int NPHASE_K = 10;
struct Args { const float* in[20]; float* out; unsigned char* ws; int ph_lo, ph_hi; };
enum { I_X = 0, I_MEM, I_N1G, I_WIN, I_LNG, I_LNB, I_WSP, I_BSP, I_LB, I_HNG, I_MNG, I_WKV, I_WBR, I_WOUT, I_N2G, I_WUP, I_CW, I_CB, I_WDN, I_FG };

template <int MAP> __device__ __forceinline__ void transpose_item(const float* W, int K, int N, bf16_t* WT, const float* sk, LAS float* scr, int item, int lane) {
    const int nblk = N / 64, kb = item / nblk, nb = item % nblk, k0 = 64 * kb, n0 = 64 * nb;
    f32x4 v[16];
#pragma unroll
    for (int i = 0; i < 16; ++i) v[i] = *(const f32x4*)(W + (size_t)(k0 + 4 * i + (lane >> 4)) * N + n0 + 4 * (lane & 15));
#pragma unroll
    for (int i = 0; i < 16; ++i) { const int kk = 4 * i + (lane >> 4); f32x4 x = v[i]; if (sk) x = x * sk[k0 + kk]; LAS float* d = scr + kk * 65 + 4 * (lane & 15); d[0] = x[0]; d[1] = x[1]; d[2] = x[2]; d[3] = x[3]; }
    asm volatile("s_waitcnt lgkmcnt(0)" ::: "memory");
    const int c = lane & 7;
    int r0 = n0;
    if (MAP == 1) { const int half = n0 >= DFF, ch = n0 - half * DFF; r0 = 256 * (ch >> 7) + 128 * half + (ch & 127); }
#pragma unroll
    for (int j = 0; j < 8; ++j) { const int n = (lane >> 3) + 8 * j; const LAS float* p = scr + (8 * c) * 65 + n;
        u32x4 o; o.x = pk2(p[0 * 65], p[1 * 65]); o.y = pk2(p[2 * 65], p[3 * 65]); o.z = pk2(p[4 * 65], p[5 * 65]); o.w = pk2(p[6 * 65], p[7 * 65]);
        *(u32x4*)(WT + (size_t)(r0 + n) * K + k0 + 8 * c) = o; }
    asm volatile("s_waitcnt lgkmcnt(0)" ::: "memory");
}
__device__ __forceinline__ void rows4_to_bf16(const float* x, bf16_t* o, float* rs, int m0, int lane) {
    f32x4 v[4][4];
#pragma unroll
    for (int r = 0; r < 4; ++r)
#pragma unroll
        for (int j = 0; j < 4; ++j) v[r][j] = *((const f32x4*)(x + (size_t)(m0 + r) * D) + lane + 64 * j);
#pragma unroll
    for (int r = 0; r < 4; ++r) { float q = 0.f;
#pragma unroll
        for (int j = 0; j < 4; ++j) q += (v[r][j].x * v[r][j].x + v[r][j].y * v[r][j].y) + (v[r][j].z * v[r][j].z + v[r][j].w * v[r][j].w);
        q = wave_sum(q);
        if (lane == 0) rs[m0 + r] = 1.0f / sqrtf(q * (1.0f / D) + EPS);
        u32x2* o8 = (u32x2*)(o + (size_t)(m0 + r) * D) + lane;
#pragma unroll
        for (int j = 0; j < 4; ++j) o8[64 * j] = (u32x2){pk2(v[r][j].x, v[r][j].y), pk2(v[r][j].z, v[r][j].w)}; }
}
__device__ __forceinline__ void p0_prologue(const Args& A, LAS unsigned char* lds) {
    const int tid = threadIdx.x, lane = tid & 63, wave = tid >> 6;
    LAS float* scr = (LAS float*)(lds + wave * 16896);
    const int gw = blockIdx.x * 8 + wave, NGW = gridDim.x * 8;
    unsigned char* ws = A.ws;
    constexpr int I0 = 16 * (INW / 64), I1 = 16 * 16, I2 = 8 * 16, I3 = 16 * 16, I4 = 16 * (NUP / 64), I5 = (DFF / 64) * 16;
    constexpr int NITEMS = I0 + I1 + 3 * I2 + I3 + I4 + I5;
    for (int it = gw; it < NITEMS; it += NGW) {
        int r = it;
        if (r < I0) { transpose_item<0>(A.in[I_WIN], D, INW, (bf16_t*)(ws + WS_WIN), A.in[I_N1G], scr, r, lane); continue; } r -= I0;
        if (r < I1) { transpose_item<0>(A.in[I_WKV], D, 1024, (bf16_t*)(ws + WS_WKV), A.in[I_MNG], scr, r, lane); continue; } r -= I1;
        if (r < 3 * I2) { const int z = r / I2; transpose_item<0>(A.in[I_WBR] + (size_t)z * 512 * 1024, 512, 1024, (bf16_t*)(ws + WS_WBR) + (size_t)z * 1024 * 512, nullptr, scr, r % I2, lane); continue; } r -= 3 * I2;
        if (r < I3) { transpose_item<0>(A.in[I_WOUT], D, D, (bf16_t*)(ws + WS_WO), nullptr, scr, r, lane); continue; } r -= I3;
        if (r < I4) { transpose_item<1>(A.in[I_WUP], D, NUP, (bf16_t*)(ws + WS_WUP), A.in[I_N2G], scr, r, lane); continue; } r -= I4;
        transpose_item<0>(A.in[I_WDN], DFF, D, (bf16_t*)(ws + WS_WD), nullptr, scr, r, lane);
    }
    for (int m = 4 * gw; m < M; m += 4 * NGW) rows4_to_bf16(A.in[I_X], (bf16_t*)(ws + WS_XB), (float*)(ws + WS_RS1), m, lane);
    for (int m = 4 * gw; m < MEMROWS; m += 4 * NGW) rows4_to_bf16(A.in[I_MEM], (bf16_t*)(ws + WS_MEMB), (float*)(ws + WS_RSM), m, lane);
    for (int i = blockIdx.x * 512 + tid; i < 2 * M; i += gridDim.x * 512) ((float*)(ws + WS_SSQ2))[i] = 0.f;
}

struct ProbP1 { int K, lda, ldb; const bf16_t *xb, *memb, *win, *wkv;
    __device__ __forceinline__ const char* a(const Unit& u) const { return (const char*)((u.z ? memb : xb) + (size_t)u.pm * 256 * 1024); }
    __device__ __forceinline__ const char* b(const Unit& u) const { return (const char*)((u.z ? wkv : win) + (size_t)u.pn * 256 * 1024); } };
struct SchedP1 { int G, c;
    __device__ __forceinline__ bool next(int i, Unit& u) const { int L = i * G + c; if (L < 3328) { pg8::tile_map(L, 128, 26, u); u.z = 0; return true; } L -= 3328; if (L >= 64) return false; u.pm = L & 15; u.pn = L >> 4; u.z = 1; return true; } };
template <int MODE> __device__ __forceinline__ void p1_store(const f32x4 (&acc)[2][2][4][2], const float* rs, int row0, bf16_t* dst, int ldc, int col0, float sc, const float* lbl, int lcol0) {
    float lb[2][8];
    if (MODE == 4) {
#pragma unroll
        for (int bj = 0; bj < 2; ++bj)
#pragma unroll
            for (int j = 0; j < 8; ++j) { const int c = lcol0 + bj * 128 + j; lb[bj][j] = fsigmoid(lbl[c] - lbl[512 + c]); }
    }
#pragma unroll
    for (int ai = 0; ai < 2; ++ai)
#pragma unroll
        for (int m = 0; m < 4; ++m) { const int row = row0 + ai * 128 + m * 16; const float r = rs[row]; bf16_t* rowp = dst + (size_t)row * ldc + col0;
#pragma unroll
            for (int bj = 0; bj < 2; ++bj) { float v[8];
#pragma unroll
                for (int j = 0; j < 8; ++j) { float x = acc[ai][bj][m][j >> 2][j & 3] * r;
                    if (MODE == 0) x *= sc; if (MODE == 1) x = fgelu(x); if (MODE == 2) x = fsilu(x); if (MODE == 3) x = fsigmoid(x);
                    if (MODE == 4) { const float fg = lb[bj][j] + (1.0f - lb[bj][j]) * fsigmoid(x); x = __logf(fg); }
                    v[j] = x; }
                u32x4 w;
                if (MODE == 4) { w.x = pkh2(v[0], v[1]); w.y = pkh2(v[2], v[3]); w.z = pkh2(v[4], v[5]); w.w = pkh2(v[6], v[7]); }
                else { w.x = pk2(v[0], v[1]); w.y = pk2(v[2], v[3]); w.z = pk2(v[4], v[5]); w.w = pk2(v[6], v[7]); }
                *(u32x4*)(rowp + bj * 128) = w; } }
}
struct EpiP1 { static constexpr bool PERM = true;
    const float *rs1, *rsm, *lbl; bf16_t *U, *V, *HQ, *HF, *HI, *HG, *XQ, *GATES, *KV;
    __device__ __forceinline__ bool operator()(f32x4 (&acc)[2][2][4][2], const Unit& u, int wr, int wc, int fr, int fq) const {
        const int row0 = u.pm * 256 + wr * 64 + fr, cw = wc * 32 + 8 * fq;
        if (u.z) { p1_store<0>(acc, rsm, row0, KV, 1024, u.pn * 256 + cw, 1.0f, nullptr, 0); return false; }
        const int seg = u.pn >> 1, col0 = (u.pn & 1) * 256 + cw;
        if (u.pn >= 14) { p1_store<3>(acc, rs1, row0, GATES, 3072, (u.pn - 14) * 256 + cw, 1.f, nullptr, 0); return false; }
        switch (seg) {
            case 0: p1_store<1>(acc, rs1, row0, U, 512, col0, 1.f, nullptr, 0); break;
            case 1: p1_store<1>(acc, rs1, row0, V, 512, col0, 1.f, nullptr, 0); break;
            case 2: p1_store<2>(acc, rs1, row0, HQ, 512, col0, 1.f, nullptr, 0); break;
            case 3: p1_store<4>(acc, rs1, row0, HF, 512, col0, 1.f, lbl, col0); break;
            case 4: p1_store<0>(acc, rs1, row0, HI, 512, col0, 1.f, nullptr, 0); break;
            case 5: p1_store<2>(acc, rs1, row0, HG, 512, col0, 1.f, nullptr, 0); break;
            default: p1_store<0>(acc, rs1, row0, XQ, 512, col0, 0.08838834764831845f * 1.4426950408889634f, nullptr, 0); break;
        }
        return false;
    }
};

__device__ __forceinline__ void attn_item(int item, const bf16_t* XQ, const bf16_t* KV, bf16_t* COUT, LAS unsigned char* lds) {
    const int tid = threadIdx.x, lane = tid & 63, wave = tid >> 6, g = lane >> 4, l15 = lane & 15;
    const int qt = item & 15, h = (item >> 4) & 3, b = item >> 6;
    LAS bf16_t* Ks = (LAS bf16_t*)lds; LAS bf16_t* Vs = Ks + 256 * 144;
#pragma unroll
    for (int i = 0; i < 8; ++i) { const int idx = tid + 512 * i, row = idx >> 4, ch = idx & 15;
        const bf16_t* src = KV + (size_t)(b * 256 + row) * 1024 + h * 128 + ch * 8;
        *(LAS u32x4*)(Ks + row * 144 + ch * 8) = *(const u32x4*)src; *(LAS u32x4*)(Vs + row * 144 + ch * 8) = *(const u32x4*)(src + 512); }
    const int t = b * SEQ + qt * 128 + wave * 16 + l15;
#if DBG_ATTN_COPY
    { __syncthreads(); const int rr = tid >> 2, cc = (tid & 3) * 32; const size_t o = (size_t)(b * SEQ + qt * 128 + rr) * 512 + h * 128 + cc;
      for (int e = 0; e < 4; ++e) *(u32x4*)(COUT + o + 8 * e) = *(const u32x4*)(KV + (size_t)((b * 256 + ((qt * 128 + rr) & 255))) * 1024 + (qt & 1) * 512 + h * 128 + cc + 8 * e);
      __syncthreads(); return; }
#endif
    bf16x8 Qf[4];
#pragma unroll
    for (int ks = 0; ks < 4; ++ks) Qf[ks] = *(const bf16x8*)(XQ + (size_t)t * 512 + h * 128 + 32 * ks + 8 * g);
    __syncthreads();
    f32x4 s[16];
#pragma unroll
    for (int i = 0; i < 16; ++i) { s[i] = (f32x4){0.f, 0.f, 0.f, 0.f};
#pragma unroll
        for (int ks = 0; ks < 4; ++ks) { const bf16x8 a = *(const LAS bf16x8*)(Ks + (16 * i + l15) * 144 + 32 * ks + 8 * g); s[i] = MFMA_BF16(a, Qf[ks], s[i]); } }
    float mx = -3.0e38f;
#pragma unroll
    for (int i = 0; i < 16; ++i) mx = fmaxf(fmaxf(fmaxf(s[i][0], s[i][1]), fmaxf(s[i][2], s[i][3])), mx);
    mx = fmaxf(mx, __shfl_xor(mx, 16)); mx = fmaxf(mx, __shfl_xor(mx, 32));
    float sum = 0.f;
#pragma unroll
    for (int i = 0; i < 16; ++i)
#pragma unroll
        for (int r = 0; r < 4; ++r) { const float p = __builtin_amdgcn_exp2f(s[i][r] - mx); s[i][r] = p; sum += p; }
    sum += __shfl_xor(sum, 16); sum += __shfl_xor(sum, 32);
    const float inv = 1.0f / sum;
    bf16x8 Pf[8];
#pragma unroll
    for (int kk = 0; kk < 8; ++kk) { u32x4 w; w.x = pk2(s[2 * kk][0] * inv, s[2 * kk][1] * inv); w.y = pk2(s[2 * kk][2] * inv, s[2 * kk][3] * inv);
        w.z = pk2(s[2 * kk + 1][0] * inv, s[2 * kk + 1][1] * inv); w.w = pk2(s[2 * kk + 1][2] * inv, s[2 * kk + 1][3] * inv); Pf[kk] = __builtin_bit_cast(bf16x8, w); }
    bf16_t* orow = COUT + (size_t)t * 512 + h * 128 + 4 * g;
#pragma unroll
    for (int dt = 0; dt < 8; ++dt) { f32x4 o = (f32x4){0.f, 0.f, 0.f, 0.f};
#pragma unroll
        for (int kk = 0; kk < 8; ++kk) { const bf16x8 a = tr8(Vs, 144, 32 * kk, 16 * dt, lane); o = MFMA_BF16(a, Pf[kk], o); }
        *(u32x2*)(orow + 16 * dt) = (u32x2){pk2(o[0], o[1]), pk2(o[2], o[3])}; }
    __syncthreads();
}
__device__ __forceinline__ void sgu_item(int item, const bf16_t* U, const bf16_t* V, const float* lng, const float* lnb, const float* wsp, const float* bsp, bf16_t* AOUT, LAS unsigned char* lds) {
    const int tid = threadIdx.x, lane = tid & 63, wave = tid >> 6, g = lane >> 4, l15 = lane & 15;
    const int t0 = item * 128;
    LAS bf16_t* vn = (LAS bf16_t*)lds;
    { float gg[8], bb[8];
#pragma unroll
      for (int j = 0; j < 8; ++j) { gg[j] = lng[8 * lane + j]; bb[j] = lnb[8 * lane + j]; }
#pragma unroll 4
      for (int i = 0; i < 16; ++i) { const int srow = wave * 16 + i; const u32x4 w = *(const u32x4*)(V + (size_t)(t0 + srow) * 512 + 8 * lane);
        float v[8] = {bflo(w.x), bfhi(w.x), bflo(w.y), bfhi(w.y), bflo(w.z), bfhi(w.z), bflo(w.w), bfhi(w.w)};
        float s = 0.f;
#pragma unroll
        for (int j = 0; j < 8; ++j) s += v[j];
        const float mu = wave_sum(s) * (1.0f / 512.0f); float q = 0.f;
#pragma unroll
        for (int j = 0; j < 8; ++j) { v[j] -= mu; q += v[j] * v[j]; }
        const float rstd = 1.0f / sqrtf(wave_sum(q) * (1.0f / 512.0f) + EPS);
#pragma unroll
        for (int j = 0; j < 8; ++j) v[j] = v[j] * rstd * gg[j] + bb[j];
        *(LAS u32x4*)(vn + srow * 528 + 8 * lane) = (u32x4){pk2(v[0], v[1]), pk2(v[2], v[3]), pk2(v[4], v[5]), pk2(v[6], v[7])}; } }
    __syncthreads();
    const int tl = wave * 16 + l15, nks = (wave >> 1) + 1;
#pragma unroll 1
    for (int g4 = 0; g4 < 4; ++g4) {
        bf16x8 Wf[4];
#pragma unroll
        for (int ks = 0; ks < 4; ++ks) { Wf[ks] = (bf16x8){0, 0, 0, 0, 0, 0, 0, 0};
            if (ks < nks) { const float* wp = wsp + (size_t)(g4 * 128 + tl) * 128 + 32 * ks + 4 * g; const f32x4 w0 = *(const f32x4*)wp, w1 = *(const f32x4*)(wp + 16);
                const int s0 = 32 * ks + 4 * g, s1 = s0 + 16; float e[8];
#pragma unroll
                for (int j = 0; j < 4; ++j) { e[j] = (s0 + j <= tl) ? w0[j] : 0.f; e[4 + j] = (s1 + j <= tl) ? w1[j] : 0.f; }
                const u32x4 w = (u32x4){pk2(e[0], e[1]), pk2(e[2], e[3]), pk2(e[4], e[5]), pk2(e[6], e[7])}; Wf[ks] = __builtin_bit_cast(bf16x8, w); } }
        const float bias = bsp[g4 * 128 + tl];
#pragma unroll
        for (int ct = 0; ct < 8; ++ct) { const int c0 = g4 * 128 + 16 * ct; f32x4 acc = (f32x4){0.f, 0.f, 0.f, 0.f};
#pragma unroll
            for (int ks = 0; ks < 4; ++ks) if (ks < nks) { const bf16x8 a = tr8(vn, 528, 32 * ks, c0, lane); acc = MFMA_BF16(a, Wf[ks], acc); }
            const size_t o = (size_t)(t0 + tl) * 512 + c0 + 4 * g; const u32x2 uw = *(const u32x2*)(U + o);
            *(u32x2*)(AOUT + o) = (u32x2){pk2(bflo(uw.x) * (acc[0] + bias), bfhi(uw.x) * (acc[1] + bias)), pk2(bflo(uw.y) * (acc[2] + bias), bfhi(uw.y) * (acc[3] + bias))}; }
    }
    __syncthreads();
}
constexpr int H_LF = 0, H_A = 18432, H_T0 = 52224, H_T1 = 70656, H_T2 = 89088, H_VS = 107520, H_RED = 125952;
#define LDS_SYNC() do { asm volatile("s_waitcnt lgkmcnt(0)" ::: "memory"); __builtin_amdgcn_s_barrier(); asm volatile("" ::: "memory"); } while (0)
struct HTile { u32x4 lf[2], vs[2]; };
__device__ __forceinline__ void hgrn_issue(int item, const bf16_t* HF, const bf16_t* HI, HTile& T) {
    const int tid = threadIdx.x, n = item & 31, bh = item >> 5, t0 = (bh >> 2) * SEQ + n * 64, cb = (bh & 3) * 128;
#pragma unroll
    for (int i = 0; i < 2; ++i) { const int idx = tid + 512 * i, row = idx >> 4, ch = idx & 15; const size_t o = (size_t)(t0 + row) * 512 + cb + ch * 8;
        T.lf[i] = *(const u32x4*)(HF + o); T.vs[i] = *(const u32x4*)(HI + o); }
}
__device__ __forceinline__ void hgrn_store_cumsum(const HTile& T, LAS unsigned char* lds) {
    const int tid = threadIdx.x, lane = tid & 63, wave = tid >> 6, g = lane >> 4, l15 = lane & 15;
    LAS bf16_t* LF = (LAS bf16_t*)(lds + H_LF); LAS bf16_t* VS = (LAS bf16_t*)(lds + H_VS); LAS float* A_ = (LAS float*)(lds + H_A);
#pragma unroll
    for (int i = 0; i < 2; ++i) { const int idx = tid + 512 * i, row = idx >> 4, ch = idx & 15;
        *(LAS u32x4*)(LF + row * 144 + ch * 8) = T.lf[i]; *(LAS u32x4*)(VS + row * 144 + ch * 8) = T.vs[i]; }
    LDS_SYNC();
    f16x8 Bf[2];
#pragma unroll
    for (int ks = 0; ks < 2; ++ks) Bf[ks] = __builtin_bit_cast(f16x8, tr8(LF, 144, 32 * ks, 16 * wave, lane));
#pragma unroll
    for (int tt = 0; tt < 4; ++tt) { f32x4 acc = (f32x4){0.f, 0.f, 0.f, 0.f}; const int t = 16 * tt + l15;
#pragma unroll
        for (int ks = 0; ks < 2; ++ks) { f16x8 a;
#pragma unroll
            for (int j = 0; j < 8; ++j) { const int sI = 32 * ks + 4 * g + (j & 3) + 16 * (j >> 2); a[j] = (sI <= t) ? (_Float16)1.0f : (_Float16)0.0f; }
            acc = __builtin_amdgcn_mfma_f32_16x16x32_f16(a, Bf[ks], acc, 0, 0, 0); }
#pragma unroll
        for (int r = 0; r < 4; ++r) A_[(16 * tt + 4 * g + r) * 132 + 16 * wave + l15] = acc[r]; }
    LDS_SYNC();
}
__device__ __forceinline__ float h2f(unsigned short h) { return (float)__builtin_bit_cast(_Float16, h); }
__device__ __forceinline__ void hgrn1_phase(int c, int G, const bf16_t* HF, const bf16_t* HI, bf16_t* GS, float* HD, LAS unsigned char* lds) {
    const int tid = threadIdx.x, lane = tid & 63, wave = tid >> 6, g = lane >> 4, l15 = lane & 15;
    LAS bf16_t* LF = (LAS bf16_t*)(lds + H_LF); LAS bf16_t* VS = (LAS bf16_t*)(lds + H_VS); LAS float* A_ = (LAS float*)(lds + H_A); LAS bf16_t* KD = (LAS bf16_t*)(lds + H_T0);
    HTile T;
    if (c < 2048) hgrn_issue(c, HF, HI, T);
#pragma unroll 1
    for (int item = c; item < 2048; item += G) {
        hgrn_store_cumsum(T, lds);
        if (item + G < 2048) hgrn_issue(item + G, HF, HI, T);
        { const int t = tid >> 3, kc = (tid & 7) * 16; unsigned w[8];
          f32x4 av[4], alv[4];
#pragma unroll
          for (int j = 0; j < 4; ++j) { av[j] = *(const LAS f32x4*)(A_ + t * 132 + kc + 4 * j); alv[j] = *(const LAS f32x4*)(A_ + 63 * 132 + kc + 4 * j); }
          const u32x4 l0 = *(const LAS u32x4*)(LF + t * 144 + kc), l1 = *(const LAS u32x4*)(LF + t * 144 + kc + 8);
          const unsigned lw[8] = {l0.x, l0.y, l0.z, l0.w, l1.x, l1.y, l1.z, l1.w};
#pragma unroll
          for (int e = 0; e < 16; e += 2) { float o[2];
#pragma unroll
            for (int d = 0; d < 2; ++d) { const int ee = e + d; const float a = av[ee >> 2][ee & 3], al = alv[ee >> 2][ee & 3], lf = h2f((unsigned short)(lw[e >> 1] >> (16 * d))); o[d] = (1.0f - fexp(lf)) * fexp(al - a); }
            w[e >> 1] = pk2(o[0], o[1]); }
          *(LAS u32x4*)(KD + t * 144 + kc) = (u32x4){w[0], w[1], w[2], w[3]}; *(LAS u32x4*)(KD + t * 144 + kc + 8) = (u32x4){w[4], w[5], w[6], w[7]};
          if (tid < 128) HD[(size_t)item * 128 + tid] = fexp(A_[63 * 132 + tid]); }
        LDS_SYNC();
        bf16x8 Af[2];
#pragma unroll
        for (int ks = 0; ks < 2; ++ks) Af[ks] = tr8(KD, 144, 32 * ks, 16 * wave, lane);
        bf16_t* gp = GS + (size_t)item * 16384 + 16 * wave + 4 * g;
#pragma unroll
        for (int vt = 0; vt < 8; ++vt) { f32x4 acc = (f32x4){0.f, 0.f, 0.f, 0.f};
#pragma unroll
            for (int ks = 0; ks < 2; ++ks) { const bf16x8 bb = tr8(VS, 144, 32 * ks, 16 * vt, lane); acc = MFMA_BF16(Af[ks], bb, acc); }
            *(u32x2*)(gp + (size_t)(16 * vt + l15) * 128) = (u32x2){pk2(acc[0], acc[1]), pk2(acc[2], acc[3])}; }
        LDS_SYNC();
    }
}
__device__ __forceinline__ void hgrn2_scan(bf16_t* GS, const float* HD) {
    for (int gid = blockIdx.x * 512 + threadIdx.x; gid < 64 * 2048; gid += gridDim.x * 512) {
        const int bh = gid >> 11, e8 = gid & 2047, kk0 = (8 * e8) & 127;
        float S[8] = {0.f, 0.f, 0.f, 0.f, 0.f, 0.f, 0.f, 0.f};
#pragma unroll 1
        for (int nb = 0; nb < 32; nb += 8) {
            u32x4 gw[8]; f32x4 d0[8], d1[8];
#pragma unroll
            for (int j = 0; j < 8; ++j) { const int item = bh * 32 + nb + j; gw[j] = *(const u32x4*)(GS + (size_t)item * 16384 + 8 * e8);
                d0[j] = *(const f32x4*)(HD + (size_t)item * 128 + kk0); d1[j] = *(const f32x4*)(HD + (size_t)item * 128 + kk0 + 4); }
#pragma unroll
            for (int j = 0; j < 8; ++j) { const int item = bh * 32 + nb + j;
                *(u32x4*)(GS + (size_t)item * 16384 + 8 * e8) = (u32x4){pk2(S[0], S[1]), pk2(S[2], S[3]), pk2(S[4], S[5]), pk2(S[6], S[7])};
                S[0] = d0[j][0] * S[0] + bflo(gw[j].x); S[1] = d0[j][1] * S[1] + bfhi(gw[j].x); S[2] = d0[j][2] * S[2] + bflo(gw[j].y); S[3] = d0[j][3] * S[3] + bfhi(gw[j].y);
                S[4] = d1[j][0] * S[4] + bflo(gw[j].z); S[5] = d1[j][1] * S[5] + bfhi(gw[j].z); S[6] = d1[j][2] * S[6] + bflo(gw[j].w); S[7] = d1[j][3] * S[7] + bfhi(gw[j].w); }
        }
    }
}
__device__ __forceinline__ void hgrn3_phase(int c, int G, const bf16_t* HQ, const bf16_t* HF, const bf16_t* HI, const bf16_t* HG, const bf16_t* GS, const float* ng, bf16_t* BOUT, LAS unsigned char* lds) {
    const int tid = threadIdx.x, lane = tid & 63, wave = tid >> 6, g = lane >> 4, l15 = lane & 15;
    LAS bf16_t* LF = (LAS bf16_t*)(lds + H_LF); LAS bf16_t* VS = (LAS bf16_t*)(lds + H_VS); LAS float* A_ = (LAS float*)(lds + H_A);
    LAS bf16_t* QI = (LAS bf16_t*)(lds + H_T0); LAS bf16_t* QE = (LAS bf16_t*)(lds + H_T1); LAS bf16_t* KE = (LAS bf16_t*)(lds + H_T2); LAS float* RED = (LAS float*)(lds + H_RED);
    const int tt = wave & 3, vh = wave >> 2, tl = 16 * tt + l15;
    HTile T;
    if (c < 2048) hgrn_issue(c, HF, HI, T);
#pragma unroll 1
    for (int item = c; item < 2048; item += G) {
        const int n = item & 31, bh = item >> 5, h = bh & 3, b = bh >> 2, t0 = b * SEQ + n * 64, cb = h * 128;
        const int te = tid >> 3, kc = (tid & 7) * 16;
        const u32x4 q0 = *(const u32x4*)(HQ + (size_t)(t0 + te) * 512 + cb + kc), q1 = *(const u32x4*)(HQ + (size_t)(t0 + te) * 512 + cb + kc + 8);
        const bf16_t* ST = GS + (size_t)item * 16384;
        bf16x8 Sf[4][4]; u32x2 gw[4];
#pragma unroll
        for (int vt = 0; vt < 4; ++vt) { const int vd0 = 64 * vh + 16 * vt;
            gw[vt] = *(const u32x2*)(HG + (size_t)(t0 + tl) * 512 + cb + vd0 + 4 * g);
#pragma unroll
            for (int ks = 0; ks < 4; ++ks) Sf[vt][ks] = *(const bf16x8*)(ST + (size_t)(vd0 + l15) * 128 + 32 * ks + 8 * g); }
        hgrn_store_cumsum(T, lds);
        { unsigned wi[8], we[8], wk[8];
          const unsigned qw[8] = {q0.x, q0.y, q0.z, q0.w, q1.x, q1.y, q1.z, q1.w};
          f32x4 av[4], amv[4];
#pragma unroll
          for (int j = 0; j < 4; ++j) { av[j] = *(const LAS f32x4*)(A_ + te * 132 + kc + 4 * j); amv[j] = *(const LAS f32x4*)(A_ + 31 * 132 + kc + 4 * j); }
          const u32x4 l0 = *(const LAS u32x4*)(LF + te * 144 + kc), l1 = *(const LAS u32x4*)(LF + te * 144 + kc + 8);
          const unsigned lw[8] = {l0.x, l0.y, l0.z, l0.w, l1.x, l1.y, l1.z, l1.w};
#pragma unroll
          for (int e = 0; e < 16; e += 2) { float oi[2], oe[2], ok[2];
#pragma unroll
            for (int d = 0; d < 2; ++d) { const int ee = e + d; const float a = av[ee >> 2][ee & 3], am = amv[ee >> 2][ee & 3], lf = h2f((unsigned short)(lw[e >> 1] >> (16 * d)));
                const float q = d ? bfhi(qw[e >> 1]) : bflo(qw[e >> 1]);
                oi[d] = q * fexp(a); oe[d] = q * fexp(a - am); ok[d] = (1.0f - fexp(lf)) * fexp(am - a); }
            wi[e >> 1] = pk2(oi[0], oi[1]); we[e >> 1] = pk2(oe[0], oe[1]); wk[e >> 1] = pk2(ok[0], ok[1]); }
          *(LAS u32x4*)(QI + te * 144 + kc) = (u32x4){wi[0], wi[1], wi[2], wi[3]}; *(LAS u32x4*)(QI + te * 144 + kc + 8) = (u32x4){wi[4], wi[5], wi[6], wi[7]};
          *(LAS u32x4*)(QE + te * 144 + kc) = (u32x4){we[0], we[1], we[2], we[3]}; *(LAS u32x4*)(QE + te * 144 + kc + 8) = (u32x4){we[4], we[5], we[6], we[7]};
          *(LAS u32x4*)(KE + te * 144 + kc) = (u32x4){wk[0], wk[1], wk[2], wk[3]}; *(LAS u32x4*)(KE + te * 144 + kc + 8) = (u32x4){wk[4], wk[5], wk[6], wk[7]}; }
        LDS_SYNC();
        if (item + G < 2048) hgrn_issue(item + G, HF, HI, T);
        f32x4 P[4];
#pragma unroll
        for (int si = 0; si < 4; ++si) { P[si] = (f32x4){0.f, 0.f, 0.f, 0.f};
            if (si <= tt) {
#pragma unroll
                for (int ks = 0; ks < 4; ++ks) { const bf16x8 a = *(const LAS bf16x8*)(KE + (16 * si + l15) * 144 + 32 * ks + 8 * g), bb = *(const LAS bf16x8*)(QE + tl * 144 + 32 * ks + 8 * g); P[si] = MFMA_BF16(a, bb, P[si]); }
                if (si == tt) {
#pragma unroll
                    for (int r = 0; r < 4; ++r) if (4 * g + r > l15) P[si][r] = 0.f; } } }
        bf16x8 Pf[2];
#pragma unroll
        for (int k2 = 0; k2 < 2; ++k2) { const u32x4 w = (u32x4){pk2(P[2 * k2][0], P[2 * k2][1]), pk2(P[2 * k2][2], P[2 * k2][3]), pk2(P[2 * k2 + 1][0], P[2 * k2 + 1][1]), pk2(P[2 * k2 + 1][2], P[2 * k2 + 1][3])}; Pf[k2] = __builtin_bit_cast(bf16x8, w); }
        bf16x8 Qf[4];
#pragma unroll
        for (int ks = 0; ks < 4; ++ks) Qf[ks] = *(const LAS bf16x8*)(QI + tl * 144 + 32 * ks + 8 * g);
        f32x4 o[4]; float ssq = 0.f;
#pragma unroll
        for (int vt = 0; vt < 4; ++vt) { const int vd0 = 64 * vh + 16 * vt; o[vt] = (f32x4){0.f, 0.f, 0.f, 0.f};
#pragma unroll
            for (int k2 = 0; k2 < 2; ++k2) if (2 * k2 <= tt) { const bf16x8 a = tr8(VS, 144, 32 * k2, vd0, lane); o[vt] = MFMA_BF16(a, Pf[k2], o[vt]); }
#pragma unroll
            for (int ks = 0; ks < 4; ++ks) o[vt] = MFMA_BF16(Sf[vt][ks], Qf[ks], o[vt]);
            ssq += (o[vt][0] * o[vt][0] + o[vt][1] * o[vt][1]) + (o[vt][2] * o[vt][2] + o[vt][3] * o[vt][3]); }
        ssq += __shfl_xor(ssq, 16); ssq += __shfl_xor(ssq, 32);
        if (g == 0) RED[vh * 64 + tl] = ssq;
        LDS_SYNC();
        const float rstd = 1.0f / sqrtf((RED[tl] + RED[64 + tl]) * (1.0f / 128.0f) + EPS);
#pragma unroll
        for (int vt = 0; vt < 4; ++vt) { const int vd = 64 * vh + 16 * vt + 4 * g; const size_t off = (size_t)(t0 + tl) * 512 + cb + vd;
            const f32x4 nw = *(const f32x4*)(ng + vd);
            *(u32x2*)(BOUT + off) = (u32x2){pk2(o[vt][0] * rstd * nw[0] * bflo(gw[vt].x), o[vt][1] * rstd * nw[1] * bfhi(gw[vt].x)), pk2(o[vt][2] * rstd * nw[2] * bflo(gw[vt].y), o[vt][3] * rstd * nw[3] * bfhi(gw[vt].y))}; }
        LDS_SYNC();
    }
}

struct ProbP3 { int K, lda, ldb; const bf16_t *br, *wbr;
    __device__ __forceinline__ const char* a(const Unit& u) const { return (const char*)(br + (size_t)u.z * M * 512 + (size_t)u.pm * 256 * 512); }
    __device__ __forceinline__ const char* b(const Unit& u) const { return (const char*)(wbr + (size_t)u.z * 1024 * 512 + (size_t)u.pn * 256 * 512); } };
struct SchedP3 { int G, c;
    __device__ __forceinline__ bool next(int i, Unit& u) const { const int L = (i / 3) * G + c; if (L >= 512) return false; pg8::tile_map(L, 128, 4, u); u.z = i % 3; return true; } };
struct EpiP3 { static constexpr bool PERM = true; const bf16_t* GATES; bf16_t* MERGED;
    __device__ __forceinline__ bool operator()(f32x4 (&acc)[2][2][4][2], const Unit& u, int wr, int wc, int fr, int fq) const {
        const int row0 = u.pm * 256 + wr * 64 + fr, col0 = u.pn * 256 + wc * 32 + 8 * fq;
#pragma unroll
        for (int ai = 0; ai < 2; ++ai)
#pragma unroll
            for (int m = 0; m < 4; ++m) { const int row = row0 + ai * 128 + m * 16;
#pragma unroll
                for (int bj = 0; bj < 2; ++bj) { const bf16_t* gp = GATES + (size_t)row * 3072 + u.z * 1024 + col0 + bj * 128;
                    const u32x4 g0 = *(const u32x4*)gp; float f[8] = {bflo(g0.x), bfhi(g0.x), bflo(g0.y), bfhi(g0.y), bflo(g0.z), bfhi(g0.z), bflo(g0.w), bfhi(g0.w)};
                    if (u.z < 2) { const u32x4 g1 = *(const u32x4*)(gp + 1024); const float d[8] = {bflo(g1.x), bfhi(g1.x), bflo(g1.y), bfhi(g1.y), bflo(g1.z), bfhi(g1.z), bflo(g1.w), bfhi(g1.w)};
#pragma unroll
                        for (int j = 0; j < 8; ++j) f[j] = f[j] * __builtin_amdgcn_rcpf(fmaxf(d[j], 1e-30f)); }
#pragma unroll
                    for (int j = 0; j < 8; ++j) acc[ai][bj][m][j >> 2][j & 3] *= f[j];
                    if (u.z == 2) { const f32x4 v0 = acc[ai][bj][m][0], v1 = acc[ai][bj][m][1];
                        *(u32x4*)(MERGED + (size_t)row * 1024 + col0 + bj * 128) = (u32x4){pk2(v0[0], v0[1]), pk2(v0[2], v0[3]), pk2(v1[0], v1[1]), pk2(v1[2], v1[3])}; } } }
        return u.z < 2;
    }
};

struct ProbN { int K, lda, ldb; const bf16_t *A_, *B_;
    __device__ __forceinline__ const char* a(const Unit& u) const { return (const char*)(A_ + (size_t)u.pm * 256 * lda); }
    __device__ __forceinline__ const char* b(const Unit& u) const { return (const char*)(B_ + (size_t)u.pn * 256 * ldb); } };
struct SchedN { int G, c, nM, nN, rep = 1;
    __device__ __forceinline__ bool next(int i, Unit& u) const { const int nwg = nM * nN, cnt = (nwg - c + G - 1) / G; if (i >= rep * cnt) return false; const int L = (i % cnt) * G + c; pg8::tile_map(L, nM, nN, u); u.z = 0; return true; } };
template <bool WB> struct EpiRes { static constexpr bool PERM = false; const float* base; float* out; bf16_t* ob; float* ssq; int nofn = 0;
    __device__ __forceinline__ bool operator()(f32x4 (&acc)[2][2][4][2], const Unit& u, int wr, int wc, int fr, int fq) const {
        const int row0 = u.pm * 256 + wr * 64 + fr, col0 = u.pn * 256 + wc * 32 + 4 * fq;
#pragma unroll
        for (int ai = 0; ai < 2; ++ai)
#pragma unroll
            for (int m = 0; m < 4; ++m) { const int row = row0 + ai * 128 + m * 16; const size_t off = (size_t)row * 1024 + col0; float s = 0.f;
#pragma unroll
                for (int bj = 0; bj < 2; ++bj)
#pragma unroll
                    for (int n = 0; n < 2; ++n) { f32x4 v = *(const f32x4*)(base + off + bj * 128 + n * 16); if (!nofn) v = v + acc[ai][bj][m][n];
                        *(f32x4*)(out + off + bj * 128 + n * 16) = v; s += (v[0] * v[0] + v[1] * v[1]) + (v[2] * v[2] + v[3] * v[3]);
                        if (WB) *(u32x2*)(ob + off + bj * 128 + n * 16) = (u32x2){pk2(v[0], v[1]), pk2(v[2], v[3])}; }
                s += __shfl_xor(s, 16); s += __shfl_xor(s, 32);
                if (fq == 0) atomicAdd(ssq + row, s); }
        return false;
    }
};

struct EpiP5 { static constexpr bool PERM = true; const float *ssq2, *cw, *cbias; bf16_t* ACT; float *HALO, *TOPA, *TOPB;
    __device__ __forceinline__ bool operator()(f32x4 (&acc)[2][2][4][2], const Unit& u, int wr, int wc, int fr, int fq) const {
        const int lane = threadIdx.x & 63;
        const int ch0 = u.pn * 128 + wc * 32 + 8 * fq;
        float w0[8], w1[8], w2[8], cb[8];
#pragma unroll
        for (int j = 0; j < 8; ++j) { w0[j] = cw[ch0 + j]; w1[j] = cw[DFF + ch0 + j]; w2[j] = cw[2 * DFF + ch0 + j]; cb[j] = cbias[ch0 + j]; }
        const int src1 = (lane & 48) | ((fr + 15) & 15), src2 = (lane & 48) | ((fr + 14) & 15);
#pragma unroll
        for (int ai = 0; ai < 2; ++ai) {
            const int blk = u.pm * 4 + ai * 2 + wr, rowb = blk * 64;
            float p1[8], p2[8];
#pragma unroll
            for (int j = 0; j < 8; ++j) { p1[j] = 0.f; p2[j] = 0.f; }
#pragma unroll
            for (int m = 0; m < 4; ++m) { const int row = rowb + m * 16 + fr; const float r = 1.0f / sqrtf(ssq2[row] * (1.0f / D) + EPS);
                float a[8], bv[8], r1[8], r2[8];
#pragma unroll
                for (int j = 0; j < 8; ++j) { a[j] = acc[ai][0][m][j >> 2][j & 3] * r; bv[j] = acc[ai][1][m][j >> 2][j & 3] * r; r1[j] = __shfl(a[j], src1); r2[j] = __shfl(a[j], src2); }
                float o[8];
#pragma unroll
                for (int j = 0; j < 8; ++j) { const float am1 = fr >= 1 ? r1[j] : p1[j], am2 = fr >= 2 ? r2[j] : p2[j]; const float cv = cb[j] + w0[j] * am2 + w1[j] * am1 + w2[j] * a[j]; o[j] = fsilu(cv) * bv[j]; p1[j] = r1[j]; p2[j] = r2[j]; }
                if (m > 0 || fr >= 2) *(u32x4*)(ACT + (size_t)row * DFF + ch0) = (u32x4){pk2(o[0], o[1]), pk2(o[2], o[3]), pk2(o[4], o[5]), pk2(o[6], o[7])};
                else { float* ta = TOPA + ((size_t)blk * 2 + fr) * DFF + ch0; float* tb = TOPB + ((size_t)blk * 2 + fr) * DFF + ch0;
                    *(f32x4*)ta = (f32x4){a[0], a[1], a[2], a[3]}; *(f32x4*)(ta + 4) = (f32x4){a[4], a[5], a[6], a[7]}; *(f32x4*)tb = (f32x4){bv[0], bv[1], bv[2], bv[3]}; *(f32x4*)(tb + 4) = (f32x4){bv[4], bv[5], bv[6], bv[7]}; }
                if (m == 3 && fr >= 14) { float* hp = HALO + ((size_t)blk * 2 + (fr - 14)) * DFF + ch0; *(f32x4*)hp = (f32x4){a[0], a[1], a[2], a[3]}; *(f32x4*)(hp + 4) = (f32x4){a[4], a[5], a[6], a[7]}; }
            }
        }
        return false;
    }
};
__device__ __forceinline__ void p6_fix_panel(int pm, const float* HALO, const float* TOPA, const float* TOPB, const float* cw, const float* cbias, bf16_t* ACT) {
    constexpr int NV = DFF / 4;
#pragma unroll 2
    for (int i = threadIdx.x; i < 8 * NV; i += 512) { const int ch = 4 * (i % NV), lr = (i / NV) & 1, b4 = i / (2 * NV), blk = pm * 4 + b4; const bool first = (blk & 31) == 0;
        const size_t hb = (size_t)(first ? blk : blk - 1) * 2 * DFF + ch, tb = (size_t)blk * 2 * DFF + ch;
        f32x4 h0 = *(const f32x4*)(HALO + hb), h1 = *(const f32x4*)(HALO + hb + DFF);
        if (first) { h0 = (f32x4){0.f, 0.f, 0.f, 0.f}; h1 = h0; }
        const f32x4 t0 = *(const f32x4*)(TOPA + tb), t1 = *(const f32x4*)(TOPA + tb + DFF), bv = *(const f32x4*)(TOPB + tb + (size_t)lr * DFF);
        const f32x4 w0 = *(const f32x4*)(cw + ch), w1 = *(const f32x4*)(cw + DFF + ch), w2 = *(const f32x4*)(cw + 2 * DFF + ch), cb = *(const f32x4*)(cbias + ch);
        const f32x4 am2 = lr ? h1 : h0, am1 = lr ? t0 : h1, a0 = lr ? t1 : t0;
        float o[4];
#pragma unroll
        for (int e = 0; e < 4; ++e) o[e] = fsilu(cb[e] + w0[e] * am2[e] + w1[e] * am1[e] + w2[e] * a0[e]) * bv[e];
        *(u32x2*)(ACT + (size_t)(blk * 64 + lr) * DFF + ch) = (u32x2){pk2(o[0], o[1]), pk2(o[2], o[3])}; }
}

__global__ void __launch_bounds__(512, 2) hybrid_fwd(Args A) {
    extern __shared__ __attribute__((aligned(16))) unsigned char lds_raw[];
    LAS unsigned char* lds = (LAS unsigned char*)lds_raw;
    cg::grid_group grid = cg::this_grid();
    unsigned char* ws = A.ws; const int G = gridDim.x, c = blockIdx.x;
    bf16_t* WIN = (bf16_t*)(ws + WS_WIN); bf16_t* WKV = (bf16_t*)(ws + WS_WKV); bf16_t* WBR = (bf16_t*)(ws + WS_WBR); bf16_t* WO = (bf16_t*)(ws + WS_WO); bf16_t* WUP = (bf16_t*)(ws + WS_WUP); bf16_t* WD = (bf16_t*)(ws + WS_WD);
    float* RS1 = (float*)(ws + WS_RS1); float* RSM = (float*)(ws + WS_RSM); float* SSQ2 = (float*)(ws + WS_SSQ2); float* SSQ3 = (float*)(ws + WS_SSQ3); float* HD = (float*)(ws + WS_HD);
    bf16_t* XB = (bf16_t*)(ws + WS_XB); bf16_t* GS = XB; bf16_t* MERGED = XB; bf16_t* MEMB = (bf16_t*)(ws + WS_MEMB); bf16_t* KV = (bf16_t*)(ws + WS_KV);
    bf16_t* HI = (bf16_t*)(ws + WS_HI); bf16_t* HG = (bf16_t*)(ws + WS_HG); bf16_t* XQ = (bf16_t*)(ws + WS_XQ); bf16_t* X1B = HI;
    bf16_t* GATES = (bf16_t*)(ws + WS_GATES); bf16_t* ACT = GATES;
    bf16_t* AOUT = (bf16_t*)(ws + WS_AOUT); bf16_t* BOUT = (bf16_t*)(ws + WS_BOUT); bf16_t* COUT = (bf16_t*)(ws + WS_COUT);
    float* HALO = (float*)(ws + WS_AOUT); float* TOPA = HALO + (size_t)512 * 2 * DFF; float* TOPB = TOPA + (size_t)512 * 2 * DFF;
    bf16_t* U = (bf16_t*)A.out; bf16_t* V = U + (size_t)M * 512; bf16_t* HQ = V + (size_t)M * 512; bf16_t* HF = HQ + (size_t)M * 512;
    const int lo = A.ph_lo, hi = A.ph_hi;
    const unsigned stg = 0u;
#define IN(k) (lo <= (k) && (k) < hi)
#define SEAM(k) do { if (IN(k) && IN((k) + 1)) { if (lo < 0) grid.sync(); else xcd_barrier(xbar); } } while (0)
    volatile LAS unsigned* xst = (volatile LAS unsigned*)(lds + LDS_BYTES - 16);
    if (threadIdx.x < 4) xst[threadIdx.x] = 0u;
    __syncthreads();
    XcdBarrier xbar; xbar.bar = (unsigned*)(ws + WS_BAR); xbar.x = 0; xbar.st = xst;
    if (hi - lo > 1) xbar = xcd_barrier_post((unsigned*)(ws + WS_BAR), xst);
    if (hi - lo == NPHASE_K) for (int q = 0; q < DBG_XSYNC; ++q) grid.sync();
    if (IN(0)) { p0_prologue(A, lds); if (DBG_DUP == 100) { __syncthreads(); p0_prologue(A, lds); } }
    SEAM(0);
    for (int rep = 0; rep < 1 + (DBG_DUP == 1); ++rep) if (IN(1)) { ProbP1 P{1024, 1024, 1024, XB, MEMB, WIN, WKV}; SchedP1 S{G, c}; EpiP1 E{RS1, RSM, A.in[I_LB], U, V, HQ, HF, HI, HG, XQ, GATES, KV}; pg8::gemm_phase(lds, P, S, E, stg * 650u); }
    SEAM(1);
    for (int rep = 0; rep < 1 + (DBG_DUP == 2); ++rep) if (IN(2)) {
        hgrn1_phase(c, G, HF, HI, GS, HD, lds);
        __syncthreads();
        for (int it = c; it < 256; it += G) sgu_item(it, U, V, A.in[I_LNG], A.in[I_LNB], A.in[I_WSP], A.in[I_BSP], AOUT, lds);
        for (int it = c; it < 1024; it += G) attn_item(it, XQ, KV, COUT, lds);
    }
    SEAM(2);
    if (IN(3)) hgrn2_scan(GS, HD);
    SEAM(3);
    for (int rep = 0; rep < 1 + (DBG_DUP == 4); ++rep) if (IN(4)) {
        if (!((DBG_ZERO_MASK >> 1) & 1)) hgrn3_phase(c, G, HQ, HF, HI, HG, GS, A.in[I_HNG], BOUT, lds);
        for (int z = 0; z < 3; ++z) if ((DBG_ZERO_MASK >> z) & 1) { u32x4* p = (u32x4*)(AOUT + (size_t)z * M * 512);
            for (size_t i = (size_t)c * 512 + threadIdx.x; i < (size_t)M * 512 / 8; i += (size_t)G * 512) p[i] = (u32x4){0u, 0u, 0u, 0u}; } }
    SEAM(4);
    for (int rep = 0; rep < 1 + (DBG_DUP == 5); ++rep) if (IN(5)) { ProbP3 P{512, 512, 512, AOUT, WBR}; SchedP3 S{G, c}; EpiP3 E{GATES, MERGED}; pg8::gemm_phase(lds, P, S, E, stg * 300u); }
    SEAM(5);
    if (IN(6)) { ProbN P{1024, 1024, 1024, MERGED, WO}; SchedN S{G, c, 128, 4}; EpiRes<true> E{A.in[I_X], A.out, X1B, SSQ2}; pg8::gemm_phase(lds, P, S, E, stg * 400u); }
    SEAM(6);
    for (int rep = 0; rep < 1 + (DBG_DUP == 7); ++rep) if (IN(7)) { ProbN P{1024, 1024, 1024, X1B, WUP}; SchedN S{G, c, 128, 22, DBG_REP5}; EpiP5 E{SSQ2, A.in[I_CW], A.in[I_CB], ACT, HALO, TOPA, TOPB}; pg8::gemm_phase(lds, P, S, E, stg * 650u); }
    SEAM(7);
    if (IN(8)) {
        SchedN S{G, c, 128, 4}; Unit u;
        for (int i = 0; S.next(i, u); ++i) p6_fix_panel(u.pm, HALO, TOPA, TOPB, A.in[I_CW], A.in[I_CB], ACT);
        __threadfence(); __syncthreads();
        ProbN P{DFF, DFF, DFF, ACT, WD}; EpiRes<false> E{A.out, A.out, nullptr, SSQ3}; E.nofn = DBG_NO_FFN; pg8::gemm_phase(lds, P, S, E, stg * 600u);
    }
    SEAM(8);
    if (IN(9)) {
        const int lane = threadIdx.x & 63, gw = c * 8 + (threadIdx.x >> 6), NGW = G * 8; const float* fg = A.in[I_FG];
        f32x4 gv[4];
#pragma unroll
        for (int j = 0; j < 4; ++j) gv[j] = *((const f32x4*)fg + lane + 64 * j);
        for (int m = gw; m < M; m += NGW) { const float r = 1.0f / sqrtf(SSQ3[m] * (1.0f / D) + EPS); f32x4* p = (f32x4*)(A.out + (size_t)m * D) + lane;
#pragma unroll
            for (int j = 0; j < 4; ++j) { f32x4 o = p[64 * j] * r * gv[j];
#if DBG_SANITIZE
                for (int e = 0; e < 4; ++e) if (!(fabsf(o[e]) < 1e30f)) o[e] = 0.f;
#endif
                p[64 * j] = o; } }
    }
#undef IN
#undef SEAM
}

constexpr int NPHASE = 10;
extern "C" void kernel_launch(void* const* d_in, const int* in_sizes, int n_in, void* d_out, int out_size, void* d_ws, size_t ws_size, hipStream_t stream) {
    static int grid = 0;
    if (grid == 0) {
        if (n_in != 20 || out_size != M * D || ws_size < WS_END) { fprintf(stderr, "kernel_launch: unexpected shapes (n_in %d out %d ws %zu)\n", n_in, out_size, ws_size); grid = -1; return; }
        int dev = 0, cus = 0, per_cu = 0;
        hipGetDevice(&dev); hipDeviceGetAttribute(&cus, hipDeviceAttributeMultiprocessorCount, dev);
        hipFuncSetAttribute((const void*)hybrid_fwd, hipFuncAttributeMaxDynamicSharedMemorySize, LDS_BYTES);
        hipOccupancyMaxActiveBlocksPerMultiprocessor(&per_cu, (const void*)hybrid_fwd, 512, LDS_BYTES);
        if (per_cu < 1) { fprintf(stderr, "kernel_launch: occupancy query says %d blocks per CU\n", per_cu); per_cu = 1; }
        (void)hipGetLastError();
        grid = cus * 1;
        if (grid > cus * per_cu) grid = cus * per_cu;
    }
    if (grid <= 0) return;
    Args a{};
    for (int i = 0; i < 20; ++i) a.in[i] = (const float*)d_in[i];
    a.out = (float*)d_out; a.ws = (unsigned char*)d_ws;
#if MK_PER_PHASE
    for (int p = 0; p < NPHASE; ++p) { a.ph_lo = p; a.ph_hi = p + 1; hipLaunchKernelGGL(hybrid_fwd, dim3(grid), dim3(512), LDS_BYTES, stream, a); }
#else
    a.ph_lo = 0; a.ph_hi = NPHASE;
    (void)hipMemsetAsync((unsigned char*)d_ws + WS_BAR, 0, XCD_BAR_WORDS * 4, stream);
    void* args[] = {&a};
    hipError_t e = hipLaunchCooperativeKernel((const void*)hybrid_fwd, dim3(grid), dim3(512), args, LDS_BYTES, stream);
    if (e != hipSuccess) fprintf(stderr, "cooperative launch failed: %s (grid %d)\n", hipGetErrorString(e), grid);
#endif
}
```

```cpp
#include <hip/hip_runtime.h>
#include <hip/hip_cooperative_groups.h>
#include <cstdio>
#include <cstdint>
namespace cg = cooperative_groups;

#define DBG_SANITIZE 0
#define DBG_ATTN_COPY 0
#define DBG_ZERO_MASK 0
#define DBG_NO_FFN 0
#define DBG_TPHASE -1
#define DBG_TSCALE 1e-4f
#define DBG_REP5 1
#define DBG_XSYNC 0
#define DBG_DUP 0
#ifndef MK_PER_PHASE
#define MK_PER_PHASE 0
#endif

#define LAS __attribute__((address_space(3)))
typedef unsigned short bf16_t;
typedef short bf16x8 __attribute__((ext_vector_type(8)));
typedef short s16x4 __attribute__((ext_vector_type(4)));
typedef _Float16 f16x8 __attribute__((ext_vector_type(8)));
typedef float f32x4 __attribute__((ext_vector_type(4)));
typedef float f32x2 __attribute__((ext_vector_type(2)));
typedef unsigned u32x4 __attribute__((ext_vector_type(4)));
typedef unsigned u32x2 __attribute__((ext_vector_type(2)));

constexpr int M = 32768, D = 1024, SEQ = 2048, INW = 6656, MEMROWS = 4096, MEML = 256, DFF = 2816, NUP = 5632;
constexpr float EPS = 1e-6f;
constexpr size_t MiB = 1u << 20;
constexpr size_t WS_WIN = 0, WS_WKV = 13 * MiB, WS_WBR = 15 * MiB, WS_WO = 18 * MiB, WS_WUP = 20 * MiB, WS_WD = 31 * MiB;
constexpr size_t WS_RS1 = 37 * MiB, WS_RSM = WS_RS1 + 128 * 1024, WS_SSQ2 = WS_RS1 + 256 * 1024, WS_SSQ3 = WS_RS1 + 384 * 1024, WS_HD = 38 * MiB;
constexpr size_t WS_BAR = 39 * MiB;
constexpr size_t WS_XB = 48 * MiB;
constexpr size_t WS_MEMB = 112 * MiB, WS_KV = 120 * MiB;
constexpr size_t WS_HI = 128 * MiB, WS_HG = 160 * MiB, WS_XQ = 192 * MiB;
constexpr size_t WS_GATES = 224 * MiB;
constexpr size_t WS_AOUT = 416 * MiB, WS_BOUT = 448 * MiB, WS_COUT = 480 * MiB;
constexpr size_t WS_END = 512 * MiB;
constexpr int LDS_BYTES = 159744;

typedef __bf16 bf16x2_t __attribute__((ext_vector_type(2)));
__device__ __forceinline__ unsigned pk2(float lo, float hi) { f32x2 v = {lo, hi}; bf16x2_t b = __builtin_convertvector(v, bf16x2_t); return __builtin_bit_cast(unsigned, b); }
__device__ __forceinline__ int otid() { int t = threadIdx.x; asm volatile("" : "+v"(t)); return t; }
__device__ __forceinline__ float bflo(unsigned w) { return __uint_as_float(w << 16); }
__device__ __forceinline__ float bfhi(unsigned w) { return __uint_as_float(w & 0xffff0000u); }
__device__ __forceinline__ float fexp(float x) { return __builtin_amdgcn_exp2f(x * 1.4426950408889634f); }
__device__ __forceinline__ float fsigmoid(float x) { return __builtin_amdgcn_rcpf(1.0f + fexp(-x)); }
__device__ __forceinline__ float fsilu(float x) { return x * fsigmoid(x); }
__device__ __forceinline__ float fgelu(float x) { return x * fsigmoid(1.5957691216057308f * (x + 0.044715f * x * x * x)); }
__device__ __forceinline__ unsigned pkh2(float lo, float hi) { _Float16 a = (_Float16)lo, b = (_Float16)hi; return (unsigned)__builtin_bit_cast(unsigned short, a) | ((unsigned)__builtin_bit_cast(unsigned short, b) << 16); }
__device__ __forceinline__ float wave_sum(float v) {
#pragma unroll
    for (int o = 1; o < 64; o <<= 1) v += __shfl_xor(v, o);
    return v;
}
typedef short v4i16_t __attribute__((ext_vector_type(4)));
__device__ __forceinline__ s16x4 tr4(const LAS bf16_t* p) { return __builtin_bit_cast(s16x4, __builtin_amdgcn_ds_read_tr16_b64_v4i16((LAS v4i16_t*)p)); }
__device__ __forceinline__ bf16x8 tr8(const LAS bf16_t* tile, int P, int k0, int c0, int lane) {
    const int g = lane >> 4, q = (lane & 15) >> 2, p = lane & 3;
    const LAS bf16_t* a = tile + (k0 + 4 * g + q) * P + c0 + 4 * p;
    const s16x4 lo = tr4(a), hi = tr4(a + 16 * P);
    return (bf16x8){lo[0], lo[1], lo[2], lo[3], hi[0], hi[1], hi[2], hi[3]};
}
#define MFMA_BF16(a, b, c) __builtin_amdgcn_mfma_f32_16x16x32_bf16((a), (b), (c), 0, 0, 0)

namespace pg8 {
constexpr int BM = 256, BK = 64, HALF = 128, HTB = HALF * BK * 2, STAGE_BYTES = 8 * HTB, NXCD = 8, WGM = 8;
__host__ __device__ __forceinline__ int lds_byte(int r, int c) { const int st = (r >> 4) * 2 + (c >> 5), rr = r & 15, cc = c & 31, ob = rr * 64 + cc * 2; return st * 1024 + (ob ^ (((ob >> 9) & 1) << 5)); }
__host__ __device__ __forceinline__ void stage_rc(int b, int& R, int& C) { const int st = b / 1024, sb = b % 1024, swz = sb ^ (((sb >> 9) & 1) << 5); R = (st >> 1) * 16 + swz / 64; C = (st & 1) * 32 + (swz % 64) / 2; }
__host__ __device__ __forceinline__ int perm32(int rho) { const int n = rho >> 4, i = rho & 15; return 8 * (i >> 2) + 4 * n + (i & 3); }
struct Unit { int pm, pn, z; };
__device__ __forceinline__ void tile_map(int wgid, int nM, int nN, Unit& u) {
    const int nwg = nM * nN;
    { const int q = nwg / NXCD, r = nwg % NXCD, xcd = wgid % NXCD, off = wgid / NXCD; wgid = (xcd < r ? xcd * (q + 1) : r * (q + 1) + (xcd - r) * q) + off; }
    const int nig = WGM * nN, gid = wgid / nig, fm = gid * WGM, gsz = (nM - fm) < WGM ? (nM - fm) : WGM;
    u.pm = fm + ((wgid % nig) % gsz); u.pn = (wgid % nig) / gsz;
}
template <class Prob, class Epi, class Sched>
__device__ __forceinline__ void gemm_phase(LAS unsigned char* lds, const Prob& Pb, const Sched& S, const Epi& E, unsigned delay = 0) {
    if (delay) { const unsigned long long t0 = __builtin_amdgcn_s_memrealtime(); while (__builtin_amdgcn_s_memrealtime() - t0 < delay) __builtin_amdgcn_s_sleep(8); }
    const int tid = otid(), wid = __builtin_amdgcn_readfirstlane(tid >> 6), lane = tid & 63, wr = wid >> 2, wc = wid & 3, fr = lane & 15, fq = lane >> 4;
    const int K = Pb.K, nt = K / BK;
    unsigned voffA[2], voffB[2];
#pragma unroll
    for (int i = 0; i < 2; ++i) { int R, C; stage_rc(tid * 16 + i * 8192, R, C); const int Rb = Epi::PERM ? ((R & ~31) + perm32(R & 31)) : R;
        voffA[i] = (unsigned)(R * Pb.lda + C) * 2u; voffB[i] = (unsigned)(Rb * Pb.ldb + C) * 2u; }
    const size_t kstep = (size_t)(BK * 2);
    const size_t hsA = (size_t)HALF * Pb.lda * 2, hsB = (size_t)HALF * Pb.ldb * 2;
    const unsigned ldsw = (unsigned)wid * 1024u;
    const int aoff = lds_byte(wr * 64 + fr, fq * 8), boff = lds_byte(wc * 32 + fr, fq * 8);
#define PG8_SA(b, h) (((b) * 2 + (h)) * HTB)
#define PG8_SB(b, h) ((4 + (b) * 2 + (h)) * HTB)
#define PG8_STAGE(bufoff, gbase, voff) do { _Pragma("unroll") for (int _i = 0; _i < 2; ++_i) \
        __builtin_amdgcn_global_load_lds((const unsigned*)((const char*)(gbase) + (voff)[_i]), (LAS unsigned*)(lds + (bufoff) + ldsw + _i * 8192), 16, 0, 0); } while (0)
#define PG8_LDA(dst, b, h) do { _Pragma("unroll") for (int m = 0; m < 4; ++m) _Pragma("unroll") for (int k = 0; k < 2; ++k) dst[m][k] = *(const LAS bf16x8*)(lds + PG8_SA(b, h) + aoff + m * 2048 + k * 1024); } while (0)
#define PG8_LDB(dst, b, h) do { _Pragma("unroll") for (int n = 0; n < 2; ++n) _Pragma("unroll") for (int k = 0; k < 2; ++k) dst[n][k] = *(const LAS bf16x8*)(lds + PG8_SB(b, h) + boff + n * 2048 + k * 1024); } while (0)
#define PG8_MMA(ai, bj, At, Bt) do { __builtin_amdgcn_s_setprio(1); _Pragma("unroll") for (int m = 0; m < 4; ++m) _Pragma("unroll") for (int n = 0; n < 2; ++n) _Pragma("unroll") for (int k = 0; k < 2; ++k) \
        acc[ai][bj][m][n] = __builtin_amdgcn_mfma_f32_16x16x32_bf16(Bt[n][k], At[m][k], acc[ai][bj][m][n], 0, 0, 0); __builtin_amdgcn_s_setprio(0); } while (0)
#define PG8_WAIT_V(n) asm volatile("s_waitcnt vmcnt(" #n ")" ::: "memory")
#define PG8_WAIT_L(n) asm volatile("s_waitcnt lgkmcnt(" #n ")" ::: "memory")
#define PG8_BAR __builtin_amdgcn_s_barrier()
#define PG8_SCHED __builtin_amdgcn_sched_barrier(0)
    Unit cur, nxt; int ui = 0;
    if (!S.next(0, cur)) return;
    f32x4 acc[2][2][4][2];
#pragma unroll
    for (int a = 0; a < 2; ++a)
#pragma unroll
        for (int b = 0; b < 2; ++b)
#pragma unroll
            for (int m = 0; m < 4; ++m)
#pragma unroll
                for (int n = 0; n < 2; ++n) acc[a][b][m][n] = (f32x4){0.f, 0.f, 0.f, 0.f};
    bf16x8 At[4][2], B0[2][2], B1[2][2];
    const char* cA = Pb.a(cur); const char* cB = Pb.b(cur);
    PG8_STAGE(PG8_SB(0, 0), cB, voffB); PG8_STAGE(PG8_SB(0, 1), cB + hsB, voffB); PG8_STAGE(PG8_SA(0, 0), cA, voffA); PG8_STAGE(PG8_SA(0, 1), cA + hsA, voffA);
    if (wr == 1) PG8_BAR;
    PG8_WAIT_V(2); PG8_BAR;
    PG8_STAGE(PG8_SB(1, 0), cB + kstep, voffB); PG8_STAGE(PG8_SA(1, 0), cA + kstep, voffA); PG8_STAGE(PG8_SB(1, 1), cB + hsB + kstep, voffB);
    PG8_WAIT_V(6); PG8_BAR;
    for (;;) {
        const bool has_next = S.next(ui + 1, nxt);
        const char* nA = has_next ? Pb.a(nxt) : cA; const char* nB = has_next ? Pb.b(nxt) : cB;
        for (int t = 0; t < nt; t += 2) {
            const bool last = (t == nt - 2);
            const char* a1 = cA + (size_t)(t + 1) * kstep;
            const char* a2 = last ? nA : cA + (size_t)(t + 2) * kstep; const char* b2 = last ? nB : cB + (size_t)(t + 2) * kstep;
            const char* a3 = a2 + kstep; const char* b3 = b2 + kstep;
            PG8_LDB(B0, 0, 0); PG8_LDB(B1, 0, 1); PG8_SCHED; PG8_LDA(At, 0, 0); PG8_STAGE(PG8_SA(1, 1), a1 + hsA, voffA);
            PG8_WAIT_V(8); PG8_WAIT_L(0); PG8_BAR; PG8_MMA(0, 0, At, B0); PG8_MMA(0, 1, At, B1); PG8_BAR; PG8_SCHED;
            PG8_LDA(At, 0, 1); PG8_STAGE(PG8_SB(0, 0), b2, voffB); PG8_STAGE(PG8_SB(0, 1), b2 + hsB, voffB); PG8_STAGE(PG8_SA(0, 0), a2, voffA);
            PG8_WAIT_V(8); PG8_WAIT_L(0); PG8_BAR; PG8_MMA(1, 0, At, B0); PG8_MMA(1, 1, At, B1); PG8_BAR; PG8_SCHED;
            PG8_LDB(B0, 1, 0); PG8_LDB(B1, 1, 1); PG8_SCHED; PG8_LDA(At, 1, 0); PG8_STAGE(PG8_SA(0, 1), a2 + hsA, voffA);
            PG8_WAIT_V(8); PG8_WAIT_L(0); PG8_BAR; PG8_MMA(0, 0, At, B0); PG8_MMA(0, 1, At, B1); PG8_BAR; PG8_SCHED;
            PG8_LDA(At, 1, 1); PG8_STAGE(PG8_SB(1, 0), b3, voffB); PG8_STAGE(PG8_SB(1, 1), b3 + hsB, voffB); PG8_STAGE(PG8_SA(1, 0), a3, voffA);
            PG8_WAIT_V(8); PG8_WAIT_L(0); PG8_BAR; PG8_MMA(1, 0, At, B0); PG8_MMA(1, 1, At, B1); PG8_BAR; PG8_SCHED;
        }
        if (wr == 0) PG8_BAR;
        const bool keep = E(acc, cur, wr, wc, fr, fq);
        if (!has_next) break;
        if (!keep) {
#pragma unroll
        for (int a = 0; a < 2; ++a)
#pragma unroll
            for (int b = 0; b < 2; ++b)
#pragma unroll
                for (int m = 0; m < 4; ++m)
#pragma unroll
                    for (int n = 0; n < 2; ++n) acc[a][b][m][n] = (f32x4){0.f, 0.f, 0.f, 0.f};
        }
        cur = nxt; cA = nA; cB = nB; ++ui;
        if (wr == 1) PG8_BAR;
    }
    PG8_WAIT_V(0);
    PG8_BAR;
#undef PG8_SA
#undef PG8_SB
#undef PG8_STAGE
#undef PG8_LDA
#undef PG8_LDB
#undef PG8_MMA
#undef PG8_WAIT_V
#undef PG8_WAIT_L
#undef PG8_BAR
#undef PG8_SCHED
}
}
using pg8::Unit;

#define XB_TMO      128
#define XB_XCNT(j)  (256  + 64 * (j))
#define XB_XSUB(j)  (1280 + 64 * (j))
#define XB_XGEN(j)  (2304 + 64 * (j))
#define XB_TOP      3328
#define XB_TOPGEN   3392
#define XCD_BAR_WORDS 3456
#define XB_SPIN_CAP (1u << 18)
__device__ __forceinline__ unsigned xb_ld(unsigned* p)              { return __hip_atomic_load(p, __ATOMIC_RELAXED, __HIP_MEMORY_SCOPE_AGENT); }
__device__ __forceinline__ unsigned xb_add(unsigned* p, unsigned v) { return __hip_atomic_fetch_add(p, v, __ATOMIC_RELAXED, __HIP_MEMORY_SCOPE_AGENT); }
__device__ __forceinline__ unsigned xb_xcc_id() { return (unsigned)__builtin_amdgcn_s_getreg((3 << 11) | 20) & 0xFu; }
#define XB_SPIN(cond, bar) do { unsigned _sp = 0; while (cond) { __builtin_amdgcn_s_sleep(1); \
    if ((++_sp & 255u) == 0u) { if (xb_ld(&(bar)[XB_TMO])) break; if (_sp > XB_SPIN_CAP) { atomicAdd(&(bar)[XB_TMO], 1u); break; } } } } while (0)
struct XcdBarrier { unsigned* bar; unsigned x; volatile LAS unsigned* st; };
__device__ __forceinline__ XcdBarrier xcd_barrier_post(unsigned* bar, volatile LAS unsigned* st) {
    XcdBarrier b; b.bar = bar; b.x = xb_xcc_id(); b.st = st;
    if (threadIdx.x == 0) (void)xb_add(&bar[XB_XCNT(b.x)], 1u);
    return b;
}
__device__ __forceinline__ void xcd_barrier_complete(unsigned* bar, unsigned x, unsigned& nloc, unsigned& nx) {
    const unsigned G = gridDim.x * gridDim.y * gridDim.z;
    unsigned sum, cnt, mine, sp = 0u;
    for (;;) {
        sum = 0u; cnt = 0u; mine = 0u;
#pragma unroll
        for (unsigned j = 0; j < 16; ++j) { const unsigned c = xb_ld(&bar[XB_XCNT(j)]); sum += c; cnt += (c > 0u) ? 1u : 0u; mine = (j == x) ? c : mine; }
        if (sum == G) break;
        __builtin_amdgcn_s_sleep(1);
        if ((++sp & 255u) == 0u) { if (xb_ld(&bar[XB_TMO])) break; if (sp > XB_SPIN_CAP) { atomicAdd(&bar[XB_TMO], 1u); break; } }
    }
    nloc = mine > 0u ? mine : 1u; nx = cnt > 0u ? cnt : 1u;
}
__device__ __forceinline__ void xcd_barrier(const XcdBarrier& b) {
    asm volatile("s_waitcnt vmcnt(0)" ::: "memory");
    __syncthreads();
    if (threadIdx.x == 0) {
        unsigned* bar = b.bar;
        __builtin_amdgcn_s_waitcnt(0);
        unsigned nloc = b.st[0], nx = b.st[1];
        if (nloc == 0u) { xcd_barrier_complete(bar, b.x, nloc, nx); b.st[0] = nloc; b.st[1] = nx; }
        const unsigned old = xb_add(&bar[XB_XSUB(b.x)], 1u);
        const unsigned gen = old / nloc;
        if (old + 1u == (gen + 1u) * nloc) {
            __builtin_amdgcn_fence(__ATOMIC_RELEASE, "agent");
            asm volatile("s_waitcnt vmcnt(0)" ::: "memory");
            const unsigned og = xb_add(&bar[XB_TOP], 1u);
            const unsigned tg = og / nx;
            if (og + 1u == (tg + 1u) * nx) xb_add(&bar[XB_TOPGEN], 1u);
            else XB_SPIN(xb_ld(&bar[XB_TOPGEN]) == tg, bar);
            __builtin_amdgcn_fence(__ATOMIC_ACQUIRE, "agent");
            xb_add(&bar[XB_XGEN(b.x)], 1u);
            asm volatile("s_waitcnt vmcnt(0)" ::: "memory");
        } else {
            XB_SPIN(xb_ld(&bar[XB_XGEN(b.x)]) == gen, bar);
            __builtin_amdgcn_fence(__ATOMIC_ACQUIRE, "agent");
            asm volatile("s_waitcnt vmcnt(0)" ::: "memory");
        }
    }
    __syncthreads();
}

constexpr int NPHASE_K = 10;
struct Args { const float* in[20]; float* out; unsigned char* ws; int ph_lo, ph_hi; };
enum { I_X = 0, I_MEM, I_N1G, I_WIN, I_LNG, I_LNB, I_WSP, I_BSP, I_LB, I_HNG, I_MNG, I_WKV, I_WBR, I_WOUT, I_N2G, I_WUP, I_CW, I_CB, I_WDN, I_FG };

template <int MAP> __device__ __forceinline__ void transpose_item(const float* W, int K, int N, bf16_t* WT, const float* sk, LAS float* scr, int item, int lane) {
    const int nblk = N / 64, kb = item / nblk, nb = item % nblk, k0 = 64 * kb, n0 = 64 * nb;
    f32x4 v[16];
#pragma unroll
    for (int i = 0; i < 16; ++i) v[i] = *(const f32x4*)(W + (size_t)(k0 + 4 * i + (lane >> 4)) * N + n0 + 4 * (lane & 15));
#pragma unroll
    for (int i = 0; i < 16; ++i) { const int kk = 4 * i + (lane >> 4); f32x4 x = v[i]; if (sk) x = x * sk[k0 + kk]; LAS float* d = scr + kk * 65 + 4 * (lane & 15); d[0] = x[0]; d[1] = x[1]; d[2] = x[2]; d[3] = x[3]; }
    asm volatile("s_waitcnt lgkmcnt(0)" ::: "memory");
    const int c = lane & 7;
    int r0 = n0;
    if (MAP == 1) { const int half = n0 >= DFF, ch = n0 - half * DFF; r0 = 256 * (ch >> 7) + 128 * half + (ch & 127); }
#pragma unroll
    for (int j = 0; j < 8; ++j) { const int n = (lane >> 3) + 8 * j; const LAS float* p = scr + (8 * c) * 65 + n;
        u32x4 o; o.x = pk2(p[0 * 65], p[1 * 65]); o.y = pk2(p[2 * 65], p[3 * 65]); o.z = pk2(p[4 * 65], p[5 * 65]); o.w = pk2(p[6 * 65], p[7 * 65]);
        *(u32x4*)(WT + (size_t)(r0 + n) * K + k0 + 8 * c) = o; }
    asm volatile("s_waitcnt lgkmcnt(0)" ::: "memory");
}
__device__ __forceinline__ void rows4_to_bf16(const float* x, bf16_t* o, float* rs, int m0, int lane) {
    f32x4 v[4][4];
#pragma unroll
    for (int r = 0; r < 4; ++r)
#pragma unroll
        for (int j = 0; j < 4; ++j) v[r][j] = *((const f32x4*)(x + (size_t)(m0 + r) * D) + lane + 64 * j);
#pragma unroll
    for (int r = 0; r < 4; ++r) { float q = 0.f;
#pragma unroll
        for (int j = 0; j < 4; ++j) q += (v[r][j].x * v[r][j].x + v[r][j].y * v[r][j].y) + (v[r][j].z * v[r][j].z + v[r][j].w * v[r][j].w);
        q = wave_sum(q);
        if (lane == 0) rs[m0 + r] = 1.0f / sqrtf(q * (1.0f / D) + EPS);
        u32x2* o8 = (u32x2*)(o + (size_t)(m0 + r) * D) + lane;
#pragma unroll
        for (int j = 0; j < 4; ++j) o8[64 * j] = (u32x2){pk2(v[r][j].x, v[r][j].y), pk2(v[r][j].z, v[r][j].w)}; }
}
__device__ __forceinline__ void p0_prologue(const Args& A, LAS unsigned char* lds) {
    const int tid = otid(), lane = tid & 63, wave = tid >> 6;
    LAS float* scr = (LAS float*)(lds + wave * 16896);
    const int gw = blockIdx.x * 8 + wave, NGW = gridDim.x * 8;
    unsigned char* ws = A.ws;
    constexpr int I0 = 16 * (INW / 64), I1 = 16 * 16, I2 = 8 * 16, I3 = 16 * 16, I4 = 16 * (NUP / 64), I5 = (DFF / 64) * 16;
    constexpr int NITEMS = I0 + I1 + 3 * I2 + I3 + I4 + I5;
    for (int it = gw; it < NITEMS; it += NGW) {
        int r = it;
        if (r < I0) { transpose_item<0>(A.in[I_WIN], D, INW, (bf16_t*)(ws + WS_WIN), A.in[I_N1G], scr, r, lane); continue; } r -= I0;
        if (r < I1) { transpose_item<0>(A.in[I_WKV], D, 1024, (bf16_t*)(ws + WS_WKV), A.in[I_MNG], scr, r, lane); continue; } r -= I1;
        if (r < 3 * I2) { const int z = r / I2; transpose_item<0>(A.in[I_WBR] + (size_t)z * 512 * 1024, 512, 1024, (bf16_t*)(ws + WS_WBR) + (size_t)z * 1024 * 512, nullptr, scr, r % I2, lane); continue; } r -= 3 * I2;
        if (r < I3) { transpose_item<0>(A.in[I_WOUT], D, D, (bf16_t*)(ws + WS_WO), nullptr, scr, r, lane); continue; } r -= I3;
        if (r < I4) { transpose_item<1>(A.in[I_WUP], D, NUP, (bf16_t*)(ws + WS_WUP), A.in[I_N2G], scr, r, lane); continue; } r -= I4;
        transpose_item<0>(A.in[I_WDN], DFF, D, (bf16_t*)(ws + WS_WD), nullptr, scr, r, lane);
    }
    for (int m = 4 * gw; m < M; m += 4 * NGW) rows4_to_bf16(A.in[I_X], (bf16_t*)(ws + WS_XB), (float*)(ws + WS_RS1), m, lane);
    for (int m = 4 * gw; m < MEMROWS; m += 4 * NGW) rows4_to_bf16(A.in[I_MEM], (bf16_t*)(ws + WS_MEMB), (float*)(ws + WS_RSM), m, lane);
    for (int i = blockIdx.x * 512 + tid; i < 2 * M; i += gridDim.x * 512) ((float*)(ws + WS_SSQ2))[i] = 0.f;
}

struct ProbP1 { int K, lda, ldb; const bf16_t *xb, *memb, *win, *wkv;
    __device__ __forceinline__ const char* a(const Unit& u) const { return (const char*)((u.z ? memb : xb) + (size_t)u.pm * 256 * 1024); }
    __device__ __forceinline__ const char* b(const Unit& u) const { return (const char*)((u.z ? wkv : win) + (size_t)u.pn * 256 * 1024); } };
struct SchedP1 { int G, c;
    __device__ __forceinline__ bool next(int i, Unit& u) const { const int L = i * G + c; if (L >= 3328) return false; pg8::tile_map(L, 128, 26, u); u.z = 0; return true; } };
struct SchedKV { int G, c;
    __device__ __forceinline__ bool next(int i, Unit& u) const { const int L = i * G + c; if (L >= 64) return false; u.pm = L & 15; u.pn = L >> 4; u.z = 0; return true; } };
template <int MODE> __device__ __forceinline__ void p1_store(const f32x4 (&acc)[2][2][4][2], const float* rs, int row0, bf16_t* dst, int ldc, int col0, float sc, const float* lbl, int lcol0) {
    float lb[2][8];
    if (MODE == 4) {
#pragma unroll
        for (int bj = 0; bj < 2; ++bj)
#pragma unroll
            for (int j = 0; j < 8; ++j) { const int c = lcol0 + bj * 128 + j; lb[bj][j] = fsigmoid(lbl[c] - lbl[512 + c]); }
    }
#pragma unroll
    for (int ai = 0; ai < 2; ++ai)
#pragma unroll
        for (int m = 0; m < 4; ++m) { const int row = row0 + ai * 128 + m * 16; const float r = rs[row]; bf16_t* rowp = dst + (size_t)row * ldc + col0;
#pragma unroll
            for (int bj = 0; bj < 2; ++bj) { float v[8];
#pragma unroll
                for (int j = 0; j < 8; ++j) { float x = acc[ai][bj][m][j >> 2][j & 3] * r;
                    if (MODE == 0) x *= sc; if (MODE == 1) x = fgelu(x); if (MODE == 2) x = fsilu(x); if (MODE == 3) x = fsigmoid(x);
                    if (MODE == 4) { const float fg = lb[bj][j] + (1.0f - lb[bj][j]) * fsigmoid(x); x = __logf(fg); }
                    v[j] = x; }
                u32x4 w;
                if (MODE == 4) { w.x = pkh2(v[0], v[1]); w.y = pkh2(v[2], v[3]); w.z = pkh2(v[4], v[5]); w.w = pkh2(v[6], v[7]); }
                else { w.x = pk2(v[0], v[1]); w.y = pk2(v[2], v[3]); w.z = pk2(v[4], v[5]); w.w = pk2(v[6], v[7]); }
                *(u32x4*)(rowp + bj * 128) = w; } }
}
struct EpiP1 { static constexpr bool PERM = true;
    const float *rs1, *rsm, *lbl; bf16_t *U, *V, *HQ, *HF, *HI, *HG, *XQ, *GATES, *KV;
    __device__ __forceinline__ bool operator()(f32x4 (&acc)[2][2][4][2], const Unit& u, int wr, int wc, int fr, int fq) const {
        const int row0 = u.pm * 256 + wr * 64 + fr, cw = wc * 32 + 8 * fq;
        const int seg = u.pn >> 1, col0 = (u.pn & 1) * 256 + cw;
        if (u.pn >= 14) { p1_store<3>(acc, rs1, row0, GATES, 3072, (u.pn - 14) * 256 + cw, 1.f, nullptr, 0); return false; }
        switch (seg) {
            case 0: p1_store<1>(acc, rs1, row0, U, 512, col0, 1.f, nullptr, 0); break;
            case 1: p1_store<1>(acc, rs1, row0, V, 512, col0, 1.f, nullptr, 0); break;
            case 2: p1_store<2>(acc, rs1, row0, HQ, 512, col0, 1.f, nullptr, 0); break;
            case 3: p1_store<4>(acc, rs1, row0, HF, 512, col0, 1.f, lbl, col0); break;
            case 4: p1_store<0>(acc, rs1, row0, HI, 512, col0, 1.f, nullptr, 0); break;
            case 5: p1_store<2>(acc, rs1, row0, HG, 512, col0, 1.f, nullptr, 0); break;
            default: p1_store<0>(acc, rs1, row0, XQ, 512, col0, 0.08838834764831845f * 1.4426950408889634f, nullptr, 0); break;
        }
        return false;
    }
};

struct EpiKV { static constexpr bool PERM = true; const float* rsm; bf16_t* KV;
    __device__ __forceinline__ bool operator()(f32x4 (&acc)[2][2][4][2], const Unit& u, int wr, int wc, int fr, int fq) const {
        p1_store<0>(acc, rsm, u.pm * 256 + wr * 64 + fr, KV, 1024, u.pn * 256 + wc * 32 + 8 * fq, 1.0f, nullptr, 0); return false; } };
struct ProbN { int K, lda, ldb; const bf16_t *A_, *B_;
    __device__ __forceinline__ const char* a(const Unit& u) const { return (const char*)(A_ + (size_t)u.pm * 256 * lda); }
    __device__ __forceinline__ const char* b(const Unit& u) const { return (const char*)(B_ + (size_t)u.pn * 256 * ldb); } };
__device__ __forceinline__ void attn_item(int item, const bf16_t* XQ, const bf16_t* KV, bf16_t* COUT, LAS unsigned char* lds) {
    const int tid = otid(), lane = tid & 63, wave = tid >> 6, g = lane >> 4, l15 = lane & 15;
    const int qt = item & 15, h = (item >> 4) & 3, b = item >> 6;
    LAS bf16_t* Ks = (LAS bf16_t*)lds; LAS bf16_t* Vs = Ks + 256 * 144;
#pragma unroll
    for (int i = 0; i < 8; ++i) { const int idx = tid + 512 * i, row = idx >> 4, ch = idx & 15;
        const bf16_t* src = KV + (size_t)(b * 256 + row) * 1024 + h * 128 + ch * 8;
        *(LAS u32x4*)(Ks + row * 144 + ch * 8) = *(const u32x4*)src; *(LAS u32x4*)(Vs + row * 144 + ch * 8) = *(const u32x4*)(src + 512); }
    const int t = b * SEQ + qt * 128 + wave * 16 + l15;
#if DBG_ATTN_COPY
    { __syncthreads(); const int rr = tid >> 2, cc = (tid & 3) * 32; const size_t o = (size_t)(b * SEQ + qt * 128 + rr) * 512 + h * 128 + cc;
      for (int e = 0; e < 4; ++e) *(u32x4*)(COUT + o + 8 * e) = *(const u32x4*)(KV + (size_t)((b * 256 + ((qt * 128 + rr) & 255))) * 1024 + (qt & 1) * 512 + h * 128 + cc + 8 * e);
      __syncthreads(); return; }
#endif
    bf16x8 Qf[4];
#pragma unroll
    for (int ks = 0; ks < 4; ++ks) Qf[ks] = *(const bf16x8*)(XQ + (size_t)t * 512 + h * 128 + 32 * ks + 8 * g);
    __syncthreads();
    f32x4 s[16];
#pragma unroll
    for (int i = 0; i < 16; ++i) { s[i] = (f32x4){0.f, 0.f, 0.f, 0.f};
#pragma unroll
        for (int ks = 0; ks < 4; ++ks) { const bf16x8 a = *(const LAS bf16x8*)(Ks + (16 * i + l15) * 144 + 32 * ks + 8 * g); s[i] = MFMA_BF16(a, Qf[ks], s[i]); } }
    float mx = -3.0e38f;
#pragma unroll
    for (int i = 0; i < 16; ++i) mx = fmaxf(fmaxf(fmaxf(s[i][0], s[i][1]), fmaxf(s[i][2], s[i][3])), mx);
    mx = fmaxf(mx, __shfl_xor(mx, 16)); mx = fmaxf(mx, __shfl_xor(mx, 32));
    float sum = 0.f;
#pragma unroll
    for (int i = 0; i < 16; ++i)
#pragma unroll
        for (int r = 0; r < 4; ++r) { const float p = __builtin_amdgcn_exp2f(s[i][r] - mx); s[i][r] = p; sum += p; }
    sum += __shfl_xor(sum, 16); sum += __shfl_xor(sum, 32);
    const float inv = 1.0f / sum;
    bf16x8 Pf[8];
#pragma unroll
    for (int kk = 0; kk < 8; ++kk) { u32x4 w; w.x = pk2(s[2 * kk][0] * inv, s[2 * kk][1] * inv); w.y = pk2(s[2 * kk][2] * inv, s[2 * kk][3] * inv);
        w.z = pk2(s[2 * kk + 1][0] * inv, s[2 * kk + 1][1] * inv); w.w = pk2(s[2 * kk + 1][2] * inv, s[2 * kk + 1][3] * inv); Pf[kk] = __builtin_bit_cast(bf16x8, w); }
    bf16_t* orow = COUT + (size_t)t * 512 + h * 128 + 4 * g;
#pragma unroll
    for (int dt = 0; dt < 8; ++dt) { f32x4 o = (f32x4){0.f, 0.f, 0.f, 0.f};
#pragma unroll
        for (int kk = 0; kk < 8; ++kk) { const bf16x8 a = tr8(Vs, 144, 32 * kk, 16 * dt, lane); o = MFMA_BF16(a, Pf[kk], o); }
        *(u32x2*)(orow + 16 * dt) = (u32x2){pk2(o[0], o[1]), pk2(o[2], o[3])}; }
    __syncthreads();
}
__device__ __forceinline__ void sgu_item(int item, const bf16_t* U, const bf16_t* V, const float* lng, const float* lnb, const float* wsp, const float* bsp, bf16_t* AOUT, LAS unsigned char* lds) {
    const int tid = otid(), lane = tid & 63, wave = tid >> 6, g = lane >> 4, l15 = lane & 15;
    const int t0 = item * 128;
    LAS bf16_t* vn = (LAS bf16_t*)lds;
    { float gg[8], bb[8];
#pragma unroll
      for (int j = 0; j < 8; ++j) { gg[j] = lng[8 * lane + j]; bb[j] = lnb[8 * lane + j]; }
#pragma unroll 4
      for (int i = 0; i < 16; ++i) { const int srow = wave * 16 + i; const u32x4 w = *(const u32x4*)(V + (size_t)(t0 + srow) * 512 + 8 * lane);
        float v[8] = {bflo(w.x), bfhi(w.x), bflo(w.y), bfhi(w.y), bflo(w.z), bfhi(w.z), bflo(w.w), bfhi(w.w)};
        float s = 0.f;
#pragma unroll
        for (int j = 0; j < 8; ++j) s += v[j];
        const float mu = wave_sum(s) * (1.0f / 512.0f); float q = 0.f;
#pragma unroll
        for (int j = 0; j < 8; ++j) { v[j] -= mu; q += v[j] * v[j]; }
        const float rstd = 1.0f / sqrtf(wave_sum(q) * (1.0f / 512.0f) + EPS);
#pragma unroll
        for (int j = 0; j < 8; ++j) v[j] = v[j] * rstd * gg[j] + bb[j];
        *(LAS u32x4*)(vn + srow * 528 + 8 * lane) = (u32x4){pk2(v[0], v[1]), pk2(v[2], v[3]), pk2(v[4], v[5]), pk2(v[6], v[7])}; } }
    __syncthreads();
    const int tl = wave * 16 + l15, nks = (wave >> 1) + 1;
#pragma unroll 1
    for (int g4 = 0; g4 < 4; ++g4) {
        bf16x8 Wf[4];
#pragma unroll
        for (int ks = 0; ks < 4; ++ks) { Wf[ks] = (bf16x8){0, 0, 0, 0, 0, 0, 0, 0};
            if (ks < nks) { const float* wp = wsp + (size_t)(g4 * 128 + tl) * 128 + 32 * ks + 4 * g; const f32x4 w0 = *(const f32x4*)wp, w1 = *(const f32x4*)(wp + 16);
                const int s0 = 32 * ks + 4 * g, s1 = s0 + 16; float e[8];
#pragma unroll
                for (int j = 0; j < 4; ++j) { e[j] = (s0 + j <= tl) ? w0[j] : 0.f; e[4 + j] = (s1 + j <= tl) ? w1[j] : 0.f; }
                const u32x4 w = (u32x4){pk2(e[0], e[1]), pk2(e[2], e[3]), pk2(e[4], e[5]), pk2(e[6], e[7])}; Wf[ks] = __builtin_bit_cast(bf16x8, w); } }
        const float bias = bsp[g4 * 128 + tl];
#pragma unroll
        for (int ct = 0; ct < 8; ++ct) { const int c0 = g4 * 128 + 16 * ct; f32x4 acc = (f32x4){0.f, 0.f, 0.f, 0.f};
#pragma unroll
            for (int ks = 0; ks < 4; ++ks) if (ks < nks) { const bf16x8 a = tr8(vn, 528, 32 * ks, c0, lane); acc = MFMA_BF16(a, Wf[ks], acc); }
            const size_t o = (size_t)(t0 + tl) * 512 + c0 + 4 * g; const u32x2 uw = *(const u32x2*)(U + o);
            *(u32x2*)(AOUT + o) = (u32x2){pk2(bflo(uw.x) * (acc[0] + bias), bfhi(uw.x) * (acc[1] + bias)), pk2(bflo(uw.y) * (acc[2] + bias), bfhi(uw.y) * (acc[3] + bias))}; }
    }
    __syncthreads();
}
constexpr int H_LF = 0, H_A = 18432, H_T0 = 52224, H_T1 = 70656, H_T2 = 89088, H_VS = 107520, H_RED = 125952;
#define LDS_SYNC() do { asm volatile("s_waitcnt lgkmcnt(0)" ::: "memory"); __builtin_amdgcn_s_barrier(); asm volatile("" ::: "memory"); } while (0)
struct HTile { u32x4 lf[2], vs[2]; };
__device__ __forceinline__ void hgrn_issue(int item, const bf16_t* HF, const bf16_t* HI, HTile& T) {
    const int tid = otid(), n = item & 31, bh = item >> 5, t0 = (bh >> 2) * SEQ + n * 64, cb = (bh & 3) * 128;
#pragma unroll
    for (int i = 0; i < 2; ++i) { const int idx = tid + 512 * i, row = idx >> 4, ch = idx & 15; const size_t o = (size_t)(t0 + row) * 512 + cb + ch * 8;
        T.lf[i] = *(const u32x4*)(HF + o); T.vs[i] = *(const u32x4*)(HI + o); }
}
__device__ __forceinline__ void hgrn_store_cumsum(const HTile& T, LAS unsigned char* lds) {
    const int tid = otid(), lane = tid & 63, wave = tid >> 6, g = lane >> 4, l15 = lane & 15;
    LAS bf16_t* LF = (LAS bf16_t*)(lds + H_LF); LAS bf16_t* VS = (LAS bf16_t*)(lds + H_VS); LAS float* A_ = (LAS float*)(lds + H_A);
#pragma unroll
    for (int i = 0; i < 2; ++i) { const int idx = tid + 512 * i, row = idx >> 4, ch = idx & 15;
        *(LAS u32x4*)(LF + row * 144 + ch * 8) = T.lf[i]; *(LAS u32x4*)(VS + row * 144 + ch * 8) = T.vs[i]; }
    LDS_SYNC();
    f16x8 Bf[2];
#pragma unroll
    for (int ks = 0; ks < 2; ++ks) Bf[ks] = __builtin_bit_cast(f16x8, tr8(LF, 144, 32 * ks, 16 * wave, lane));
#pragma unroll
    for (int tt = 0; tt < 4; ++tt) { f32x4 acc = (f32x4){0.f, 0.f, 0.f, 0.f}; const int t = 16 * tt + l15;
#pragma unroll
        for (int ks = 0; ks < 2; ++ks) { f16x8 a;
#pragma unroll
            for (int j = 0; j < 8; ++j) { const int sI = 32 * ks + 4 * g + (j & 3) + 16 * (j >> 2); a[j] = (sI <= t) ? (_Float16)1.0f : (_Float16)0.0f; }
            acc = __builtin_amdgcn_mfma_f32_16x16x32_f16(a, Bf[ks], acc, 0, 0, 0); }
#pragma unroll
        for (int r = 0; r < 4; ++r) A_[(16 * tt + 4 * g + r) * 132 + 16 * wave + l15] = acc[r]; }
    LDS_SYNC();
}
__device__ __forceinline__ float h2f(unsigned short h) { return (float)__builtin_bit_cast(_Float16, h); }
__device__ __forceinline__ void hgrn1_phase(int c, int G, const bf16_t* HF, const bf16_t* HI, bf16_t* GS, float* HD, LAS unsigned char* lds) {
    const int tid = otid(), lane = tid & 63, wave = tid >> 6, g = lane >> 4, l15 = lane & 15;
    LAS bf16_t* LF = (LAS bf16_t*)(lds + H_LF); LAS bf16_t* VS = (LAS bf16_t*)(lds + H_VS); LAS float* A_ = (LAS float*)(lds + H_A); LAS bf16_t* KD = (LAS bf16_t*)(lds + H_T0);
    HTile T;
    if (c < 2048) hgrn_issue(c, HF, HI, T);
#pragma unroll 1
    for (int item = c; item < 2048; item += G) {
        hgrn_store_cumsum(T, lds);
        if (item + G < 2048) hgrn_issue(item + G, HF, HI, T);
        { const int t = tid >> 3, kc = (tid & 7) * 16; unsigned w[8];
          f32x4 av[4], alv[4];
#pragma unroll
          for (int j = 0; j < 4; ++j) { av[j] = *(const LAS f32x4*)(A_ + t * 132 + kc + 4 * j); alv[j] = *(const LAS f32x4*)(A_ + 63 * 132 + kc + 4 * j); }
          const u32x4 l0 = *(const LAS u32x4*)(LF + t * 144 + kc), l1 = *(const LAS u32x4*)(LF + t * 144 + kc + 8);
          const unsigned lw[8] = {l0.x, l0.y, l0.z, l0.w, l1.x, l1.y, l1.z, l1.w};
#pragma unroll
          for (int e = 0; e < 16; e += 2) { float o[2];
#pragma unroll
            for (int d = 0; d < 2; ++d) { const int ee = e + d; const float a = av[ee >> 2][ee & 3], al = alv[ee >> 2][ee & 3], lf = h2f((unsigned short)(lw[e >> 1] >> (16 * d))); o[d] = (1.0f - fexp(lf)) * fexp(al - a); }
            w[e >> 1] = pk2(o[0], o[1]); }
          *(LAS u32x4*)(KD + t * 144 + kc) = (u32x4){w[0], w[1], w[2], w[3]}; *(LAS u32x4*)(KD + t * 144 + kc + 8) = (u32x4){w[4], w[5], w[6], w[7]};
          if (tid < 128) HD[(size_t)item * 128 + tid] = fexp(A_[63 * 132 + tid]); }
        LDS_SYNC();
        bf16x8 Af[2];
#pragma unroll
        for (int ks = 0; ks < 2; ++ks) Af[ks] = tr8(KD, 144, 32 * ks, 16 * wave, lane);
        bf16_t* gp = GS + (size_t)item * 16384 + 16 * wave + 4 * g;
#pragma unroll
        for (int vt = 0; vt < 8; ++vt) { f32x4 acc = (f32x4){0.f, 0.f, 0.f, 0.f};
#pragma unroll
            for (int ks = 0; ks < 2; ++ks) { const bf16x8 bb = tr8(VS, 144, 32 * ks, 16 * vt, lane); acc = MFMA_BF16(Af[ks], bb, acc); }
            *(u32x2*)(gp + (size_t)(16 * vt + l15) * 128) = (u32x2){pk2(acc[0], acc[1]), pk2(acc[2], acc[3])}; }
        LDS_SYNC();
    }
}
__device__ __forceinline__ void hgrn2_scan(bf16_t* GS, const float* HD, int vb, int nvb) {
    for (int gid = vb * 512 + otid(); gid < 64 * 2048; gid += nvb * 512) {
        const int bh = gid >> 11, e8 = gid & 2047, kk0 = (8 * e8) & 127;
        float S[8] = {0.f, 0.f, 0.f, 0.f, 0.f, 0.f, 0.f, 0.f};
#pragma unroll 1
        for (int nb = 0; nb < 32; nb += 8) {
            u32x4 gw[8]; f32x4 d0[8], d1[8];
#pragma unroll
            for (int j = 0; j < 8; ++j) { const int item = bh * 32 + nb + j; gw[j] = *(const u32x4*)(GS + (size_t)item * 16384 + 8 * e8);
                d0[j] = *(const f32x4*)(HD + (size_t)item * 128 + kk0); d1[j] = *(const f32x4*)(HD + (size_t)item * 128 + kk0 + 4); }
#pragma unroll
            for (int j = 0; j < 8; ++j) { const int item = bh * 32 + nb + j;
                *(u32x4*)(GS + (size_t)item * 16384 + 8 * e8) = (u32x4){pk2(S[0], S[1]), pk2(S[2], S[3]), pk2(S[4], S[5]), pk2(S[6], S[7])};
                S[0] = d0[j][0] * S[0] + bflo(gw[j].x); S[1] = d0[j][1] * S[1] + bfhi(gw[j].x); S[2] = d0[j][2] * S[2] + bflo(gw[j].y); S[3] = d0[j][3] * S[3] + bfhi(gw[j].y);
                S[4] = d1[j][0] * S[4] + bflo(gw[j].z); S[5] = d1[j][1] * S[5] + bfhi(gw[j].z); S[6] = d1[j][2] * S[6] + bflo(gw[j].w); S[7] = d1[j][3] * S[7] + bfhi(gw[j].w); }
        }
    }
}
__device__ __forceinline__ void hgrn3_phase(int c, int G, const bf16_t* HQ, const bf16_t* HF, const bf16_t* HI, const bf16_t* HG, const bf16_t* GS, const float* ng, bf16_t* BOUT, LAS unsigned char* lds) {
    const int tid = otid(), lane = tid & 63, wave = tid >> 6, g = lane >> 4, l15 = lane & 15;
    LAS bf16_t* LF = (LAS bf16_t*)(lds + H_LF); LAS bf16_t* VS = (LAS bf16_t*)(lds + H_VS); LAS float* A_ = (LAS float*)(lds + H_A);
    LAS bf16_t* QI = (LAS bf16_t*)(lds + H_T0); LAS bf16_t* QE = (LAS bf16_t*)(lds + H_T1); LAS bf16_t* KE = (LAS bf16_t*)(lds + H_T2); LAS float* RED = (LAS float*)(lds + H_RED);
    const int tt = wave & 3, vh = wave >> 2, tl = 16 * tt + l15;
    HTile T;
    if (c < 2048) hgrn_issue(c, HF, HI, T);
#pragma unroll 1
    for (int item = c; item < 2048; item += G) {
        const int n = item & 31, bh = item >> 5, h = bh & 3, b = bh >> 2, t0 = b * SEQ + n * 64, cb = h * 128;
        const int te = tid >> 3, kc = (tid & 7) * 16;
        const u32x4 q0 = *(const u32x4*)(HQ + (size_t)(t0 + te) * 512 + cb + kc), q1 = *(const u32x4*)(HQ + (size_t)(t0 + te) * 512 + cb + kc + 8);
        const bf16_t* ST = GS + (size_t)item * 16384;
        bf16x8 Sf[4][4]; u32x2 gw[4];
#pragma unroll
        for (int vt = 0; vt < 4; ++vt) { const int vd0 = 64 * vh + 16 * vt;
            gw[vt] = *(const u32x2*)(HG + (size_t)(t0 + tl) * 512 + cb + vd0 + 4 * g);
#pragma unroll
            for (int ks = 0; ks < 4; ++ks) Sf[vt][ks] = *(const bf16x8*)(ST + (size_t)(vd0 + l15) * 128 + 32 * ks + 8 * g); }
        hgrn_store_cumsum(T, lds);
        { unsigned wi[8], we[8], wk[8];
          const unsigned qw[8] = {q0.x, q0.y, q0.z, q0.w, q1.x, q1.y, q1.z, q1.w};
          f32x4 av[4], amv[4];
#pragma unroll
          for (int j = 0; j < 4; ++j) { av[j] = *(const LAS f32x4*)(A_ + te * 132 + kc + 4 * j); amv[j] = *(const LAS f32x4*)(A_ + 31 * 132 + kc + 4 * j); }
          const u32x4 l0 = *(const LAS u32x4*)(LF + te * 144 + kc), l1 = *(const LAS u32x4*)(LF + te * 144 + kc + 8);
          const unsigned lw[8] = {l0.x, l0.y, l0.z, l0.w, l1.x, l1.y, l1.z, l1.w};
#pragma unroll
          for (int e = 0; e < 16; e += 2) { float oi[2], oe[2], ok[2];
#pragma unroll
            for (int d = 0; d < 2; ++d) { const int ee = e + d; const float a = av[ee >> 2][ee & 3], am = amv[ee >> 2][ee & 3], lf = h2f((unsigned short)(lw[e >> 1] >> (16 * d)));
                const float q = d ? bfhi(qw[e >> 1]) : bflo(qw[e >> 1]);
                oi[d] = q * fexp(a); oe[d] = q * fexp(a - am); ok[d] = (1.0f - fexp(lf)) * fexp(am - a); }
            wi[e >> 1] = pk2(oi[0], oi[1]); we[e >> 1] = pk2(oe[0], oe[1]); wk[e >> 1] = pk2(ok[0], ok[1]); }
          *(LAS u32x4*)(QI + te * 144 + kc) = (u32x4){wi[0], wi[1], wi[2], wi[3]}; *(LAS u32x4*)(QI + te * 144 + kc + 8) = (u32x4){wi[4], wi[5], wi[6], wi[7]};
          *(LAS u32x4*)(QE + te * 144 + kc) = (u32x4){we[0], we[1], we[2], we[3]}; *(LAS u32x4*)(QE + te * 144 + kc + 8) = (u32x4){we[4], we[5], we[6], we[7]};
          *(LAS u32x4*)(KE + te * 144 + kc) = (u32x4){wk[0], wk[1], wk[2], wk[3]}; *(LAS u32x4*)(KE + te * 144 + kc + 8) = (u32x4){wk[4], wk[5], wk[6], wk[7]}; }
        LDS_SYNC();
        if (item + G < 2048) hgrn_issue(item + G, HF, HI, T);
        f32x4 P[4];
#pragma unroll
        for (int si = 0; si < 4; ++si) { P[si] = (f32x4){0.f, 0.f, 0.f, 0.f};
            if (si <= tt) {
#pragma unroll
                for (int ks = 0; ks < 4; ++ks) { const bf16x8 a = *(const LAS bf16x8*)(KE + (16 * si + l15) * 144 + 32 * ks + 8 * g), bb = *(const LAS bf16x8*)(QE + tl * 144 + 32 * ks + 8 * g); P[si] = MFMA_BF16(a, bb, P[si]); }
                if (si == tt) {
#pragma unroll
                    for (int r = 0; r < 4; ++r) if (4 * g + r > l15) P[si][r] = 0.f; } } }
        bf16x8 Pf[2];
#pragma unroll
        for (int k2 = 0; k2 < 2; ++k2) { const u32x4 w = (u32x4){pk2(P[2 * k2][0], P[2 * k2][1]), pk2(P[2 * k2][2], P[2 * k2][3]), pk2(P[2 * k2 + 1][0], P[2 * k2 + 1][1]), pk2(P[2 * k2 + 1][2], P[2 * k2 + 1][3])}; Pf[k2] = __builtin_bit_cast(bf16x8, w); }
        bf16x8 Qf[4];
#pragma unroll
        for (int ks = 0; ks < 4; ++ks) Qf[ks] = *(const LAS bf16x8*)(QI + tl * 144 + 32 * ks + 8 * g);
        f32x4 o[4]; float ssq = 0.f;
#pragma unroll
        for (int vt = 0; vt < 4; ++vt) { const int vd0 = 64 * vh + 16 * vt; o[vt] = (f32x4){0.f, 0.f, 0.f, 0.f};
#pragma unroll
            for (int k2 = 0; k2 < 2; ++k2) if (2 * k2 <= tt) { const bf16x8 a = tr8(VS, 144, 32 * k2, vd0, lane); o[vt] = MFMA_BF16(a, Pf[k2], o[vt]); }
#pragma unroll
            for (int ks = 0; ks < 4; ++ks) o[vt] = MFMA_BF16(Sf[vt][ks], Qf[ks], o[vt]);
            ssq += (o[vt][0] * o[vt][0] + o[vt][1] * o[vt][1]) + (o[vt][2] * o[vt][2] + o[vt][3] * o[vt][3]); }
        ssq += __shfl_xor(ssq, 16); ssq += __shfl_xor(ssq, 32);
        if (g == 0) RED[vh * 64 + tl] = ssq;
        LDS_SYNC();
        const float rstd = 1.0f / sqrtf((RED[tl] + RED[64 + tl]) * (1.0f / 128.0f) + EPS);
#pragma unroll
        for (int vt = 0; vt < 4; ++vt) { const int vd = 64 * vh + 16 * vt + 4 * g; const size_t off = (size_t)(t0 + tl) * 512 + cb + vd;
            const f32x4 nw = *(const f32x4*)(ng + vd);
            *(u32x2*)(BOUT + off) = (u32x2){pk2(o[vt][0] * rstd * nw[0] * bflo(gw[vt].x), o[vt][1] * rstd * nw[1] * bfhi(gw[vt].x)), pk2(o[vt][2] * rstd * nw[2] * bflo(gw[vt].y), o[vt][3] * rstd * nw[3] * bfhi(gw[vt].y))}; }
        LDS_SYNC();
    }
}

struct ProbP3 { int K, lda, ldb; const bf16_t *br, *wbr;
    __device__ __forceinline__ const char* a(const Unit& u) const { return (const char*)(br + (size_t)u.z * M * 512 + (size_t)u.pm * 256 * 512); }
    __device__ __forceinline__ const char* b(const Unit& u) const { return (const char*)(wbr + (size_t)u.z * 1024 * 512 + (size_t)u.pn * 256 * 512); } };
struct SchedP3 { int G, c;
    __device__ __forceinline__ bool next(int i, Unit& u) const { const int L = (i / 3) * G + c; if (L >= 512) return false; pg8::tile_map(L, 128, 4, u); u.z = i % 3; return true; } };
struct EpiP3 { static constexpr bool PERM = true; const bf16_t* GATES; bf16_t* MERGED;
    __device__ __forceinline__ bool operator()(f32x4 (&acc)[2][2][4][2], const Unit& u, int wr, int wc, int fr, int fq) const {
        const int row0 = u.pm * 256 + wr * 64 + fr, col0 = u.pn * 256 + wc * 32 + 8 * fq;
#pragma unroll
        for (int ai = 0; ai < 2; ++ai) {
            u32x4 g0[4][2], g1[4][2];
#pragma unroll
            for (int m = 0; m < 4; ++m)
#pragma unroll
                for (int bj = 0; bj < 2; ++bj) { const bf16_t* gp = GATES + (size_t)(row0 + ai * 128 + m * 16) * 3072 + u.z * 1024 + col0 + bj * 128;
                    g0[m][bj] = *(const u32x4*)gp; g1[m][bj] = (u.z < 2) ? *(const u32x4*)(gp + 1024) : (u32x4){0x3f803f80u, 0x3f803f80u, 0x3f803f80u, 0x3f803f80u}; }
            __builtin_amdgcn_sched_barrier(0);
#pragma unroll
            for (int m = 0; m < 4; ++m) { const int row = row0 + ai * 128 + m * 16;
#pragma unroll
                for (int bj = 0; bj < 2; ++bj) { const u32x4 a = g0[m][bj], d4 = g1[m][bj];
                    float f[8] = {bflo(a.x), bfhi(a.x), bflo(a.y), bfhi(a.y), bflo(a.z), bfhi(a.z), bflo(a.w), bfhi(a.w)};
                    if (u.z < 2) { const float d[8] = {bflo(d4.x), bfhi(d4.x), bflo(d4.y), bfhi(d4.y), bflo(d4.z), bfhi(d4.z), bflo(d4.w), bfhi(d4.w)};
#pragma unroll
                        for (int j = 0; j < 8; ++j) f[j] = f[j] * __builtin_amdgcn_rcpf(fmaxf(d[j], 1e-30f)); }
#pragma unroll
                    for (int j = 0; j < 8; ++j) acc[ai][bj][m][j >> 2][j & 3] *= f[j];
                    if (u.z == 2) { const f32x4 v0 = acc[ai][bj][m][0], v1 = acc[ai][bj][m][1];
                        *(u32x4*)(MERGED + (size_t)row * 1024 + col0 + bj * 128) = (u32x4){pk2(v0[0], v0[1]), pk2(v0[2], v0[3]), pk2(v1[0], v1[1]), pk2(v1[2], v1[3])}; } } }
            __builtin_amdgcn_sched_barrier(0);
        }
        return u.z < 2;
    }
};

struct SchedN { int G, c, nM, nN, rep = 1;
    __device__ __forceinline__ bool next(int i, Unit& u) const { const int nwg = nM * nN, cnt = (nwg - c + G - 1) / G; if (i >= rep * cnt) return false; const int L = (i % cnt) * G + c; pg8::tile_map(L, nM, nN, u); u.z = 0; return true; } };
struct EpiP4 { static constexpr bool PERM = true; const float* base; bf16_t* ob; float* ssq;
    __device__ __forceinline__ bool operator()(f32x4 (&acc)[2][2][4][2], const Unit& u, int wr, int wc, int fr, int fq) const {
        const int row0 = u.pm * 256 + wr * 64 + fr, col0 = u.pn * 256 + wc * 32 + 8 * fq;
#pragma unroll
        for (int ah = 0; ah < 4; ++ah) { const int ai = ah >> 1, mb = (ah & 1) * 2;
            f32x4 bs[4][2][2];
#pragma unroll
            for (int m = mb; m < mb + 2; ++m)
#pragma unroll
                for (int bj = 0; bj < 2; ++bj)
#pragma unroll
                    for (int n = 0; n < 2; ++n) bs[m][bj][n] = *(const f32x4*)(base + (size_t)(row0 + ai * 128 + m * 16) * 1024 + col0 + bj * 128 + n * 4);
            __builtin_amdgcn_sched_barrier(0);
#pragma unroll
            for (int m = mb; m < mb + 2; ++m) { const int row = row0 + ai * 128 + m * 16; const size_t off = (size_t)row * 1024 + col0; float s = 0.f;
#pragma unroll
                for (int bj = 0; bj < 2; ++bj) { const f32x4 v0 = bs[m][bj][0] + acc[ai][bj][m][0], v1 = bs[m][bj][1] + acc[ai][bj][m][1];
                    s += (v0[0] * v0[0] + v0[1] * v0[1]) + (v0[2] * v0[2] + v0[3] * v0[3]) + (v1[0] * v1[0] + v1[1] * v1[1]) + (v1[2] * v1[2] + v1[3] * v1[3]);
                    *(u32x4*)(ob + off + bj * 128) = (u32x4){pk2(v0[0], v0[1]), pk2(v0[2], v0[3]), pk2(v1[0], v1[1]), pk2(v1[2], v1[3])}; }
                s += __shfl_xor(s, 16); s += __shfl_xor(s, 32);
                if (fq == 0) atomicAdd(ssq + row, s); }
            __builtin_amdgcn_sched_barrier(0);
        }
        return false;
    }
};
struct EpiP6 { static constexpr bool PERM = true; const bf16_t* base; bf16_t* ob; float* ssq; int nofn;
    __device__ __forceinline__ bool operator()(f32x4 (&acc)[2][2][4][2], const Unit& u, int wr, int wc, int fr, int fq) const {
        const int row0 = u.pm * 256 + wr * 64 + fr, col0 = u.pn * 256 + wc * 32 + 8 * fq;
#pragma unroll
        for (int ai = 0; ai < 2; ++ai) {
        u32x4 bs[2][4][2];
#pragma unroll
            for (int m = 0; m < 4; ++m)
#pragma unroll
                for (int bj = 0; bj < 2; ++bj) bs[ai][m][bj] = *(const u32x4*)(base + (size_t)(row0 + ai * 128 + m * 16) * 1024 + col0 + bj * 128);
        __builtin_amdgcn_sched_barrier(0);
#pragma unroll
            for (int m = 0; m < 4; ++m) { const int row = row0 + ai * 128 + m * 16; const size_t off = (size_t)row * 1024 + col0; float s = 0.f;
#pragma unroll
                for (int bj = 0; bj < 2; ++bj) { const u32x4 w = bs[ai][m][bj];
                    f32x4 v0 = (f32x4){bflo(w.x), bfhi(w.x), bflo(w.y), bfhi(w.y)}, v1 = (f32x4){bflo(w.z), bfhi(w.z), bflo(w.w), bfhi(w.w)};
                    if (!nofn) { v0 = v0 + acc[ai][bj][m][0]; v1 = v1 + acc[ai][bj][m][1]; }
                    s += (v0[0] * v0[0] + v0[1] * v0[1]) + (v0[2] * v0[2] + v0[3] * v0[3]) + (v1[0] * v1[0] + v1[1] * v1[1]) + (v1[2] * v1[2] + v1[3] * v1[3]);
                    *(u32x4*)(ob + off + bj * 128) = (u32x4){pk2(v0[0], v0[1]), pk2(v0[2], v0[3]), pk2(v1[0], v1[1]), pk2(v1[2], v1[3])}; }
                s += __shfl_xor(s, 16); s += __shfl_xor(s, 32);
                if (fq == 0) atomicAdd(ssq + row, s); }
        __builtin_amdgcn_sched_barrier(0);
        }
        return false;
    }
};

struct EpiP5 { static constexpr bool PERM = true; const float *ssq2, *cw, *cbias; bf16_t* ACT; float *HALO, *TOPA, *TOPB;
    __device__ __forceinline__ bool operator()(f32x4 (&acc)[2][2][4][2], const Unit& u, int wr, int wc, int fr, int fq) const {
        const int lane = otid() & 63;
        const int ch0 = u.pn * 128 + wc * 32 + 8 * fq;
        float w0[8], w1[8], w2[8], cb[8];
#pragma unroll
        for (int j = 0; j < 8; ++j) { w0[j] = cw[ch0 + j]; w1[j] = cw[DFF + ch0 + j]; w2[j] = cw[2 * DFF + ch0 + j]; cb[j] = cbias[ch0 + j]; }
        const int src1 = (lane & 48) | ((fr + 15) & 15), src2 = (lane & 48) | ((fr + 14) & 15);
#pragma unroll
        for (int ai = 0; ai < 2; ++ai) {
            const int blk = u.pm * 4 + ai * 2 + wr, rowb = blk * 64;
            float p1[8], p2[8];
#pragma unroll
            for (int j = 0; j < 8; ++j) { p1[j] = 0.f; p2[j] = 0.f; }
#pragma unroll
            for (int m = 0; m < 4; ++m) { const int row = rowb + m * 16 + fr; const float r = 1.0f / sqrtf(ssq2[row] * (1.0f / D) + EPS);
                float a[8], bv[8], r1[8], r2[8];
#pragma unroll
                for (int j = 0; j < 8; ++j) { a[j] = acc[ai][0][m][j >> 2][j & 3] * r; bv[j] = acc[ai][1][m][j >> 2][j & 3] * r; r1[j] = __shfl(a[j], src1); r2[j] = __shfl(a[j], src2); }
                float o[8];
#pragma unroll
                for (int j = 0; j < 8; ++j) { const float am1 = fr >= 1 ? r1[j] : p1[j], am2 = fr >= 2 ? r2[j] : p2[j]; const float cv = cb[j] + w0[j] * am2 + w1[j] * am1 + w2[j] * a[j]; o[j] = fsilu(cv) * bv[j]; p1[j] = r1[j]; p2[j] = r2[j]; }
                if (m > 0 || fr >= 2) *(u32x4*)(ACT + (size_t)row * DFF + ch0) = (u32x4){pk2(o[0], o[1]), pk2(o[2], o[3]), pk2(o[4], o[5]), pk2(o[6], o[7])};
                else { float* ta = TOPA + ((size_t)blk * 2 + fr) * DFF + ch0; float* tb = TOPB + ((size_t)blk * 2 + fr) * DFF + ch0;
                    *(f32x4*)ta = (f32x4){a[0], a[1], a[2], a[3]}; *(f32x4*)(ta + 4) = (f32x4){a[4], a[5], a[6], a[7]}; *(f32x4*)tb = (f32x4){bv[0], bv[1], bv[2], bv[3]}; *(f32x4*)(tb + 4) = (f32x4){bv[4], bv[5], bv[6], bv[7]}; }
                if (m == 3 && fr >= 14) { float* hp = HALO + ((size_t)blk * 2 + (fr - 14)) * DFF + ch0; *(f32x4*)hp = (f32x4){a[0], a[1], a[2], a[3]}; *(f32x4*)(hp + 4) = (f32x4){a[4], a[5], a[6], a[7]}; }
            }
        }
        return false;
    }
};
__device__ __forceinline__ void p6_fix_panel(int pm, const float* HALO, const float* TOPA, const float* TOPB, const float* cw, const float* cbias, bf16_t* ACT) {
    constexpr int NV = DFF / 4;
#pragma unroll 2
    for (int i = otid(); i < 8 * NV; i += 512) { const int ch = 4 * (i % NV), lr = (i / NV) & 1, b4 = i / (2 * NV), blk = pm * 4 + b4; const bool first = (blk & 31) == 0;
        const size_t hb = (size_t)(first ? blk : blk - 1) * 2 * DFF + ch, tb = (size_t)blk * 2 * DFF + ch;
        f32x4 h0 = *(const f32x4*)(HALO + hb), h1 = *(const f32x4*)(HALO + hb + DFF);
        if (first) { h0 = (f32x4){0.f, 0.f, 0.f, 0.f}; h1 = h0; }
        const f32x4 t0 = *(const f32x4*)(TOPA + tb), t1 = *(const f32x4*)(TOPA + tb + DFF), bv = *(const f32x4*)(TOPB + tb + (size_t)lr * DFF);
        const f32x4 w0 = *(const f32x4*)(cw + ch), w1 = *(const f32x4*)(cw + DFF + ch), w2 = *(const f32x4*)(cw + 2 * DFF + ch), cb = *(const f32x4*)(cbias + ch);
        const f32x4 am2 = lr ? h1 : h0, am1 = lr ? t0 : h1, a0 = lr ? t1 : t0;
        float o[4];
#pragma unroll
        for (int e = 0; e < 4; ++e) o[e] = fsilu(cb[e] + w0[e] * am2[e] + w1[e] * am1[e] + w2[e] * a0[e]) * bv[e];
        *(u32x2*)(ACT + (size_t)(blk * 64 + lr) * DFF + ch) = (u32x2){pk2(o[0], o[1]), pk2(o[2], o[3])}; }
}

__global__ void __launch_bounds__(512, 2) hybrid_fwd(Args A) {
    extern __shared__ __attribute__((aligned(16))) unsigned char lds_raw[];
    LAS unsigned char* lds = (LAS unsigned char*)lds_raw;
    cg::grid_group grid = cg::this_grid();
    unsigned char* ws = A.ws; const int G = gridDim.x, c = blockIdx.x;
    bf16_t* WIN = (bf16_t*)(ws + WS_WIN); bf16_t* WKV = (bf16_t*)(ws + WS_WKV); bf16_t* WBR = (bf16_t*)(ws + WS_WBR); bf16_t* WO = (bf16_t*)(ws + WS_WO); bf16_t* WUP = (bf16_t*)(ws + WS_WUP); bf16_t* WD = (bf16_t*)(ws + WS_WD);
    float* RS1 = (float*)(ws + WS_RS1); float* RSM = (float*)(ws + WS_RSM); float* SSQ2 = (float*)(ws + WS_SSQ2); float* SSQ3 = (float*)(ws + WS_SSQ3); float* HD = (float*)(ws + WS_HD);
    bf16_t* XB = (bf16_t*)(ws + WS_XB); bf16_t* GS = XB; bf16_t* MERGED = XB; bf16_t* X2B = XB; bf16_t* MEMB = (bf16_t*)(ws + WS_MEMB); bf16_t* KV = (bf16_t*)(ws + WS_KV);
    bf16_t* HI = (bf16_t*)(ws + WS_HI); bf16_t* HG = (bf16_t*)(ws + WS_HG); bf16_t* XQ = (bf16_t*)(ws + WS_XQ); bf16_t* X1B = HI;
    bf16_t* GATES = (bf16_t*)(ws + WS_GATES); bf16_t* ACT = GATES;
    bf16_t* AOUT = (bf16_t*)(ws + WS_AOUT); bf16_t* BOUT = (bf16_t*)(ws + WS_BOUT); bf16_t* COUT = (bf16_t*)(ws + WS_COUT);
    float* HALO = (float*)(ws + WS_AOUT); float* TOPA = HALO + (size_t)512 * 2 * DFF; float* TOPB = TOPA + (size_t)512 * 2 * DFF;
    bf16_t* U = (bf16_t*)A.out; bf16_t* V = U + (size_t)M * 512; bf16_t* HQ = V + (size_t)M * 512; bf16_t* HF = HQ + (size_t)M * 512;
    const int lo = A.ph_lo, hi = A.ph_hi;
    const unsigned stg = 0u;
#define IN(k) (lo <= (k) && (k) < hi)
#define SEAM(k) do { if (IN(k) && IN((k) + 1)) { if (lo < 0) grid.sync(); else xcd_barrier(xbar); } } while (0)
    unsigned long long tp0 = 0ull;
#define TSTART(k) do { if (DBG_TPHASE == (k) && c == 0 && threadIdx.x == 0) tp0 = __builtin_amdgcn_s_memrealtime(); } while (0)
#define TEND(k) do { if (DBG_TPHASE == (k) && c == 0 && threadIdx.x == 0) { *(volatile unsigned*)(ws + WS_BAR + 32768) = (unsigned)(__builtin_amdgcn_s_memrealtime() - tp0); } if (DBG_TPHASE == (k) && (k) == 8) xcd_barrier(xbar); } while (0)
    volatile LAS unsigned* xst = (volatile LAS unsigned*)(lds + LDS_BYTES - 16);
    if (threadIdx.x < 4) xst[threadIdx.x] = 0u;
    __syncthreads();
    XcdBarrier xbar; xbar.bar = (unsigned*)(ws + WS_BAR); xbar.x = 0; xbar.st = xst;
    if (hi - lo > 1) xbar = xcd_barrier_post((unsigned*)(ws + WS_BAR), xst);
    if (hi - lo == NPHASE_K) for (int q = 0; q < DBG_XSYNC; ++q) grid.sync();
    TSTART(0);
    if (IN(0)) { p0_prologue(A, lds); if (DBG_DUP == 100) { __syncthreads(); p0_prologue(A, lds); } }
    SEAM(0);
    TEND(0); TSTART(1);
    if (IN(1)) { ProbN P{1024, 1024, 1024, XB, WIN}; SchedP1 S{G, c}; EpiP1 E{RS1, RSM, A.in[I_LB], U, V, HQ, HF, HI, HG, XQ, GATES, KV}; pg8::gemm_phase(lds, P, S, E, stg * 650u); }
    SEAM(1);
    TEND(1); TSTART(2);
    for (int rep = 0; rep < 1 + (DBG_DUP == 2); ++rep) if (IN(2)) {
        hgrn1_phase(c, G, HF, HI, GS, HD, lds);
        __syncthreads();
        for (int it = c; it < 256; it += G) sgu_item(it, U, V, A.in[I_LNG], A.in[I_LNB], A.in[I_WSP], A.in[I_BSP], AOUT, lds);
    }
    SEAM(2);
    TEND(2); TSTART(3);
    if (IN(3)) {
        const bool split = G > 64;
        if (!split || c >= 64) hgrn2_scan(GS, HD, split ? c - 64 : c, split ? G - 64 : G);
        if (c < 64) { __syncthreads(); ProbN P{1024, 1024, 1024, MEMB, WKV}; SchedKV S{G, c}; EpiKV E{RSM, KV}; pg8::gemm_phase(lds, P, S, E); }
    }
    SEAM(3);
    TEND(3); TSTART(4);
    for (int rep = 0; rep < 1 + (DBG_DUP == 4); ++rep) if (IN(4)) {
        if (!((DBG_ZERO_MASK >> 1) & 1)) hgrn3_phase(c, G, HQ, HF, HI, HG, GS, A.in[I_HNG], BOUT, lds);
        __syncthreads();
        for (int it = c; it < 1024; it += G) attn_item(it, XQ, KV, COUT, lds);
        for (int z = 0; z < 3; ++z) if ((DBG_ZERO_MASK >> z) & 1) { u32x4* p = (u32x4*)(AOUT + (size_t)z * M * 512);
            for (size_t i = (size_t)c * 512 + threadIdx.x; i < (size_t)M * 512 / 8; i += (size_t)G * 512) p[i] = (u32x4){0u, 0u, 0u, 0u}; } }
    SEAM(4);
    TEND(4); TSTART(5);
    for (int rep = 0; rep < 1 + (DBG_DUP == 5); ++rep) if (IN(5)) { ProbP3 P{512, 512, 512, AOUT, WBR}; SchedP3 S{G, c}; EpiP3 E{GATES, MERGED}; pg8::gemm_phase(lds, P, S, E, stg * 300u); }
    SEAM(5);
    TEND(5); TSTART(6);
    if (IN(6)) { ProbN P{1024, 1024, 1024, MERGED, WO}; SchedN S{G, c, 128, 4}; EpiP4 E{A.in[I_X], X1B, SSQ2}; pg8::gemm_phase(lds, P, S, E, stg * 400u); }
    SEAM(6);
    TEND(6); TSTART(7);
    for (int rep = 0; rep < 1 + (DBG_DUP == 7); ++rep) if (IN(7)) { ProbN P{1024, 1024, 1024, X1B, WUP}; SchedN S{G, c, 128, 22, DBG_REP5}; EpiP5 E{SSQ2, A.in[I_CW], A.in[I_CB], ACT, HALO, TOPA, TOPB}; pg8::gemm_phase(lds, P, S, E, stg * 650u); }
    SEAM(7);
    TEND(7); TSTART(8);
    if (IN(8)) {
        SchedN S{G, c, 128, 4}; Unit u;
        for (int i = 0; S.next(i, u); ++i) p6_fix_panel(u.pm, HALO, TOPA, TOPB, A.in[I_CW], A.in[I_CB], ACT);
        __threadfence(); __syncthreads();
        ProbN P{DFF, DFF, DFF, ACT, WD}; EpiP6 E{X1B, X2B, SSQ3, DBG_NO_FFN}; pg8::gemm_phase(lds, P, S, E, stg * 600u);
    }
    SEAM(8);
    TEND(8); TSTART(9);
    if (IN(9)) {
        const int t9 = otid(), lane = t9 & 63, gw = c * 8 + (t9 >> 6), NGW = G * 8; const float* fg = A.in[I_FG];
        f32x4 gv[4];
#pragma unroll
        for (int j = 0; j < 4; ++j) gv[j] = *((const f32x4*)fg + lane + 64 * j);
        const float tsc = (DBG_TPHASE >= 0) ? 1.0f + (float)(*(volatile unsigned*)(ws + WS_BAR + 32768)) * 0.01f * DBG_TSCALE : 1.0f;
        for (int m0 = 4 * gw; m0 < M; m0 += 4 * NGW) {
            u32x2 w[4][4]; float r[4];
#pragma unroll
            for (int q = 0; q < 4; ++q) { r[q] = tsc / sqrtf(SSQ3[m0 + q] * (1.0f / D) + EPS);
#pragma unroll
                for (int j = 0; j < 4; ++j) w[q][j] = *((const u32x2*)(X2B + (size_t)(m0 + q) * D) + lane + 64 * j); }
#pragma unroll
            for (int q = 0; q < 4; ++q) { f32x4* p = (f32x4*)(A.out + (size_t)(m0 + q) * D) + lane;
#pragma unroll
                for (int j = 0; j < 4; ++j) { f32x4 o = (f32x4){bflo(w[q][j].x), bfhi(w[q][j].x), bflo(w[q][j].y), bfhi(w[q][j].y)} * r[q] * gv[j];
#if DBG_SANITIZE
                    for (int e = 0; e < 4; ++e) if (!(fabsf(o[e]) < 1e30f)) o[e] = 0.f;
#endif
                    p[64 * j] = o; } } }
    }
#undef IN
#undef SEAM
}

constexpr int NPHASE = 10;
extern "C" void kernel_launch(void* const* d_in, const int* in_sizes, int n_in, void* d_out, int out_size, void* d_ws, size_t ws_size, hipStream_t stream) {
    static int grid = 0;
    if (grid == 0) {
        if (n_in != 20 || out_size != M * D || ws_size < WS_END) { fprintf(stderr, "kernel_launch: unexpected shapes (n_in %d out %d ws %zu)\n", n_in, out_size, ws_size); grid = -1; return; }
        int dev = 0, cus = 0, per_cu = 0;
        hipGetDevice(&dev); hipDeviceGetAttribute(&cus, hipDeviceAttributeMultiprocessorCount, dev);
        hipFuncSetAttribute((const void*)hybrid_fwd, hipFuncAttributeMaxDynamicSharedMemorySize, LDS_BYTES);
        hipOccupancyMaxActiveBlocksPerMultiprocessor(&per_cu, (const void*)hybrid_fwd, 512, LDS_BYTES);
        if (per_cu < 1) { fprintf(stderr, "kernel_launch: occupancy query says %d blocks per CU\n", per_cu); per_cu = 1; }
        (void)hipGetLastError();
        grid = cus * 1;
        if (grid > cus * per_cu) grid = cus * per_cu;
    }
    if (grid <= 0) return;
    Args a{};
    for (int i = 0; i < 20; ++i) a.in[i] = (const float*)d_in[i];
    a.out = (float*)d_out; a.ws = (unsigned char*)d_ws;
#if MK_PER_PHASE
    for (int p = 0; p < NPHASE; ++p) { a.ph_lo = p; a.ph_hi = p + 1; hipLaunchKernelGGL(hybrid_fwd, dim3(grid), dim3(512), LDS_BYTES, stream, a); }
#else
    a.ph_lo = 0; a.ph_hi = NPHASE;
    (void)hipMemsetAsync((unsigned char*)d_ws + WS_BAR, 0, XCD_BAR_WORDS * 4, stream);
    void* args[] = {&a};
    hipError_t e = hipLaunchCooperativeKernel((const void*)hybrid_fwd, dim3(grid), dim3(512), args, LDS_BYTES, stream);
    if (e != hipSuccess) fprintf(stderr, "cooperative launch failed: %s (grid %d)\n", hipGetErrorString(e), grid);
#endif
}
```

```cpp
#include <hip/hip_runtime.h>
#include <hip/hip_cooperative_groups.h>
#include <cstdio>
#include <cstdint>
namespace cg = cooperative_groups;

#define DBG_SANITIZE 0
#define DBG_ATTN_COPY 0
#define DBG_ZERO_MASK 0
#define DBG_NO_FFN 0
#define DBG_TPHASE -1
#define DBG_TSCALE 1e-4f
#define DBG_REP5 1
#define DBG_XSYNC 0
#define DBG_DUP 0
#ifndef MK_PER_PHASE
#define MK_PER_PHASE 0
#endif

#define LAS __attribute__((address_space(3)))
typedef unsigned short bf16_t;
typedef short bf16x8 __attribute__((ext_vector_type(8)));
typedef short s16x4 __attribute__((ext_vector_type(4)));
typedef _Float16 f16x8 __attribute__((ext_vector_type(8)));
typedef float f32x4 __attribute__((ext_vector_type(4)));
typedef float f32x2 __attribute__((ext_vector_type(2)));
typedef unsigned u32x4 __attribute__((ext_vector_type(4)));
typedef unsigned u32x2 __attribute__((ext_vector_type(2)));

constexpr int M = 32768, D = 1024, SEQ = 2048, INW = 6656, MEMROWS = 4096, MEML = 256, DFF = 2816, NUP = 5632;
constexpr float EPS = 1e-6f;
constexpr size_t MiB = 1u << 20;
constexpr size_t WS_WIN = 0, WS_WKV = 13 * MiB, WS_WBR = 15 * MiB, WS_WO = 18 * MiB, WS_WUP = 20 * MiB, WS_WD = 31 * MiB;
constexpr size_t WS_RS1 = 37 * MiB, WS_RSM = WS_RS1 + 128 * 1024, WS_SSQ2 = WS_RS1 + 256 * 1024, WS_SSQ3 = WS_RS1 + 384 * 1024, WS_HD = 38 * MiB;
constexpr size_t WS_BAR = 39 * MiB;
constexpr size_t WS_XB = 48 * MiB;
constexpr size_t WS_MEMB = 112 * MiB, WS_KV = 120 * MiB;
constexpr size_t WS_HI = 128 * MiB, WS_HG = 160 * MiB, WS_XQ = 192 * MiB;
constexpr size_t WS_GATES = 224 * MiB;
constexpr size_t WS_AOUT = 416 * MiB, WS_BOUT = 448 * MiB, WS_COUT = 480 * MiB;
constexpr size_t WS_END = 512 * MiB;
constexpr int LDS_BYTES = 159744;

typedef __bf16 bf16x2_t __attribute__((ext_vector_type(2)));
__device__ __forceinline__ unsigned pk2(float lo, float hi) { f32x2 v = {lo, hi}; bf16x2_t b = __builtin_convertvector(v, bf16x2_t); return __builtin_bit_cast(unsigned, b); }
__device__ __forceinline__ int otid() { int t = threadIdx.x; asm volatile("" : "+v"(t)); return t; }
__device__ __forceinline__ float bflo(unsigned w) { return __uint_as_float(w << 16); }
__device__ __forceinline__ float bfhi(unsigned w) { return __uint_as_float(w & 0xffff0000u); }
__device__ __forceinline__ float fexp(float x) { return __builtin_amdgcn_exp2f(x * 1.4426950408889634f); }
__device__ __forceinline__ float fsigmoid(float x) { return __builtin_amdgcn_rcpf(1.0f + fexp(-x)); }
__device__ __forceinline__ float fsilu(float x) { return x * fsigmoid(x); }
__device__ __forceinline__ float fgelu(float x) { return x * fsigmoid(1.5957691216057308f * (x + 0.044715f * x * x * x)); }
__device__ __forceinline__ unsigned pkh2(float lo, float hi) { _Float16 a = (_Float16)lo, b = (_Float16)hi; return (unsigned)__builtin_bit_cast(unsigned short, a) | ((unsigned)__builtin_bit_cast(unsigned short, b) << 16); }
__device__ __forceinline__ float wave_sum(float v) {
#pragma unroll
    for (int o = 1; o < 64; o <<= 1) v += __shfl_xor(v, o);
    return v;
}
typedef short v4i16_t __attribute__((ext_vector_type(4)));
__device__ __forceinline__ s16x4 tr4(const LAS bf16_t* p) { return __builtin_bit_cast(s16x4, __builtin_amdgcn_ds_read_tr16_b64_v4i16((LAS v4i16_t*)p)); }
__device__ __forceinline__ bf16x8 tr8(const LAS bf16_t* tile, int P, int k0, int c0, int lane) {
    const int g = lane >> 4, q = (lane & 15) >> 2, p = lane & 3;
    const LAS bf16_t* a = tile + (k0 + 4 * g + q) * P + c0 + 4 * p;
    const s16x4 lo = tr4(a), hi = tr4(a + 16 * P);
    return (bf16x8){lo[0], lo[1], lo[2], lo[3], hi[0], hi[1], hi[2], hi[3]};
}
#define MFMA_BF16(a, b, c) __builtin_amdgcn_mfma_f32_16x16x32_bf16((a), (b), (c), 0, 0, 0)

namespace pg8 {
constexpr int BM = 256, BK = 64, HALF = 128, HTB = HALF * BK * 2, STAGE_BYTES = 8 * HTB, NXCD = 8, WGM = 8;
__host__ __device__ __forceinline__ int lds_byte(int r, int c) { const int st = (r >> 4) * 2 + (c >> 5), rr = r & 15, cc = c & 31, ob = rr * 64 + cc * 2; return st * 1024 + (ob ^ (((ob >> 9) & 1) << 5)); }
__host__ __device__ __forceinline__ void stage_rc(int b, int& R, int& C) { const int st = b / 1024, sb = b % 1024, swz = sb ^ (((sb >> 9) & 1) << 5); R = (st >> 1) * 16 + swz / 64; C = (st & 1) * 32 + (swz % 64) / 2; }
__host__ __device__ __forceinline__ int perm32(int rho) { const int n = rho >> 4, i = rho & 15; return 8 * (i >> 2) + 4 * n + (i & 3); }
struct Unit { int pm, pn, z; };
__device__ __forceinline__ void tile_map(int wgid, int nM, int nN, Unit& u) {
    const int nwg = nM * nN;
    { const int q = nwg / NXCD, r = nwg % NXCD, xcd = wgid % NXCD, off = wgid / NXCD; wgid = (xcd < r ? xcd * (q + 1) : r * (q + 1) + (xcd - r) * q) + off; }
    const int nig = WGM * nN, gid = wgid / nig, fm = gid * WGM, gsz = (nM - fm) < WGM ? (nM - fm) : WGM;
    u.pm = fm + ((wgid % nig) % gsz); u.pn = (wgid % nig) / gsz;
}
template <class Prob, class Epi, class Sched>
__device__ __forceinline__ void gemm_phase(LAS unsigned char* lds, const Prob& Pb, const Sched& S, const Epi& E, unsigned delay = 0) {
    if (delay) { const unsigned long long t0 = __builtin_amdgcn_s_memrealtime(); while (__builtin_amdgcn_s_memrealtime() - t0 < delay) __builtin_amdgcn_s_sleep(8); }
    const int tid = otid(), wid = __builtin_amdgcn_readfirstlane(tid >> 6), lane = tid & 63, wr = wid >> 2, wc = wid & 3, fr = lane & 15, fq = lane >> 4;
    const int K = Pb.K, nt = K / BK;
    unsigned voffA[2], voffB[2];
#pragma unroll
    for (int i = 0; i < 2; ++i) { int R, C; stage_rc(tid * 16 + i * 8192, R, C); const int Rb = Epi::PERM ? ((R & ~31) + perm32(R & 31)) : R;
        voffA[i] = (unsigned)(R * Pb.lda + C) * 2u; voffB[i] = (unsigned)(Rb * Pb.ldb + C) * 2u; }
    const size_t kstep = (size_t)(BK * 2);
    const size_t hsA = (size_t)HALF * Pb.lda * 2, hsB = (size_t)HALF * Pb.ldb * 2;
    const unsigned ldsw = (unsigned)wid * 1024u;
    const int aoff = lds_byte(wr * 64 + fr, fq * 8), boff = lds_byte(wc * 32 + fr, fq * 8);
#define PG8_SA(b, h) (((b) * 2 + (h)) * HTB)
#define PG8_SB(b, h) ((4 + (b) * 2 + (h)) * HTB)
#define PG8_STAGE(bufoff, gbase, voff) do { _Pragma("unroll") for (int _i = 0; _i < 2; ++_i) \
        __builtin_amdgcn_global_load_lds((const unsigned*)((const char*)(gbase) + (voff)[_i]), (LAS unsigned*)(lds + (bufoff) + ldsw + _i * 8192), 16, 0, 0); } while (0)
#define PG8_LDA(dst, b, h) do { _Pragma("unroll") for (int m = 0; m < 4; ++m) _Pragma("unroll") for (int k = 0; k < 2; ++k) dst[m][k] = *(const LAS bf16x8*)(lds + PG8_SA(b, h) + aoff + m * 2048 + k * 1024); } while (0)
#define PG8_LDB(dst, b, h) do { _Pragma("unroll") for (int n = 0; n < 2; ++n) _Pragma("unroll") for (int k = 0; k < 2; ++k) dst[n][k] = *(const LAS bf16x8*)(lds + PG8_SB(b, h) + boff + n * 2048 + k * 1024); } while (0)
#define PG8_MMA(ai, bj, At, Bt) do { __builtin_amdgcn_s_setprio(1); _Pragma("unroll") for (int m = 0; m < 4; ++m) _Pragma("unroll") for (int n = 0; n < 2; ++n) _Pragma("unroll") for (int k = 0; k < 2; ++k) \
        acc[ai][bj][m][n] = __builtin_amdgcn_mfma_f32_16x16x32_bf16(Bt[n][k], At[m][k], acc[ai][bj][m][n], 0, 0, 0); __builtin_amdgcn_s_setprio(0); } while (0)
#define PG8_WAIT_V(n) asm volatile("s_waitcnt vmcnt(" #n ")" ::: "memory")
#define PG8_WAIT_L(n) asm volatile("s_waitcnt lgkmcnt(" #n ")" ::: "memory")
#define PG8_BAR __builtin_amdgcn_s_barrier()
#define PG8_SCHED __builtin_amdgcn_sched_barrier(0)
    Unit cur, nxt; int ui = 0;
    if (!S.next(0, cur)) return;
    f32x4 acc[2][2][4][2];
#pragma unroll
    for (int a = 0; a < 2; ++a)
#pragma unroll
        for (int b = 0; b < 2; ++b)
#pragma unroll
            for (int m = 0; m < 4; ++m)
#pragma unroll
                for (int n = 0; n < 2; ++n) acc[a][b][m][n] = (f32x4){0.f, 0.f, 0.f, 0.f};
    bf16x8 At[4][2], B0[2][2], B1[2][2];
    const char* cA = Pb.a(cur); const char* cB = Pb.b(cur);
    PG8_STAGE(PG8_SB(0, 0), cB, voffB); PG8_STAGE(PG8_SB(0, 1), cB + hsB, voffB); PG8_STAGE(PG8_SA(0, 0), cA, voffA); PG8_STAGE(PG8_SA(0, 1), cA + hsA, voffA);
    if (wr == 1) PG8_BAR;
    PG8_WAIT_V(2); PG8_BAR;
    PG8_STAGE(PG8_SB(1, 0), cB + kstep, voffB); PG8_STAGE(PG8_SA(1, 0), cA + kstep, voffA); PG8_STAGE(PG8_SB(1, 1), cB + hsB + kstep, voffB);
    PG8_WAIT_V(6); PG8_BAR;
    for (;;) {
        const bool has_next = S.next(ui + 1, nxt);
        const char* nA = has_next ? Pb.a(nxt) : cA; const char* nB = has_next ? Pb.b(nxt) : cB;
        for (int t = 0; t < nt; t += 2) {
            const bool last = (t == nt - 2);
            const char* a1 = cA + (size_t)(t + 1) * kstep;
            const char* a2 = last ? nA : cA + (size_t)(t + 2) * kstep; const char* b2 = last ? nB : cB + (size_t)(t + 2) * kstep;
            const char* a3 = a2 + kstep; const char* b3 = b2 + kstep;
            PG8_LDB(B0, 0, 0); PG8_LDB(B1, 0, 1); PG8_SCHED; PG8_LDA(At, 0, 0); PG8_STAGE(PG8_SA(1, 1), a1 + hsA, voffA);
            PG8_WAIT_V(8); PG8_WAIT_L(0); PG8_BAR; PG8_MMA(0, 0, At, B0); PG8_MMA(0, 1, At, B1); PG8_BAR; PG8_SCHED;
            PG8_LDA(At, 0, 1); PG8_STAGE(PG8_SB(0, 0), b2, voffB); PG8_STAGE(PG8_SB(0, 1), b2 + hsB, voffB); PG8_STAGE(PG8_SA(0, 0), a2, voffA);
            PG8_WAIT_V(8); PG8_WAIT_L(0); PG8_BAR; PG8_MMA(1, 0, At, B0); PG8_MMA(1, 1, At, B1); PG8_BAR; PG8_SCHED;
            PG8_LDB(B0, 1, 0); PG8_LDB(B1, 1, 1); PG8_SCHED; PG8_LDA(At, 1, 0); PG8_STAGE(PG8_SA(0, 1), a2 + hsA, voffA);
            PG8_WAIT_V(8); PG8_WAIT_L(0); PG8_BAR; PG8_MMA(0, 0, At, B0); PG8_MMA(0, 1, At, B1); PG8_BAR; PG8_SCHED;
            PG8_LDA(At, 1, 1); PG8_STAGE(PG8_SB(1, 0), b3, voffB); PG8_STAGE(PG8_SB(1, 1), b3 + hsB, voffB); PG8_STAGE(PG8_SA(1, 0), a3, voffA);
            PG8_WAIT_V(8); PG8_WAIT_L(0); PG8_BAR; PG8_MMA(1, 0, At, B0); PG8_MMA(1, 1, At, B1); PG8_BAR; PG8_SCHED;
        }
        if (wr == 0) PG8_BAR;
        const bool keep = E(acc, cur, wr, wc, fr, fq);
        if (!has_next) break;
        if (!keep) {
#pragma unroll
        for (int a = 0; a < 2; ++a)
#pragma unroll
            for (int b = 0; b < 2; ++b)
#pragma unroll
                for (int m = 0; m < 4; ++m)
#pragma unroll
                    for (int n = 0; n < 2; ++n) acc[a][b][m][n] = (f32x4){0.f, 0.f, 0.f, 0.f};
        }
        cur = nxt; cA = nA; cB = nB; ++ui;
        if (wr == 1) PG8_BAR;
    }
    PG8_WAIT_V(0);
    PG8_BAR;
#undef PG8_SA
#undef PG8_SB
#undef PG8_STAGE
#undef PG8_LDA
#undef PG8_LDB
#undef PG8_MMA
#undef PG8_WAIT_V
#undef PG8_WAIT_L
#undef PG8_BAR
#undef PG8_SCHED
}
}
using pg8::Unit;

#define XB_TMO      128
#define XB_XCNT(j)  (256  + 64 * (j))
#define XB_XSUB(j)  (1280 + 64 * (j))
#define XB_XGEN(j)  (2304 + 64 * (j))
#define XB_TOP      3328
#define XB_TOPGEN   3392
#define XCD_BAR_WORDS 3456
#define XB_SPIN_CAP (1u << 18)
__device__ __forceinline__ unsigned xb_ld(unsigned* p)              { return __hip_atomic_load(p, __ATOMIC_RELAXED, __HIP_MEMORY_SCOPE_AGENT); }
__device__ __forceinline__ unsigned xb_add(unsigned* p, unsigned v) { return __hip_atomic_fetch_add(p, v, __ATOMIC_RELAXED, __HIP_MEMORY_SCOPE_AGENT); }
__device__ __forceinline__ unsigned xb_xcc_id() { return (unsigned)__builtin_amdgcn_s_getreg((3 << 11) | 20) & 0xFu; }
#define XB_SPIN(cond, bar) do { unsigned _sp = 0; while (cond) { __builtin_amdgcn_s_sleep(1); \
    if ((++_sp & 255u) == 0u) { if (xb_ld(&(bar)[XB_TMO])) break; if (_sp > XB_SPIN_CAP) { atomicAdd(&(bar)[XB_TMO], 1u); break; } } } } while (0)
struct XcdBarrier { unsigned* bar; unsigned x; volatile LAS unsigned* st; };
__device__ __forceinline__ XcdBarrier xcd_barrier_post(unsigned* bar, volatile LAS unsigned* st) {
    XcdBarrier b; b.bar = bar; b.x = xb_xcc_id(); b.st = st;
    if (threadIdx.x == 0) (void)xb_add(&bar[XB_XCNT(b.x)], 1u);
    return b;
}
__device__ __forceinline__ void xcd_barrier_complete(unsigned* bar, unsigned x, unsigned& nloc, unsigned& nx) {
    const unsigned G = gridDim.x * gridDim.y * gridDim.z;
    unsigned sum, cnt, mine, sp = 0u;
    for (;;) {
        sum = 0u; cnt = 0u; mine = 0u;
#pragma unroll
        for (unsigned j = 0; j < 16; ++j) { const unsigned c = xb_ld(&bar[XB_XCNT(j)]); sum += c; cnt += (c > 0u) ? 1u : 0u; mine = (j == x) ? c : mine; }
        if (sum == G) break;
        __builtin_amdgcn_s_sleep(1);
        if ((++sp & 255u) == 0u) { if (xb_ld(&bar[XB_TMO])) break; if (sp > XB_SPIN_CAP) { atomicAdd(&bar[XB_TMO], 1u); break; } }
    }
    nloc = mine > 0u ? mine : 1u; nx = cnt > 0u ? cnt : 1u;
}
__device__ __forceinline__ void xcd_barrier(const XcdBarrier& b) {
    asm volatile("s_waitcnt vmcnt(0)" ::: "memory");
    __syncthreads();
    if (threadIdx.x == 0) {
        unsigned* bar = b.bar;
        __builtin_amdgcn_s_waitcnt(0);
        unsigned nloc = b.st[0], nx = b.st[1];
        if (nloc == 0u) { xcd_barrier_complete(bar, b.x, nloc, nx); b.st[0] = nloc; b.st[1] = nx; }
        const unsigned old = xb_add(&bar[XB_XSUB(b.x)], 1u);
        const unsigned gen = old / nloc;
        if (old + 1u == (gen + 1u) * nloc) {
            __builtin_amdgcn_fence(__ATOMIC_RELEASE, "agent");
            asm volatile("s_waitcnt vmcnt(0)" ::: "memory");
            const unsigned og = xb_add(&bar[XB_TOP], 1u);
            const unsigned tg = og / nx;
            if (og + 1u == (tg + 1u) * nx) xb_add(&bar[XB_TOPGEN], 1u);
            else XB_SPIN(xb_ld(&bar[XB_TOPGEN]) == tg, bar);
            __builtin_amdgcn_fence(__ATOMIC_ACQUIRE, "agent");
            xb_add(&bar[XB_XGEN(b.x)], 1u);
            asm volatile("s_waitcnt vmcnt(0)" ::: "memory");
        } else {
            XB_SPIN(xb_ld(&bar[XB_XGEN(b.x)]) == gen, bar);
            __builtin_amdgcn_fence(__ATOMIC_ACQUIRE, "agent");
            asm volatile("s_waitcnt vmcnt(0)" ::: "memory");
        }
    }
    __syncthreads();
}

constexpr int NPHASE_K = 10;
struct Args { const float* in[20]; float* out; unsigned char* ws; int ph_lo, ph_hi; };
enum { I_X = 0, I_MEM, I_N1G, I_WIN, I_LNG, I_LNB, I_WSP, I_BSP, I_LB, I_HNG, I_MNG, I_WKV, I_WBR, I_WOUT, I_N2G, I_WUP, I_CW, I_CB, I_WDN, I_FG };

template <int MAP> __device__ __forceinline__ void transpose_item(const float* W, int K, int N, bf16_t* WT, const float* sk, LAS float* scr, int item, int lane) {
    const int nblk = N / 64, kb = item / nblk, nb = item % nblk, k0 = 64 * kb, n0 = 64 * nb;
    f32x4 v[16];
#pragma unroll
    for (int i = 0; i < 16; ++i) v[i] = *(const f32x4*)(W + (size_t)(k0 + 4 * i + (lane >> 4)) * N + n0 + 4 * (lane & 15));
#pragma unroll
    for (int i = 0; i < 16; ++i) { const int kk = 4 * i + (lane >> 4); f32x4 x = v[i]; if (sk) x = x * sk[k0 + kk]; LAS float* d = scr + kk * 65 + 4 * (lane & 15); d[0] = x[0]; d[1] = x[1]; d[2] = x[2]; d[3] = x[3]; }
    asm volatile("s_waitcnt lgkmcnt(0)" ::: "memory");
    const int c = lane & 7;
    int r0 = n0;
    if (MAP == 1) { const int half = n0 >= DFF, ch = n0 - half * DFF; r0 = 256 * (ch >> 7) + 128 * half + (ch & 127); }
#pragma unroll
    for (int j = 0; j < 8; ++j) { const int n = (lane >> 3) + 8 * j; const LAS float* p = scr + (8 * c) * 65 + n;
        u32x4 o; o.x = pk2(p[0 * 65], p[1 * 65]); o.y = pk2(p[2 * 65], p[3 * 65]); o.z = pk2(p[4 * 65], p[5 * 65]); o.w = pk2(p[6 * 65], p[7 * 65]);
        *(u32x4*)(WT + (size_t)(r0 + n) * K + k0 + 8 * c) = o; }
    asm volatile("s_waitcnt lgkmcnt(0)" ::: "memory");
}
__device__ __forceinline__ void rows4_to_bf16(const float* x, bf16_t* o, float* rs, int m0, int lane) {
    f32x4 v[4][4];
#pragma unroll
    for (int r = 0; r < 4; ++r)
#pragma unroll
        for (int j = 0; j < 4; ++j) v[r][j] = *((const f32x4*)(x + (size_t)(m0 + r) * D) + lane + 64 * j);
#pragma unroll
    for (int r = 0; r < 4; ++r) { float q = 0.f;
#pragma unroll
        for (int j = 0; j < 4; ++j) q += (v[r][j].x * v[r][j].x + v[r][j].y * v[r][j].y) + (v[r][j].z * v[r][j].z + v[r][j].w * v[r][j].w);
        q = wave_sum(q);
        if (lane == 0) rs[m0 + r] = 1.0f / sqrtf(q * (1.0f / D) + EPS);
        u32x2* o8 = (u32x2*)(o + (size_t)(m0 + r) * D) + lane;
#pragma unroll
        for (int j = 0; j < 4; ++j) o8[64 * j] = (u32x2){pk2(v[r][j].x, v[r][j].y), pk2(v[r][j].z, v[r][j].w)}; }
}
__device__ __forceinline__ void p0_prologue(const Args& A, LAS unsigned char* lds) {
    const int tid = otid(), lane = tid & 63, wave = tid >> 6;
    LAS float* scr = (LAS float*)(lds + wave * 16896);
    const int gw = blockIdx.x * 8 + wave, NGW = gridDim.x * 8;
    unsigned char* ws = A.ws;
    constexpr int I0 = 16 * (INW / 64), I1 = 16 * 16, I2 = 8 * 16, I3 = 16 * 16, I4 = 16 * (NUP / 64), I5 = (DFF / 64) * 16;
    constexpr int NITEMS = I0 + I1 + 3 * I2 + I3 + I4 + I5;
    for (int it = gw; it < NITEMS; it += NGW) {
        int r = it;
        if (r < I0) { transpose_item<0>(A.in[I_WIN], D, INW, (bf16_t*)(ws + WS_WIN), A.in[I_N1G], scr, r, lane); continue; } r -= I0;
        if (r < I1) { transpose_item<0>(A.in[I_WKV], D, 1024, (bf16_t*)(ws + WS_WKV), A.in[I_MNG], scr, r, lane); continue; } r -= I1;
        if (r < 3 * I2) { const int z = r / I2; transpose_item<0>(A.in[I_WBR] + (size_t)z * 512 * 1024, 512, 1024, (bf16_t*)(ws + WS_WBR) + (size_t)z * 1024 * 512, nullptr, scr, r % I2, lane); continue; } r -= 3 * I2;
        if (r < I3) { transpose_item<0>(A.in[I_WOUT], D, D, (bf16_t*)(ws + WS_WO), nullptr, scr, r, lane); continue; } r -= I3;
        if (r < I4) { transpose_item<1>(A.in[I_WUP], D, NUP, (bf16_t*)(ws + WS_WUP), A.in[I_N2G], scr, r, lane); continue; } r -= I4;
        transpose_item<0>(A.in[I_WDN], DFF, D, (bf16_t*)(ws + WS_WD), nullptr, scr, r, lane);
    }
    for (int m = 4 * gw; m < M; m += 4 * NGW) rows4_to_bf16(A.in[I_X], (bf16_t*)(ws + WS_XB), (float*)(ws + WS_RS1), m, lane);
    for (int m = 4 * gw; m < MEMROWS; m += 4 * NGW) rows4_to_bf16(A.in[I_MEM], (bf16_t*)(ws + WS_MEMB), (float*)(ws + WS_RSM), m, lane);
    for (int i = blockIdx.x * 512 + tid; i < 2 * M; i += gridDim.x * 512) ((float*)(ws + WS_SSQ2))[i] = 0.f;
}

struct ProbP1 { int K, lda, ldb; const bf16_t *xb, *memb, *win, *wkv;
    __device__ __forceinline__ const char* a(const Unit& u) const { return (const char*)((u.z ? memb : xb) + (size_t)u.pm * 256 * 1024); }
    __device__ __forceinline__ const char* b(const Unit& u) const { return (const char*)((u.z ? wkv : win) + (size_t)u.pn * 256 * 1024); } };
struct SchedP1 { int G, c;
    __device__ __forceinline__ bool next(int i, Unit& u) const { const int L = i * G + c; if (L >= 3328) return false; pg8::tile_map(L, 128, 26, u); u.z = 0; return true; } };
struct SchedKV { int G, c;
    __device__ __forceinline__ bool next(int i, Unit& u) const { const int L = i * G + c; if (L >= 64) return false; u.pm = L & 15; u.pn = L >> 4; u.z = 0; return true; } };
template <int MODE> __device__ __forceinline__ void p1_store(const f32x4 (&acc)[2][2][4][2], const float* rs, int row0, bf16_t* dst, int ldc, int col0, float sc, const float* lbl, int lcol0) {
    float lb[2][8];
    if (MODE == 4) {
#pragma unroll
        for (int bj = 0; bj < 2; ++bj)
#pragma unroll
            for (int j = 0; j < 8; ++j) { const int c = lcol0 + bj * 128 + j; lb[bj][j] = fsigmoid(lbl[c] - lbl[512 + c]); }
    }
    float rsv[2][4];
#pragma unroll
    for (int ai = 0; ai < 2; ++ai)
#pragma unroll
        for (int m = 0; m < 4; ++m) rsv[ai][m] = rs[row0 + ai * 128 + m * 16];
    __builtin_amdgcn_sched_barrier(0);
#pragma unroll
    for (int ai = 0; ai < 2; ++ai)
#pragma unroll
        for (int m = 0; m < 4; ++m) { const int row = row0 + ai * 128 + m * 16; const float r = rsv[ai][m]; bf16_t* rowp = dst + (size_t)row * ldc + col0;
#pragma unroll
            for (int bj = 0; bj < 2; ++bj) { float v[8];
#pragma unroll
                for (int j = 0; j < 8; ++j) { float x = acc[ai][bj][m][j >> 2][j & 3] * r;
                    if (MODE == 0) x *= sc; if (MODE == 1) x = fgelu(x); if (MODE == 2) x = fsilu(x); if (MODE == 3) x = fsigmoid(x);
                    if (MODE == 4) { const float fg = lb[bj][j] + (1.0f - lb[bj][j]) * fsigmoid(x); x = __logf(fg); }
                    v[j] = x; }
                u32x4 w;
                if (MODE == 4) { w.x = pkh2(v[0], v[1]); w.y = pkh2(v[2], v[3]); w.z = pkh2(v[4], v[5]); w.w = pkh2(v[6], v[7]); }
                else { w.x = pk2(v[0], v[1]); w.y = pk2(v[2], v[3]); w.z = pk2(v[4], v[5]); w.w = pk2(v[6], v[7]); }
                *(u32x4*)(rowp + bj * 128) = w; } }
}
struct EpiP1 { static constexpr bool PERM = true;
    const float *rs1, *rsm, *lbl; bf16_t *U, *V, *HQ, *HF, *HI, *HG, *XQ, *GATES, *KV;
    __device__ __forceinline__ bool operator()(f32x4 (&acc)[2][2][4][2], const Unit& u, int wr, int wc, int fr, int fq) const {
        const int row0 = u.pm * 256 + wr * 64 + fr, cw = wc * 32 + 8 * fq;
        const int seg = u.pn >> 1, col0 = (u.pn & 1) * 256 + cw;
        if (u.pn >= 14) { p1_store<3>(acc, rs1, row0, GATES, 3072, (u.pn - 14) * 256 + cw, 1.f, nullptr, 0); return false; }
        switch (seg) {
            case 0: p1_store<1>(acc, rs1, row0, U, 512, col0, 1.f, nullptr, 0); break;
            case 1: p1_store<1>(acc, rs1, row0, V, 512, col0, 1.f, nullptr, 0); break;
            case 2: p1_store<2>(acc, rs1, row0, HQ, 512, col0, 1.f, nullptr, 0); break;
            case 3: p1_store<4>(acc, rs1, row0, HF, 512, col0, 1.f, lbl, col0); break;
            case 4: p1_store<0>(acc, rs1, row0, HI, 512, col0, 1.f, nullptr, 0); break;
            case 5: p1_store<2>(acc, rs1, row0, HG, 512, col0, 1.f, nullptr, 0); break;
            default: p1_store<0>(acc, rs1, row0, XQ, 512, col0, 0.08838834764831845f * 1.4426950408889634f, nullptr, 0); break;
        }
        return false;
    }
};

struct EpiKV { static constexpr bool PERM = true; const float* rsm; bf16_t* KV;
    __device__ __forceinline__ bool operator()(f32x4 (&acc)[2][2][4][2], const Unit& u, int wr, int wc, int fr, int fq) const {
        p1_store<0>(acc, rsm, u.pm * 256 + wr * 64 + fr, KV, 1024, u.pn * 256 + wc * 32 + 8 * fq, 1.0f, nullptr, 0); return false; } };
struct ProbN { int K, lda, ldb; const bf16_t *A_, *B_;
    __device__ __forceinline__ const char* a(const Unit& u) const { return (const char*)(A_ + (size_t)u.pm * 256 * lda); }
    __device__ __forceinline__ const char* b(const Unit& u) const { return (const char*)(B_ + (size_t)u.pn * 256 * ldb); } };
__device__ __forceinline__ void attn_item(int item, const bf16_t* XQ, const bf16_t* KV, bf16_t* COUT, LAS unsigned char* lds) {
    const int tid = otid(), lane = tid & 63, wave = tid >> 6, g = lane >> 4, l15 = lane & 15;
    const int qt = item & 15, h = (item >> 4) & 3, b = item >> 6;
    LAS bf16_t* Ks = (LAS bf16_t*)lds; LAS bf16_t* Vs = Ks + 256 * 144;
#pragma unroll
    for (int i = 0; i < 8; ++i) { const int idx = tid + 512 * i, row = idx >> 4, ch = idx & 15;
        const bf16_t* src = KV + (size_t)(b * 256 + row) * 1024 + h * 128 + ch * 8;
        *(LAS u32x4*)(Ks + row * 144 + ch * 8) = *(const u32x4*)src; *(LAS u32x4*)(Vs + row * 144 + ch * 8) = *(const u32x4*)(src + 512); }
    const int t = b * SEQ + qt * 128 + wave * 16 + l15;
#if DBG_ATTN_COPY
    { __syncthreads(); const int rr = tid >> 2, cc = (tid & 3) * 32; const size_t o = (size_t)(b * SEQ + qt * 128 + rr) * 512 + h * 128 + cc;
      for (int e = 0; e < 4; ++e) *(u32x4*)(COUT + o + 8 * e) = *(const u32x4*)(KV + (size_t)((b * 256 + ((qt * 128 + rr) & 255))) * 1024 + (qt & 1) * 512 + h * 128 + cc + 8 * e);
      __syncthreads(); return; }
#endif
    bf16x8 Qf[4];
#pragma unroll
    for (int ks = 0; ks < 4; ++ks) Qf[ks] = *(const bf16x8*)(XQ + (size_t)t * 512 + h * 128 + 32 * ks + 8 * g);
    __syncthreads();
    f32x4 s[16];
#pragma unroll
    for (int i = 0; i < 16; ++i) { s[i] = (f32x4){0.f, 0.f, 0.f, 0.f};
#pragma unroll
        for (int ks = 0; ks < 4; ++ks) { const bf16x8 a = *(const LAS bf16x8*)(Ks + (16 * i + l15) * 144 + 32 * ks + 8 * g); s[i] = MFMA_BF16(a, Qf[ks], s[i]); } }
    float mx = -3.0e38f;
#pragma unroll
    for (int i = 0; i < 16; ++i) mx = fmaxf(fmaxf(fmaxf(s[i][0], s[i][1]), fmaxf(s[i][2], s[i][3])), mx);
    mx = fmaxf(mx, __shfl_xor(mx, 16)); mx = fmaxf(mx, __shfl_xor(mx, 32));
    float sum = 0.f;
#pragma unroll
    for (int i = 0; i < 16; ++i)
#pragma unroll
        for (int r = 0; r < 4; ++r) { const float p = __builtin_amdgcn_exp2f(s[i][r] - mx); s[i][r] = p; sum += p; }
    sum += __shfl_xor(sum, 16); sum += __shfl_xor(sum, 32);
    const float inv = 1.0f / sum;
    bf16x8 Pf[8];
#pragma unroll
    for (int kk = 0; kk < 8; ++kk) { u32x4 w; w.x = pk2(s[2 * kk][0] * inv, s[2 * kk][1] * inv); w.y = pk2(s[2 * kk][2] * inv, s[2 * kk][3] * inv);
        w.z = pk2(s[2 * kk + 1][0] * inv, s[2 * kk + 1][1] * inv); w.w = pk2(s[2 * kk + 1][2] * inv, s[2 * kk + 1][3] * inv); Pf[kk] = __builtin_bit_cast(bf16x8, w); }
    bf16_t* orow = COUT + (size_t)t * 512 + h * 128 + 4 * g;
#pragma unroll
    for (int dt = 0; dt < 8; ++dt) { f32x4 o = (f32x4){0.f, 0.f, 0.f, 0.f};
#pragma unroll
        for (int kk = 0; kk < 8; ++kk) { const bf16x8 a = tr8(Vs, 144, 32 * kk, 16 * dt, lane); o = MFMA_BF16(a, Pf[kk], o); }
        *(u32x2*)(orow + 16 * dt) = (u32x2){pk2(o[0], o[1]), pk2(o[2], o[3])}; }
    __syncthreads();
}
__device__ __forceinline__ void sgu_item(int item, const bf16_t* U, const bf16_t* V, const float* lng, const float* lnb, const float* wsp, const float* bsp, bf16_t* AOUT, LAS unsigned char* lds) {
    const int tid = otid(), lane = tid & 63, wave = tid >> 6, g = lane >> 4, l15 = lane & 15;
    const int t0 = item * 128;
    LAS bf16_t* vn = (LAS bf16_t*)lds;
    { float gg[8], bb[8];
#pragma unroll
      for (int j = 0; j < 8; ++j) { gg[j] = lng[8 * lane + j]; bb[j] = lnb[8 * lane + j]; }
#pragma unroll 4
      for (int i = 0; i < 16; ++i) { const int srow = wave * 16 + i; const u32x4 w = *(const u32x4*)(V + (size_t)(t0 + srow) * 512 + 8 * lane);
        float v[8] = {bflo(w.x), bfhi(w.x), bflo(w.y), bfhi(w.y), bflo(w.z), bfhi(w.z), bflo(w.w), bfhi(w.w)};
        float s = 0.f;
#pragma unroll
        for (int j = 0; j < 8; ++j) s += v[j];
        const float mu = wave_sum(s) * (1.0f / 512.0f); float q = 0.f;
#pragma unroll
        for (int j = 0; j < 8; ++j) { v[j] -= mu; q += v[j] * v[j]; }
        const float rstd = 1.0f / sqrtf(wave_sum(q) * (1.0f / 512.0f) + EPS);
#pragma unroll
        for (int j = 0; j < 8; ++j) v[j] = v[j] * rstd * gg[j] + bb[j];
        *(LAS u32x4*)(vn + srow * 528 + 8 * lane) = (u32x4){pk2(v[0], v[1]), pk2(v[2], v[3]), pk2(v[4], v[5]), pk2(v[6], v[7])}; } }
    __syncthreads();
    const int tl = wave * 16 + l15, nks = (wave >> 1) + 1;
#pragma unroll 1
    for (int g4 = 0; g4 < 4; ++g4) {
        bf16x8 Wf[4];
#pragma unroll
        for (int ks = 0; ks < 4; ++ks) { Wf[ks] = (bf16x8){0, 0, 0, 0, 0, 0, 0, 0};
            if (ks < nks) { const float* wp = wsp + (size_t)(g4 * 128 + tl) * 128 + 32 * ks + 4 * g; const f32x4 w0 = *(const f32x4*)wp, w1 = *(const f32x4*)(wp + 16);
                const int s0 = 32 * ks + 4 * g, s1 = s0 + 16; float e[8];
#pragma unroll
                for (int j = 0; j < 4; ++j) { e[j] = (s0 + j <= tl) ? w0[j] : 0.f; e[4 + j] = (s1 + j <= tl) ? w1[j] : 0.f; }
                const u32x4 w = (u32x4){pk2(e[0], e[1]), pk2(e[2], e[3]), pk2(e[4], e[5]), pk2(e[6], e[7])}; Wf[ks] = __builtin_bit_cast(bf16x8, w); } }
        const float bias = bsp[g4 * 128 + tl];
#pragma unroll
        for (int ct = 0; ct < 8; ++ct) { const int c0 = g4 * 128 + 16 * ct; f32x4 acc = (f32x4){0.f, 0.f, 0.f, 0.f};
#pragma unroll
            for (int ks = 0; ks < 4; ++ks) if (ks < nks) { const bf16x8 a = tr8(vn, 528, 32 * ks, c0, lane); acc = MFMA_BF16(a, Wf[ks], acc); }
            const size_t o = (size_t)(t0 + tl) * 512 + c0 + 4 * g; const u32x2 uw = *(const u32x2*)(U + o);
            *(u32x2*)(AOUT + o) = (u32x2){pk2(bflo(uw.x) * (acc[0] + bias), bfhi(uw.x) * (acc[1] + bias)), pk2(bflo(uw.y) * (acc[2] + bias), bfhi(uw.y) * (acc[3] + bias))}; }
    }
    __syncthreads();
}
constexpr int H_LF = 0, H_A = 18432, H_T0 = 52224, H_T1 = 70656, H_T2 = 89088, H_VS = 107520, H_RED = 125952;
#define LDS_SYNC() do { asm volatile("s_waitcnt lgkmcnt(0)" ::: "memory"); __builtin_amdgcn_s_barrier(); asm volatile("" ::: "memory"); } while (0)
struct HTile { u32x4 lf[2], vs[2]; };
__device__ __forceinline__ void hgrn_issue(int item, const bf16_t* HF, const bf16_t* HI, HTile& T) {
    const int tid = otid(), n = item & 31, bh = item >> 5, t0 = (bh >> 2) * SEQ + n * 64, cb = (bh & 3) * 128;
#pragma unroll
    for (int i = 0; i < 2; ++i) { const int idx = tid + 512 * i, row = idx >> 4, ch = idx & 15; const size_t o = (size_t)(t0 + row) * 512 + cb + ch * 8;
        T.lf[i] = *(const u32x4*)(HF + o); T.vs[i] = *(const u32x4*)(HI + o); }
}
__device__ __forceinline__ void hgrn_store_cumsum(const HTile& T, LAS unsigned char* lds) {
    const int tid = otid(), lane = tid & 63, wave = tid >> 6, g = lane >> 4, l15 = lane & 15;
    LAS bf16_t* LF = (LAS bf16_t*)(lds + H_LF); LAS bf16_t* VS = (LAS bf16_t*)(lds + H_VS); LAS float* A_ = (LAS float*)(lds + H_A);
#pragma unroll
    for (int i = 0; i < 2; ++i) { const int idx = tid + 512 * i, row = idx >> 4, ch = idx & 15;
        *(LAS u32x4*)(LF + row * 144 + ch * 8) = T.lf[i]; *(LAS u32x4*)(VS + row * 144 + ch * 8) = T.vs[i]; }
    LDS_SYNC();
    f16x8 Bf[2];
#pragma unroll
    for (int ks = 0; ks < 2; ++ks) Bf[ks] = __builtin_bit_cast(f16x8, tr8(LF, 144, 32 * ks, 16 * wave, lane));
#pragma unroll
    for (int tt = 0; tt < 4; ++tt) { f32x4 acc = (f32x4){0.f, 0.f, 0.f, 0.f}; const int t = 16 * tt + l15;
#pragma unroll
        for (int ks = 0; ks < 2; ++ks) { f16x8 a;
#pragma unroll
            for (int j = 0; j < 8; ++j) { const int sI = 32 * ks + 4 * g + (j & 3) + 16 * (j >> 2); a[j] = (sI <= t) ? (_Float16)1.0f : (_Float16)0.0f; }
            acc = __builtin_amdgcn_mfma_f32_16x16x32_f16(a, Bf[ks], acc, 0, 0, 0); }
#pragma unroll
        for (int r = 0; r < 4; ++r) A_[(16 * tt + 4 * g + r) * 132 + 16 * wave + l15] = acc[r]; }
    LDS_SYNC();
}
__device__ __forceinline__ float h2f(unsigned short h) { return (float)__builtin_bit_cast(_Float16, h); }
__device__ __forceinline__ void hgrn1_phase(int c, int G, const bf16_t* HF, const bf16_t* HI, bf16_t* GS, float* HD, LAS unsigned char* lds) {
    const int tid = otid(), lane = tid & 63, wave = tid >> 6, g = lane >> 4, l15 = lane & 15;
    LAS bf16_t* LF = (LAS bf16_t*)(lds + H_LF); LAS bf16_t* VS = (LAS bf16_t*)(lds + H_VS); LAS float* A_ = (LAS float*)(lds + H_A); LAS bf16_t* KD = (LAS bf16_t*)(lds + H_T0);
    HTile T;
    if (c < 2048) hgrn_issue(c, HF, HI, T);
#pragma unroll 1
    for (int item = c; item < 2048; item += G) {
        hgrn_store_cumsum(T, lds);
        if (item + G < 2048) hgrn_issue(item + G, HF, HI, T);
        { const int t = tid >> 3, kc = (tid & 7) * 16; unsigned w[8];
          f32x4 av[4], alv[4];
#pragma unroll
          for (int j = 0; j < 4; ++j) { av[j] = *(const LAS f32x4*)(A_ + t * 132 + kc + 4 * j); alv[j] = *(const LAS f32x4*)(A_ + 63 * 132 + kc + 4 * j); }
          const u32x4 l0 = *(const LAS u32x4*)(LF + t * 144 + kc), l1 = *(const LAS u32x4*)(LF + t * 144 + kc + 8);
          const unsigned lw[8] = {l0.x, l0.y, l0.z, l0.w, l1.x, l1.y, l1.z, l1.w};
#pragma unroll
          for (int e = 0; e < 16; e += 2) { float o[2];
#pragma unroll
            for (int d = 0; d < 2; ++d) { const int ee = e + d; const float a = av[ee >> 2][ee & 3], al = alv[ee >> 2][ee & 3], lf = h2f((unsigned short)(lw[e >> 1] >> (16 * d))); o[d] = (1.0f - fexp(lf)) * fexp(al - a); }
            w[e >> 1] = pk2(o[0], o[1]); }
          *(LAS u32x4*)(KD + t * 144 + kc) = (u32x4){w[0], w[1], w[2], w[3]}; *(LAS u32x4*)(KD + t * 144 + kc + 8) = (u32x4){w[4], w[5], w[6], w[7]};
          if (tid < 128) HD[(size_t)item * 128 + tid] = fexp(A_[63 * 132 + tid]); }
        LDS_SYNC();
        bf16x8 Af[2];
#pragma unroll
        for (int ks = 0; ks < 2; ++ks) Af[ks] = tr8(KD, 144, 32 * ks, 16 * wave, lane);
        bf16_t* gp = GS + (size_t)item * 16384 + 16 * wave + 4 * g;
#pragma unroll
        for (int vt = 0; vt < 8; ++vt) { f32x4 acc = (f32x4){0.f, 0.f, 0.f, 0.f};
#pragma unroll
            for (int ks = 0; ks < 2; ++ks) { const bf16x8 bb = tr8(VS, 144, 32 * ks, 16 * vt, lane); acc = MFMA_BF16(Af[ks], bb, acc); }
            *(u32x2*)(gp + (size_t)(16 * vt + l15) * 128) = (u32x2){pk2(acc[0], acc[1]), pk2(acc[2], acc[3])}; }
        LDS_SYNC();
    }
}
__device__ __forceinline__ void hgrn2_scan(bf16_t* GS, const float* HD, int vb, int nvb) {
    for (int gid = vb * 512 + otid(); gid < 64 * 2048; gid += nvb * 512) {
        const int bh = gid >> 11, e8 = gid & 2047, kk0 = (8 * e8) & 127;
        float S[8] = {0.f, 0.f, 0.f, 0.f, 0.f, 0.f, 0.f, 0.f};
#pragma unroll 1
        for (int nb = 0; nb < 32; nb += 8) {
            u32x4 gw[8]; f32x4 d0[8], d1[8];
#pragma unroll
            for (int j = 0; j < 8; ++j) { const int item = bh * 32 + nb + j; gw[j] = *(const u32x4*)(GS + (size_t)item * 16384 + 8 * e8);
                d0[j] = *(const f32x4*)(HD + (size_t)item * 128 + kk0); d1[j] = *(const f32x4*)(HD + (size_t)item * 128 + kk0 + 4); }
#pragma unroll
            for (int j = 0; j < 8; ++j) { const int item = bh * 32 + nb + j;
                *(u32x4*)(GS + (size_t)item * 16384 + 8 * e8) = (u32x4){pk2(S[0], S[1]), pk2(S[2], S[3]), pk2(S[4], S[5]), pk2(S[6], S[7])};
                S[0] = d0[j][0] * S[0] + bflo(gw[j].x); S[1] = d0[j][1] * S[1] + bfhi(gw[j].x); S[2] = d0[j][2] * S[2] + bflo(gw[j].y); S[3] = d0[j][3] * S[3] + bfhi(gw[j].y);
                S[4] = d1[j][0] * S[4] + bflo(gw[j].z); S[5] = d1[j][1] * S[5] + bfhi(gw[j].z); S[6] = d1[j][2] * S[6] + bflo(gw[j].w); S[7] = d1[j][3] * S[7] + bfhi(gw[j].w); }
        }
    }
}
__device__ __forceinline__ void hgrn3_phase(int c, int G, const bf16_t* HQ, const bf16_t* HF, const bf16_t* HI, const bf16_t* HG, const bf16_t* GS, const float* ng, bf16_t* BOUT, LAS unsigned char* lds) {
    const int tid = otid(), lane = tid & 63, wave = tid >> 6, g = lane >> 4, l15 = lane & 15;
    LAS bf16_t* LF = (LAS bf16_t*)(lds + H_LF); LAS bf16_t* VS = (LAS bf16_t*)(lds + H_VS); LAS float* A_ = (LAS float*)(lds + H_A);
    LAS bf16_t* QI = (LAS bf16_t*)(lds + H_T0); LAS bf16_t* QE = (LAS bf16_t*)(lds + H_T1); LAS bf16_t* KE = (LAS bf16_t*)(lds + H_T2); LAS float* RED = (LAS float*)(lds + H_RED);
    const int tt = wave & 3, vh = wave >> 2, tl = 16 * tt + l15;
    HTile T;
    if (c < 2048) hgrn_issue(c, HF, HI, T);
#pragma unroll 1
    for (int item = c; item < 2048; item += G) {
        const int n = item & 31, bh = item >> 5, h = bh & 3, b = bh >> 2, t0 = b * SEQ + n * 64, cb = h * 128;
        const int te = tid >> 3, kc = (tid & 7) * 16;
        const u32x4 q0 = *(const u32x4*)(HQ + (size_t)(t0 + te) * 512 + cb + kc), q1 = *(const u32x4*)(HQ + (size_t)(t0 + te) * 512 + cb + kc + 8);
        const bf16_t* ST = GS + (size_t)item * 16384;
        bf16x8 Sf[4][4]; u32x2 gw[4];
#pragma unroll
        for (int vt = 0; vt < 4; ++vt) { const int vd0 = 64 * vh + 16 * vt;
            gw[vt] = *(const u32x2*)(HG + (size_t)(t0 + tl) * 512 + cb + vd0 + 4 * g);
#pragma unroll
            for (int ks = 0; ks < 4; ++ks) Sf[vt][ks] = *(const bf16x8*)(ST + (size_t)(vd0 + l15) * 128 + 32 * ks + 8 * g); }
        hgrn_store_cumsum(T, lds);
        { unsigned wi[8], we[8], wk[8];
          const unsigned qw[8] = {q0.x, q0.y, q0.z, q0.w, q1.x, q1.y, q1.z, q1.w};
          f32x4 av[4], amv[4];
#pragma unroll
          for (int j = 0; j < 4; ++j) { av[j] = *(const LAS f32x4*)(A_ + te * 132 + kc + 4 * j); amv[j] = *(const LAS f32x4*)(A_ + 31 * 132 + kc + 4 * j); }
          const u32x4 l0 = *(const LAS u32x4*)(LF + te * 144 + kc), l1 = *(const LAS u32x4*)(LF + te * 144 + kc + 8);
          const unsigned lw[8] = {l0.x, l0.y, l0.z, l0.w, l1.x, l1.y, l1.z, l1.w};
#pragma unroll
          for (int e = 0; e < 16; e += 2) { float oi[2], oe[2], ok[2];
#pragma unroll
            for (int d = 0; d < 2; ++d) { const int ee = e + d; const float a = av[ee >> 2][ee & 3], am = amv[ee >> 2][ee & 3], lf = h2f((unsigned short)(lw[e >> 1] >> (16 * d)));
                const float q = d ? bfhi(qw[e >> 1]) : bflo(qw[e >> 1]);
                oi[d] = q * fexp(a); oe[d] = q * fexp(a - am); ok[d] = (1.0f - fexp(lf)) * fexp(am - a); }
            wi[e >> 1] = pk2(oi[0], oi[1]); we[e >> 1] = pk2(oe[0], oe[1]); wk[e >> 1] = pk2(ok[0], ok[1]); }
          *(LAS u32x4*)(QI + te * 144 + kc) = (u32x4){wi[0], wi[1], wi[2], wi[3]}; *(LAS u32x4*)(QI + te * 144 + kc + 8) = (u32x4){wi[4], wi[5], wi[6], wi[7]};
          *(LAS u32x4*)(QE + te * 144 + kc) = (u32x4){we[0], we[1], we[2], we[3]}; *(LAS u32x4*)(QE + te * 144 + kc + 8) = (u32x4){we[4], we[5], we[6], we[7]};
          *(LAS u32x4*)(KE + te * 144 + kc) = (u32x4){wk[0], wk[1], wk[2], wk[3]}; *(LAS u32x4*)(KE + te * 144 + kc + 8) = (u32x4){wk[4], wk[5], wk[6], wk[7]}; }
        LDS_SYNC();
        if (item + G < 2048) hgrn_issue(item + G, HF, HI, T);
        f32x4 P[4];
#pragma unroll
        for (int si = 0; si < 4; ++si) { P[si] = (f32x4){0.f, 0.f, 0.f, 0.f};
            if (si <= tt) {
#pragma unroll
                for (int ks = 0; ks < 4; ++ks) { const bf16x8 a = *(const LAS bf16x8*)(KE + (16 * si + l15) * 144 + 32 * ks + 8 * g), bb = *(const LAS bf16x8*)(QE + tl * 144 + 32 * ks + 8 * g); P[si] = MFMA_BF16(a, bb, P[si]); }
                if (si == tt) {
#pragma unroll
                    for (int r = 0; r < 4; ++r) if (4 * g + r > l15) P[si][r] = 0.f; } } }
        bf16x8 Pf[2];
#pragma unroll
        for (int k2 = 0; k2 < 2; ++k2) { const u32x4 w = (u32x4){pk2(P[2 * k2][0], P[2 * k2][1]), pk2(P[2 * k2][2], P[2 * k2][3]), pk2(P[2 * k2 + 1][0], P[2 * k2 + 1][1]), pk2(P[2 * k2 + 1][2], P[2 * k2 + 1][3])}; Pf[k2] = __builtin_bit_cast(bf16x8, w); }
        bf16x8 Qf[4];
#pragma unroll
        for (int ks = 0; ks < 4; ++ks) Qf[ks] = *(const LAS bf16x8*)(QI + tl * 144 + 32 * ks + 8 * g);
        f32x4 o[4]; float ssq = 0.f;
#pragma unroll
        for (int vt = 0; vt < 4; ++vt) { const int vd0 = 64 * vh + 16 * vt; o[vt] = (f32x4){0.f, 0.f, 0.f, 0.f};
#pragma unroll
            for (int k2 = 0; k2 < 2; ++k2) if (2 * k2 <= tt) { const bf16x8 a = tr8(VS, 144, 32 * k2, vd0, lane); o[vt] = MFMA_BF16(a, Pf[k2], o[vt]); }
#pragma unroll
            for (int ks = 0; ks < 4; ++ks) o[vt] = MFMA_BF16(Sf[vt][ks], Qf[ks], o[vt]);
            ssq += (o[vt][0] * o[vt][0] + o[vt][1] * o[vt][1]) + (o[vt][2] * o[vt][2] + o[vt][3] * o[vt][3]); }
        ssq += __shfl_xor(ssq, 16); ssq += __shfl_xor(ssq, 32);
        if (g == 0) RED[vh * 64 + tl] = ssq;
        LDS_SYNC();
        const float rstd = 1.0f / sqrtf((RED[tl] + RED[64 + tl]) * (1.0f / 128.0f) + EPS);
#pragma unroll
        for (int vt = 0; vt < 4; ++vt) { const int vd = 64 * vh + 16 * vt + 4 * g; const size_t off = (size_t)(t0 + tl) * 512 + cb + vd;
            const f32x4 nw = *(const f32x4*)(ng + vd);
            *(u32x2*)(BOUT + off) = (u32x2){pk2(o[vt][0] * rstd * nw[0] * bflo(gw[vt].x), o[vt][1] * rstd * nw[1] * bfhi(gw[vt].x)), pk2(o[vt][2] * rstd * nw[2] * bflo(gw[vt].y), o[vt][3] * rstd * nw[3] * bfhi(gw[vt].y))}; }
        LDS_SYNC();
    }
}

struct ProbP3 { int K, lda, ldb; const bf16_t *br, *wbr;
    __device__ __forceinline__ const char* a(const Unit& u) const { return (const char*)(br + (size_t)u.z * M * 512 + (size_t)u.pm * 256 * 512); }
    __device__ __forceinline__ const char* b(const Unit& u) const { return (const char*)(wbr + (size_t)u.z * 1024 * 512 + (size_t)u.pn * 256 * 512); } };
struct SchedP3 { int G, c;
    __device__ __forceinline__ bool next(int i, Unit& u) const { const int L = (i / 3) * G + c; if (L >= 512) return false; pg8::tile_map(L, 128, 4, u); u.z = i % 3; return true; } };
struct EpiP3 { static constexpr bool PERM = true; const bf16_t* GATES; bf16_t* MERGED;
    __device__ __forceinline__ bool operator()(f32x4 (&acc)[2][2][4][2], const Unit& u, int wr, int wc, int fr, int fq) const {
        const int row0 = u.pm * 256 + wr * 64 + fr, col0 = u.pn * 256 + wc * 32 + 8 * fq;
#pragma unroll
        for (int ai = 0; ai < 2; ++ai) {
            u32x4 g0[4][2], g1[4][2];
#pragma unroll
            for (int m = 0; m < 4; ++m)
#pragma unroll
                for (int bj = 0; bj < 2; ++bj) { const bf16_t* gp = GATES + (size_t)(row0 + ai * 128 + m * 16) * 3072 + u.z * 1024 + col0 + bj * 128;
                    g0[m][bj] = *(const u32x4*)gp; g1[m][bj] = (u.z < 2) ? *(const u32x4*)(gp + 1024) : (u32x4){0x3f803f80u, 0x3f803f80u, 0x3f803f80u, 0x3f803f80u}; }
            __builtin_amdgcn_sched_barrier(0);
#pragma unroll
            for (int m = 0; m < 4; ++m) { const int row = row0 + ai * 128 + m * 16;
#pragma unroll
                for (int bj = 0; bj < 2; ++bj) { const u32x4 a = g0[m][bj], d4 = g1[m][bj];
                    float f[8] = {bflo(a.x), bfhi(a.x), bflo(a.y), bfhi(a.y), bflo(a.z), bfhi(a.z), bflo(a.w), bfhi(a.w)};
                    if (u.z < 2) { const float d[8] = {bflo(d4.x), bfhi(d4.x), bflo(d4.y), bfhi(d4.y), bflo(d4.z), bfhi(d4.z), bflo(d4.w), bfhi(d4.w)};
#pragma unroll
                        for (int j = 0; j < 8; ++j) f[j] = f[j] * __builtin_amdgcn_rcpf(fmaxf(d[j], 1e-30f)); }
#pragma unroll
                    for (int j = 0; j < 8; ++j) acc[ai][bj][m][j >> 2][j & 3] *= f[j];
                    if (u.z == 2) { const f32x4 v0 = acc[ai][bj][m][0], v1 = acc[ai][bj][m][1];
                        *(u32x4*)(MERGED + (size_t)row * 1024 + col0 + bj * 128) = (u32x4){pk2(v0[0], v0[1]), pk2(v0[2], v0[3]), pk2(v1[0], v1[1]), pk2(v1[2], v1[3])}; } } }
            __builtin_amdgcn_sched_barrier(0);
        }
        return u.z < 2;
    }
};

struct SchedN { int G, c, nM, nN, rep = 1;
    __device__ __forceinline__ bool next(int i, Unit& u) const { const int nwg = nM * nN, cnt = (nwg - c + G - 1) / G; if (i >= rep * cnt) return false; const int L = (i % cnt) * G + c; pg8::tile_map(L, nM, nN, u); u.z = 0; return true; } };
struct EpiP4 { static constexpr bool PERM = true; const float* base; bf16_t* ob; float* ssq;
    __device__ __forceinline__ bool operator()(f32x4 (&acc)[2][2][4][2], const Unit& u, int wr, int wc, int fr, int fq) const {
        const int row0 = u.pm * 256 + wr * 64 + fr, col0 = u.pn * 256 + wc * 32 + 8 * fq;
#pragma unroll
        for (int ah = 0; ah < 4; ++ah) { const int ai = ah >> 1, mb = (ah & 1) * 2;
            f32x4 bs[4][2][2];
#pragma unroll
            for (int m = mb; m < mb + 2; ++m)
#pragma unroll
                for (int bj = 0; bj < 2; ++bj)
#pragma unroll
                    for (int n = 0; n < 2; ++n) bs[m][bj][n] = *(const f32x4*)(base + (size_t)(row0 + ai * 128 + m * 16) * 1024 + col0 + bj * 128 + n * 4);
            __builtin_amdgcn_sched_barrier(0);
#pragma unroll
            for (int m = mb; m < mb + 2; ++m) { const int row = row0 + ai * 128 + m * 16; const size_t off = (size_t)row * 1024 + col0; float s = 0.f;
#pragma unroll
                for (int bj = 0; bj < 2; ++bj) { const f32x4 v0 = bs[m][bj][0] + acc[ai][bj][m][0], v1 = bs[m][bj][1] + acc[ai][bj][m][1];
                    s += (v0[0] * v0[0] + v0[1] * v0[1]) + (v0[2] * v0[2] + v0[3] * v0[3]) + (v1[0] * v1[0] + v1[1] * v1[1]) + (v1[2] * v1[2] + v1[3] * v1[3]);
                    *(u32x4*)(ob + off + bj * 128) = (u32x4){pk2(v0[0], v0[1]), pk2(v0[2], v0[3]), pk2(v1[0], v1[1]), pk2(v1[2], v1[3])}; }
                s += __shfl_xor(s, 16); s += __shfl_xor(s, 32);
                if (fq == 0) atomicAdd(ssq + row, s); }
            __builtin_amdgcn_sched_barrier(0);
        }
        return false;
    }
};
struct EpiP6 { static constexpr bool PERM = true; const bf16_t* base; bf16_t* ob; float* ssq; int nofn;
    __device__ __forceinline__ bool operator()(f32x4 (&acc)[2][2][4][2], const Unit& u, int wr, int wc, int fr, int fq) const {
        const int row0 = u.pm * 256 + wr * 64 + fr, col0 = u.pn * 256 + wc * 32 + 8 * fq;
#pragma unroll
        for (int ai = 0; ai < 2; ++ai) {
        u32x4 bs[2][4][2];
#pragma unroll
            for (int m = 0; m < 4; ++m)
#pragma unroll
                for (int bj = 0; bj < 2; ++bj) bs[ai][m][bj] = *(const u32x4*)(base + (size_t)(row0 + ai * 128 + m * 16) * 1024 + col0 + bj * 128);
        __builtin_amdgcn_sched_barrier(0);
#pragma unroll
            for (int m = 0; m < 4; ++m) { const int row = row0 + ai * 128 + m * 16; const size_t off = (size_t)row * 1024 + col0; float s = 0.f;
#pragma unroll
                for (int bj = 0; bj < 2; ++bj) { const u32x4 w = bs[ai][m][bj];
                    f32x4 v0 = (f32x4){bflo(w.x), bfhi(w.x), bflo(w.y), bfhi(w.y)}, v1 = (f32x4){bflo(w.z), bfhi(w.z), bflo(w.w), bfhi(w.w)};
                    if (!nofn) { v0 = v0 + acc[ai][bj][m][0]; v1 = v1 + acc[ai][bj][m][1]; }
                    s += (v0[0] * v0[0] + v0[1] * v0[1]) + (v0[2] * v0[2] + v0[3] * v0[3]) + (v1[0] * v1[0] + v1[1] * v1[1]) + (v1[2] * v1[2] + v1[3] * v1[3]);
                    *(u32x4*)(ob + off + bj * 128) = (u32x4){pk2(v0[0], v0[1]), pk2(v0[2], v0[3]), pk2(v1[0], v1[1]), pk2(v1[2], v1[3])}; }
                s += __shfl_xor(s, 16); s += __shfl_xor(s, 32);
                if (fq == 0) atomicAdd(ssq + row, s); }
        __builtin_amdgcn_sched_barrier(0);
        }
        return false;
    }
};

__device__ __forceinline__ float dpp_ror1(float x) { return __builtin_bit_cast(float, __builtin_amdgcn_update_dpp(0, __builtin_bit_cast(int, x), 0x121, 0xf, 0xf, false)); }
__device__ __forceinline__ float dpp_ror2(float x) { return __builtin_bit_cast(float, __builtin_amdgcn_update_dpp(0, __builtin_bit_cast(int, x), 0x122, 0xf, 0xf, false)); }
struct EpiP5 { static constexpr bool PERM = true; const float *ssq2, *cw, *cbias; bf16_t* ACT; float *HALO, *TOPA, *TOPB;
    __device__ __forceinline__ bool operator()(f32x4 (&acc)[2][2][4][2], const Unit& u, int wr, int wc, int fr, int fq) const {
        const int ch0 = u.pn * 128 + wc * 32 + 8 * fq;
        float w0[8], w1[8], w2[8], cb[8], rr[2][4];
        { const f32x4 a0 = *(const f32x4*)(cw + ch0), a1 = *(const f32x4*)(cw + ch0 + 4), b0 = *(const f32x4*)(cw + DFF + ch0), b1 = *(const f32x4*)(cw + DFF + ch0 + 4),
                      c0 = *(const f32x4*)(cw + 2 * DFF + ch0), c1 = *(const f32x4*)(cw + 2 * DFF + ch0 + 4), d0 = *(const f32x4*)(cbias + ch0), d1 = *(const f32x4*)(cbias + ch0 + 4);
#pragma unroll
          for (int ai = 0; ai < 2; ++ai)
#pragma unroll
              for (int m = 0; m < 4; ++m) rr[ai][m] = ssq2[(u.pm * 4 + ai * 2 + wr) * 64 + m * 16 + fr];
#pragma unroll
          for (int j = 0; j < 4; ++j) { w0[j] = a0[j]; w0[4 + j] = a1[j]; w1[j] = b0[j]; w1[4 + j] = b1[j]; w2[j] = c0[j]; w2[4 + j] = c1[j]; cb[j] = d0[j]; cb[4 + j] = d1[j]; } }
#pragma unroll
        for (int ai = 0; ai < 2; ++ai) {
            const int blk = u.pm * 4 + ai * 2 + wr, rowb = blk * 64;
            float p1[8], p2[8];
#pragma unroll
            for (int j = 0; j < 8; ++j) { p1[j] = 0.f; p2[j] = 0.f; }
#pragma unroll
            for (int m = 0; m < 4; ++m) { const int row = rowb + m * 16 + fr; const float r = 1.0f / sqrtf(rr[ai][m] * (1.0f / D) + EPS);
                float a[8], bv[8], r1[8], r2[8];
#pragma unroll
                for (int j = 0; j < 8; ++j) { a[j] = acc[ai][0][m][j >> 2][j & 3] * r; bv[j] = acc[ai][1][m][j >> 2][j & 3] * r; r1[j] = dpp_ror1(a[j]); r2[j] = dpp_ror2(a[j]); }
                float o[8];
#pragma unroll
                for (int j = 0; j < 8; ++j) { const float am1 = fr >= 1 ? r1[j] : p1[j], am2 = fr >= 2 ? r2[j] : p2[j]; const float cv = cb[j] + w0[j] * am2 + w1[j] * am1 + w2[j] * a[j]; o[j] = fsilu(cv) * bv[j]; p1[j] = r1[j]; p2[j] = r2[j]; }
                if (m > 0 || fr >= 2) *(u32x4*)(ACT + (size_t)row * DFF + ch0) = (u32x4){pk2(o[0], o[1]), pk2(o[2], o[3]), pk2(o[4], o[5]), pk2(o[6], o[7])};
                else { float* ta = TOPA + ((size_t)blk * 2 + fr) * DFF + ch0; float* tb = TOPB + ((size_t)blk * 2 + fr) * DFF + ch0;
                    *(f32x4*)ta = (f32x4){a[0], a[1], a[2], a[3]}; *(f32x4*)(ta + 4) = (f32x4){a[4], a[5], a[6], a[7]}; *(f32x4*)tb = (f32x4){bv[0], bv[1], bv[2], bv[3]}; *(f32x4*)(tb + 4) = (f32x4){bv[4], bv[5], bv[6], bv[7]}; }
                if (m == 3 && fr >= 14) { float* hp = HALO + ((size_t)blk * 2 + (fr - 14)) * DFF + ch0; *(f32x4*)hp = (f32x4){a[0], a[1], a[2], a[3]}; *(f32x4*)(hp + 4) = (f32x4){a[4], a[5], a[6], a[7]}; }
            }
        }
        return false;
    }
};
__device__ __forceinline__ void p6_fix_panel(int pm, const float* HALO, const float* TOPA, const float* TOPB, const float* cw, const float* cbias, bf16_t* ACT) {
    constexpr int NV = DFF / 4;
#pragma unroll 2
    for (int i = otid(); i < 8 * NV; i += 512) { const int ch = 4 * (i % NV), lr = (i / NV) & 1, b4 = i / (2 * NV), blk = pm * 4 + b4; const bool first = (blk & 31) == 0;
        const size_t hb = (size_t)(first ? blk : blk - 1) * 2 * DFF + ch, tb = (size_t)blk * 2 * DFF + ch;
        f32x4 h0 = *(const f32x4*)(HALO + hb), h1 = *(const f32x4*)(HALO + hb + DFF);
        if (first) { h0 = (f32x4){0.f, 0.f, 0.f, 0.f}; h1 = h0; }
        const f32x4 t0 = *(const f32x4*)(TOPA + tb), t1 = *(const f32x4*)(TOPA + tb + DFF), bv = *(const f32x4*)(TOPB + tb + (size_t)lr * DFF);
        const f32x4 w0 = *(const f32x4*)(cw + ch), w1 = *(const f32x4*)(cw + DFF + ch), w2 = *(const f32x4*)(cw + 2 * DFF + ch), cb = *(const f32x4*)(cbias + ch);
        const f32x4 am2 = lr ? h1 : h0, am1 = lr ? t0 : h1, a0 = lr ? t1 : t0;
        float o[4];
#pragma unroll
        for (int e = 0; e < 4; ++e) o[e] = fsilu(cb[e] + w0[e] * am2[e] + w1[e] * am1[e] + w2[e] * a0[e]) * bv[e];
        *(u32x2*)(ACT + (size_t)(blk * 64 + lr) * DFF + ch) = (u32x2){pk2(o[0], o[1]), pk2(o[2], o[3])}; }
}

__global__ void __launch_bounds__(512, 2) hybrid_fwd(Args A) {
    extern __shared__ __attribute__((aligned(16))) unsigned char lds_raw[];
    LAS unsigned char* lds = (LAS unsigned char*)lds_raw;
    cg::grid_group grid = cg::this_grid();
    unsigned char* ws = A.ws; const int G = gridDim.x, c = blockIdx.x;
    bf16_t* WIN = (bf16_t*)(ws + WS_WIN); bf16_t* WKV = (bf16_t*)(ws + WS_WKV); bf16_t* WBR = (bf16_t*)(ws + WS_WBR); bf16_t* WO = (bf16_t*)(ws + WS_WO); bf16_t* WUP = (bf16_t*)(ws + WS_WUP); bf16_t* WD = (bf16_t*)(ws + WS_WD);
    float* RS1 = (float*)(ws + WS_RS1); float* RSM = (float*)(ws + WS_RSM); float* SSQ2 = (float*)(ws + WS_SSQ2); float* SSQ3 = (float*)(ws + WS_SSQ3); float* HD = (float*)(ws + WS_HD);
    bf16_t* XB = (bf16_t*)(ws + WS_XB); bf16_t* GS = XB; bf16_t* MERGED = XB; bf16_t* X2B = XB; bf16_t* MEMB = (bf16_t*)(ws + WS_MEMB); bf16_t* KV = (bf16_t*)(ws + WS_KV);
    bf16_t* HI = (bf16_t*)(ws + WS_HI); bf16_t* HG = (bf16_t*)(ws + WS_HG); bf16_t* XQ = (bf16_t*)(ws + WS_XQ); bf16_t* X1B = HI;
    bf16_t* GATES = (bf16_t*)(ws + WS_GATES); bf16_t* ACT = GATES;
    bf16_t* AOUT = (bf16_t*)(ws + WS_AOUT); bf16_t* BOUT = (bf16_t*)(ws + WS_BOUT); bf16_t* COUT = (bf16_t*)(ws + WS_COUT);
    float* HALO = (float*)(ws + WS_AOUT); float* TOPA = HALO + (size_t)512 * 2 * DFF; float* TOPB = TOPA + (size_t)512 * 2 * DFF;
    bf16_t* U = (bf16_t*)A.out; bf16_t* V = U + (size_t)M * 512; bf16_t* HQ = V + (size_t)M * 512; bf16_t* HF = HQ + (size_t)M * 512;
    const int lo = A.ph_lo, hi = A.ph_hi;
    const unsigned stg = 0u;
#define IN(k) (lo <= (k) && (k) < hi)
#define SEAM(k) do { if (IN(k) && IN((k) + 1)) { if (lo < 0) grid.sync(); else xcd_barrier(xbar); } } while (0)
    unsigned long long tp0 = 0ull;
#define TSTART(k) do { if (DBG_TPHASE == (k) && c == 0 && threadIdx.x == 0) tp0 = __builtin_amdgcn_s_memrealtime(); } while (0)
#define TEND(k) do { if (DBG_TPHASE == (k) && c == 0 && threadIdx.x == 0) { *(volatile unsigned*)(ws + WS_BAR + 32768) = (unsigned)(__builtin_amdgcn_s_memrealtime() - tp0); } if (DBG_TPHASE == (k) && (k) == 8) xcd_barrier(xbar); } while (0)
    volatile LAS unsigned* xst = (volatile LAS unsigned*)(lds + LDS_BYTES - 16);
    if (threadIdx.x < 4) xst[threadIdx.x] = 0u;
    __syncthreads();
    XcdBarrier xbar; xbar.bar = (unsigned*)(ws + WS_BAR); xbar.x = 0; xbar.st = xst;
    if (hi - lo > 1) xbar = xcd_barrier_post((unsigned*)(ws + WS_BAR), xst);
    if (hi - lo == NPHASE_K) for (int q = 0; q < DBG_XSYNC; ++q) grid.sync();
    TSTART(0);
    if (IN(0)) { p0_prologue(A, lds); if (DBG_DUP == 100) { __syncthreads(); p0_prologue(A, lds); } }
    SEAM(0);
    TEND(0); TSTART(1);
    if (IN(1)) { ProbN P{1024, 1024, 1024, XB, WIN}; SchedP1 S{G, c}; EpiP1 E{RS1, RSM, A.in[I_LB], U, V, HQ, HF, HI, HG, XQ, GATES, KV}; pg8::gemm_phase(lds, P, S, E, stg * 650u); }
    SEAM(1);
    TEND(1); TSTART(2);
    for (int rep = 0; rep < 1 + (DBG_DUP == 2); ++rep) if (IN(2)) {
        hgrn1_phase(c, G, HF, HI, GS, HD, lds);
        __syncthreads();
        for (int it = c; it < 256; it += G) sgu_item(it, U, V, A.in[I_LNG], A.in[I_LNB], A.in[I_WSP], A.in[I_BSP], AOUT, lds);
    }
    SEAM(2);
    TEND(2); TSTART(3);
    if (IN(3)) {
        const bool split = G > 64;
        if (!split || c >= 64) hgrn2_scan(GS, HD, split ? c - 64 : c, split ? G - 64 : G);
        if (c < 64) { __syncthreads(); ProbN P{1024, 1024, 1024, MEMB, WKV}; SchedKV S{G, c}; EpiKV E{RSM, KV}; pg8::gemm_phase(lds, P, S, E); }
    }
    SEAM(3);
    TEND(3); TSTART(4);
    for (int rep = 0; rep < 1 + (DBG_DUP == 4); ++rep) if (IN(4)) {
        if (!((DBG_ZERO_MASK >> 1) & 1)) hgrn3_phase(c, G, HQ, HF, HI, HG, GS, A.in[I_HNG], BOUT, lds);
        __syncthreads();
        for (int it = c; it < 1024; it += G) attn_item(it, XQ, KV, COUT, lds);
        for (int z = 0; z < 3; ++z) if ((DBG_ZERO_MASK >> z) & 1) { u32x4* p = (u32x4*)(AOUT + (size_t)z * M * 512);
            for (size_t i = (size_t)c * 512 + threadIdx.x; i < (size_t)M * 512 / 8; i += (size_t)G * 512) p[i] = (u32x4){0u, 0u, 0u, 0u}; } }
    SEAM(4);
    TEND(4); TSTART(5);
    for (int rep = 0; rep < 1 + (DBG_DUP == 5); ++rep) if (IN(5)) { ProbP3 P{512, 512, 512, AOUT, WBR}; SchedP3 S{G, c}; EpiP3 E{GATES, MERGED}; pg8::gemm_phase(lds, P, S, E, stg * 300u); }
    SEAM(5);
    TEND(5); TSTART(6);
    if (IN(6)) { ProbN P{1024, 1024, 1024, MERGED, WO}; SchedN S{G, c, 128, 4}; EpiP4 E{A.in[I_X], X1B, SSQ2}; pg8::gemm_phase(lds, P, S, E, stg * 400u); }
    SEAM(6);
    TEND(6); TSTART(7);
    for (int rep = 0; rep < 1 + (DBG_DUP == 7); ++rep) if (IN(7)) { ProbN P{1024, 1024, 1024, X1B, WUP}; SchedN S{G, c, 128, 22, DBG_REP5}; EpiP5 E{SSQ2, A.in[I_CW], A.in[I_CB], ACT, HALO, TOPA, TOPB}; pg8::gemm_phase(lds, P, S, E, stg * 650u); }
    SEAM(7);
    TEND(7); TSTART(8);
    if (IN(8)) {
        SchedN S{G, c, 128, 4}; Unit u;
        for (int i = 0; S.next(i, u); ++i) p6_fix_panel(u.pm, HALO, TOPA, TOPB, A.in[I_CW], A.in[I_CB], ACT);
        __threadfence(); __syncthreads();
        ProbN P{DFF, DFF, DFF, ACT, WD}; EpiP6 E{X1B, X2B, SSQ3, DBG_NO_FFN}; pg8::gemm_phase(lds, P, S, E, stg * 600u);
    }
    SEAM(8);
    TEND(8); TSTART(9);
    if (IN(9)) {
        const int t9 = otid(), lane = t9 & 63, gw = c * 8 + (t9 >> 6), NGW = G * 8; const float* fg = A.in[I_FG];
        f32x4 gv[4];
#pragma unroll
        for (int j = 0; j < 4; ++j) gv[j] = *((const f32x4*)fg + lane + 64 * j);
        const float tsc = (DBG_TPHASE >= 0) ? 1.0f + (float)(*(volatile unsigned*)(ws + WS_BAR + 32768)) * 0.01f * DBG_TSCALE : 1.0f;
        for (int m0 = 4 * gw; m0 < M; m0 += 4 * NGW) {
            u32x2 w[4][4]; float r[4];
#pragma unroll
            for (int q = 0; q < 4; ++q) { r[q] = tsc / sqrtf(SSQ3[m0 + q] * (1.0f / D) + EPS);
#pragma unroll
                for (int j = 0; j < 4; ++j) w[q][j] = *((const u32x2*)(X2B + (size_t)(m0 + q) * D) + lane + 64 * j); }
#pragma unroll
            for (int q = 0; q < 4; ++q) { f32x4* p = (f32x4*)(A.out + (size_t)(m0 + q) * D) + lane;
#pragma unroll
                for (int j = 0; j < 4; ++j) { f32x4 o = (f32x4){bflo(w[q][j].x), bfhi(w[q][j].x), bflo(w[q][j].y), bfhi(w[q][j].y)} * r[q] * gv[j];
#if DBG_SANITIZE
                    for (int e = 0; e < 4; ++e) if (!(fabsf(o[e]) < 1e30f)) o[e] = 0.f;
#endif
                    p[64 * j] = o; } } }
    }
#undef IN
#undef SEAM
}

constexpr int NPHASE = 10;
extern "C" void kernel_launch(void* const* d_in, const int* in_sizes, int n_in, void* d_out, int out_size, void* d_ws, size_t ws_size, hipStream_t stream) {
    static int grid = 0;
    if (grid == 0) {
        if (n_in != 20 || out_size != M * D || ws_size < WS_END) { fprintf(stderr, "kernel_launch: unexpected shapes (n_in %d out %d ws %zu)\n", n_in, out_size, ws_size); grid = -1; return; }
        int dev = 0, cus = 0, per_cu = 0;
        hipGetDevice(&dev); hipDeviceGetAttribute(&cus, hipDeviceAttributeMultiprocessorCount, dev);
        hipFuncSetAttribute((const void*)hybrid_fwd, hipFuncAttributeMaxDynamicSharedMemorySize, LDS_BYTES);
        hipOccupancyMaxActiveBlocksPerMultiprocessor(&per_cu, (const void*)hybrid_fwd, 512, LDS_BYTES);
        if (per_cu < 1) { fprintf(stderr, "kernel_launch: occupancy query says %d blocks per CU\n", per_cu); per_cu = 1; }
        (void)hipGetLastError();
        grid = cus * 1;
        if (grid > cus * per_cu) grid = cus * per_cu;
    }
    if (grid <= 0) return;
    Args a{};
    for (int i = 0; i < 20; ++i) a.in[i] = (const float*)d_in[i];
    a.out = (float*)d_out; a.ws = (unsigned char*)d_ws;
#if MK_PER_PHASE
    for (int p = 0; p < NPHASE; ++p) { a.ph_lo = p; a.ph_hi = p + 1; hipLaunchKernelGGL(hybrid_fwd, dim3(grid), dim3(512), LDS_BYTES, stream, a); }
#else
    a.ph_lo = 0; a.ph_hi = NPHASE;
    (void)hipMemsetAsync((unsigned char*)d_ws + WS_BAR, 0, XCD_BAR_WORDS * 4, stream);
    void* args[] = {&a};
    hipError_t e = hipLaunchCooperativeKernel((const void*)hybrid_fwd, dim3(grid), dim3(512), args, LDS_BYTES, stream);
    if (e != hipSuccess) fprintf(stderr, "cooperative launch failed: %s (grid %d)\n", hipGetErrorString(e), grid);
#endif
}
```

```cpp
#include <hip/hip_runtime.h>
#include <hip/hip_cooperative_groups.h>
#include <cstdio>
#include <cstdint>
namespace cg = cooperative_groups;

#define DBG_SANITIZE 0
#define DBG_ATTN_COPY 0
#define DBG_ZERO_MASK 0
#define DBG_NO_FFN 0
#define DBG_TPHASE -1
#define DBG_TSCALE 1e-4f
#define DBG_REP5 1
#define DBG_XSYNC 0
#define DBG_DUP 0
#ifndef MK_PER_PHASE
#define MK_PER_PHASE 0
#endif

#define LAS __attribute__((address_space(3)))
typedef unsigned short bf16_t;
typedef short bf16x8 __attribute__((ext_vector_type(8)));
typedef short s16x4 __attribute__((ext_vector_type(4)));
typedef _Float16 f16x8 __attribute__((ext_vector_type(8)));
typedef float f32x4 __attribute__((ext_vector_type(4)));
typedef float f32x2 __attribute__((ext_vector_type(2)));
typedef unsigned u32x4 __attribute__((ext_vector_type(4)));
typedef unsigned u32x2 __attribute__((ext_vector_type(2)));

constexpr int M = 32768, D = 1024, SEQ = 2048, INW = 6656, MEMROWS = 4096, MEML = 256, DFF = 2816, NUP = 5632;
constexpr float EPS = 1e-6f;
constexpr size_t MiB = 1u << 20;
constexpr size_t WS_WIN = 0, WS_WKV = 13 * MiB, WS_WBR = 15 * MiB, WS_WO = 18 * MiB, WS_WUP = 20 * MiB, WS_WD = 31 * MiB;
constexpr size_t WS_RS1 = 37 * MiB, WS_RSM = WS_RS1 + 128 * 1024, WS_SSQ2 = WS_RS1 + 256 * 1024, WS_SSQ3 = WS_RS1 + 384 * 1024, WS_HD = 38 * MiB;
constexpr size_t WS_BAR = 39 * MiB;
constexpr size_t WS_XB = 48 * MiB;
constexpr size_t WS_MEMB = 112 * MiB, WS_KV = 120 * MiB;
constexpr size_t WS_HI = 128 * MiB, WS_HG = 160 * MiB, WS_XQ = 192 * MiB;
constexpr size_t WS_GATES = 224 * MiB;
constexpr size_t WS_AOUT = 416 * MiB, WS_BOUT = 448 * MiB, WS_COUT = 480 * MiB;
constexpr size_t WS_END = 512 * MiB;
constexpr int LDS_BYTES = 159744;

typedef __bf16 bf16x2_t __attribute__((ext_vector_type(2)));
__device__ __forceinline__ unsigned pk2(float lo, float hi) { f32x2 v = {lo, hi}; bf16x2_t b = __builtin_convertvector(v, bf16x2_t); return __builtin_bit_cast(unsigned, b); }
__device__ __forceinline__ int otid() { int t = threadIdx.x; asm volatile("" : "+v"(t)); return t; }
__device__ __forceinline__ float bflo(unsigned w) { return __uint_as_float(w << 16); }
__device__ __forceinline__ float bfhi(unsigned w) { return __uint_as_float(w & 0xffff0000u); }
__device__ __forceinline__ float fexp(float x) { return __builtin_amdgcn_exp2f(x * 1.4426950408889634f); }
__device__ __forceinline__ float fsigmoid(float x) { return __builtin_amdgcn_rcpf(1.0f + fexp(-x)); }
__device__ __forceinline__ float fsilu(float x) { return x * fsigmoid(x); }
__device__ __forceinline__ float fgelu(float x) { return x * fsigmoid(1.5957691216057308f * (x + 0.044715f * x * x * x)); }
__device__ __forceinline__ unsigned pkh2(float lo, float hi) { _Float16 a = (_Float16)lo, b = (_Float16)hi; return (unsigned)__builtin_bit_cast(unsigned short, a) | ((unsigned)__builtin_bit_cast(unsigned short, b) << 16); }
__device__ __forceinline__ float wave_sum(float v) {
#pragma unroll
    for (int o = 1; o < 64; o <<= 1) v += __shfl_xor(v, o);
    return v;
}
typedef short v4i16_t __attribute__((ext_vector_type(4)));
__device__ __forceinline__ s16x4 tr4(const LAS bf16_t* p) { return __builtin_bit_cast(s16x4, __builtin_amdgcn_ds_read_tr16_b64_v4i16((LAS v4i16_t*)p)); }
__device__ __forceinline__ bf16x8 tr8(const LAS bf16_t* tile, int P, int k0, int c0, int lane) {
    const int g = lane >> 4, q = (lane & 15) >> 2, p = lane & 3;
    const LAS bf16_t* a = tile + (k0 + 4 * g + q) * P + c0 + 4 * p;
    const s16x4 lo = tr4(a), hi = tr4(a + 16 * P);
    return (bf16x8){lo[0], lo[1], lo[2], lo[3], hi[0], hi[1], hi[2], hi[3]};
}
#define MFMA_BF16(a, b, c) __builtin_amdgcn_mfma_f32_16x16x32_bf16((a), (b), (c), 0, 0, 0)

namespace pg8 {
constexpr int BM = 256, BK = 64, HALF = 128, HTB = HALF * BK * 2, STAGE_BYTES = 8 * HTB, NXCD = 8, WGM = 8;
__host__ __device__ __forceinline__ int lds_byte(int r, int c) { const int st = (r >> 4) * 2 + (c >> 5), rr = r & 15, cc = c & 31, ob = rr * 64 + cc * 2; return st * 1024 + (ob ^ (((ob >> 9) & 1) << 5)); }
__host__ __device__ __forceinline__ void stage_rc(int b, int& R, int& C) { const int st = b / 1024, sb = b % 1024, swz = sb ^ (((sb >> 9) & 1) << 5); R = (st >> 1) * 16 + swz / 64; C = (st & 1) * 32 + (swz % 64) / 2; }
__host__ __device__ __forceinline__ int perm32(int rho) { const int n = rho >> 4, i = rho & 15; return 8 * (i >> 2) + 4 * n + (i & 3); }
struct Unit { int pm, pn, z; };
__device__ __forceinline__ void tile_map(int wgid, int nM, int nN, Unit& u) {
    const int nwg = nM * nN;
    { const int q = nwg / NXCD, r = nwg % NXCD, xcd = wgid % NXCD, off = wgid / NXCD; wgid = (xcd < r ? xcd * (q + 1) : r * (q + 1) + (xcd - r) * q) + off; }
    const int nig = WGM * nN, gid = wgid / nig, fm = gid * WGM, gsz = (nM - fm) < WGM ? (nM - fm) : WGM;
    u.pm = fm + ((wgid % nig) % gsz); u.pn = (wgid % nig) / gsz;
}
template <class Prob, class Epi, class Sched>
__device__ __forceinline__ void gemm_phase(LAS unsigned char* lds, const Prob& Pb, const Sched& S, const Epi& E, unsigned delay = 0) {
    if (delay) { const unsigned long long t0 = __builtin_amdgcn_s_memrealtime(); while (__builtin_amdgcn_s_memrealtime() - t0 < delay) __builtin_amdgcn_s_sleep(8); }
    const int tid = otid(), wid = __builtin_amdgcn_readfirstlane(tid >> 6), lane = tid & 63, wr = wid >> 2, wc = wid & 3, fr = lane & 15, fq = lane >> 4;
    const int K = Pb.K, nt = K / BK;
    unsigned voffA[2], voffB[2];
#pragma unroll
    for (int i = 0; i < 2; ++i) { int R, C; stage_rc(tid * 16 + i * 8192, R, C); const int Rb = Epi::PERM ? ((R & ~31) + perm32(R & 31)) : R;
        voffA[i] = (unsigned)(R * Pb.lda + C) * 2u; voffB[i] = (unsigned)(Rb * Pb.ldb + C) * 2u; }
    const size_t kstep = (size_t)(BK * 2);
    const size_t hsA = (size_t)HALF * Pb.lda * 2, hsB = (size_t)HALF * Pb.ldb * 2;
    const unsigned ldsw = (unsigned)wid * 1024u;
    const int aoff = lds_byte(wr * 64 + fr, fq * 8), boff = lds_byte(wc * 32 + fr, fq * 8);
#define PG8_SA(b, h) (((b) * 2 + (h)) * HTB)
#define PG8_SB(b, h) ((4 + (b) * 2 + (h)) * HTB)
#define PG8_STAGE(bufoff, gbase, voff) do { _Pragma("unroll") for (int _i = 0; _i < 2; ++_i) \
        __builtin_amdgcn_global_load_lds((const unsigned*)((const char*)(gbase) + (voff)[_i]), (LAS unsigned*)(lds + (bufoff) + ldsw + _i * 8192), 16, 0, 0); } while (0)
#define PG8_LDA(dst, b, h) do { _Pragma("unroll") for (int m = 0; m < 4; ++m) _Pragma("unroll") for (int k = 0; k < 2; ++k) dst[m][k] = *(const LAS bf16x8*)(lds + PG8_SA(b, h) + aoff + m * 2048 + k * 1024); } while (0)
#define PG8_LDB(dst, b, h) do { _Pragma("unroll") for (int n = 0; n < 2; ++n) _Pragma("unroll") for (int k = 0; k < 2; ++k) dst[n][k] = *(const LAS bf16x8*)(lds + PG8_SB(b, h) + boff + n * 2048 + k * 1024); } while (0)
#define PG8_MMA(ai, bj, At, Bt) do { __builtin_amdgcn_s_setprio(1); _Pragma("unroll") for (int m = 0; m < 4; ++m) _Pragma("unroll") for (int n = 0; n < 2; ++n) _Pragma("unroll") for (int k = 0; k < 2; ++k) \
        acc[ai][bj][m][n] = __builtin_amdgcn_mfma_f32_16x16x32_bf16(Bt[n][k], At[m][k], acc[ai][bj][m][n], 0, 0, 0); __builtin_amdgcn_s_setprio(0); } while (0)
#define PG8_WAIT_V(n) asm volatile("s_waitcnt vmcnt(" #n ")" ::: "memory")
#define PG8_WAIT_L(n) asm volatile("s_waitcnt lgkmcnt(" #n ")" ::: "memory")
#define PG8_BAR __builtin_amdgcn_s_barrier()
#define PG8_SCHED __builtin_amdgcn_sched_barrier(0)
    Unit cur, nxt; int ui = 0;
    if (!S.next(0, cur)) return;
    f32x4 acc[2][2][4][2];
#pragma unroll
    for (int a = 0; a < 2; ++a)
#pragma unroll
        for (int b = 0; b < 2; ++b)
#pragma unroll
            for (int m = 0; m < 4; ++m)
#pragma unroll
                for (int n = 0; n < 2; ++n) acc[a][b][m][n] = (f32x4){0.f, 0.f, 0.f, 0.f};
    bf16x8 At[4][2], B0[2][2], B1[2][2];
    const char* cA = Pb.a(cur); const char* cB = Pb.b(cur);
    PG8_STAGE(PG8_SB(0, 0), cB, voffB); PG8_STAGE(PG8_SB(0, 1), cB + hsB, voffB); PG8_STAGE(PG8_SA(0, 0), cA, voffA); PG8_STAGE(PG8_SA(0, 1), cA + hsA, voffA);
    if (wr == 1) PG8_BAR;
    PG8_WAIT_V(2); PG8_BAR;
    PG8_STAGE(PG8_SB(1, 0), cB + kstep, voffB); PG8_STAGE(PG8_SA(1, 0), cA + kstep, voffA); PG8_STAGE(PG8_SB(1, 1), cB + hsB + kstep, voffB);
    PG8_WAIT_V(6); PG8_BAR;
    for (;;) {
        const bool has_next = S.next(ui + 1, nxt);
        const char* nA = has_next ? Pb.a(nxt) : cA; const char* nB = has_next ? Pb.b(nxt) : cB;
        for (int t = 0; t < nt; t += 2) {
            const bool last = (t == nt - 2);
            const char* a1 = cA + (size_t)(t + 1) * kstep;
            const char* a2 = last ? nA : cA + (size_t)(t + 2) * kstep; const char* b2 = last ? nB : cB + (size_t)(t + 2) * kstep;
            const char* a3 = a2 + kstep; const char* b3 = b2 + kstep;
            PG8_LDB(B0, 0, 0); PG8_LDB(B1, 0, 1); PG8_SCHED; PG8_LDA(At, 0, 0); PG8_STAGE(PG8_SA(1, 1), a1 + hsA, voffA);
            PG8_WAIT_V(8); PG8_WAIT_L(0); PG8_BAR; PG8_MMA(0, 0, At, B0); PG8_MMA(0, 1, At, B1); PG8_BAR; PG8_SCHED;
            PG8_LDA(At, 0, 1); PG8_STAGE(PG8_SB(0, 0), b2, voffB); PG8_STAGE(PG8_SB(0, 1), b2 + hsB, voffB); PG8_STAGE(PG8_SA(0, 0), a2, voffA);
            PG8_WAIT_V(8); PG8_WAIT_L(0); PG8_BAR; PG8_MMA(1, 0, At, B0); PG8_MMA(1, 1, At, B1); PG8_BAR; PG8_SCHED;
            PG8_LDB(B0, 1, 0); PG8_LDB(B1, 1, 1); PG8_SCHED; PG8_LDA(At, 1, 0); PG8_STAGE(PG8_SA(0, 1), a2 + hsA, voffA);
            PG8_WAIT_V(8); PG8_WAIT_L(0); PG8_BAR; PG8_MMA(0, 0, At, B0); PG8_MMA(0, 1, At, B1); PG8_BAR; PG8_SCHED;
            PG8_LDA(At, 1, 1); PG8_STAGE(PG8_SB(1, 0), b3, voffB); PG8_STAGE(PG8_SB(1, 1), b3 + hsB, voffB); PG8_STAGE(PG8_SA(1, 0), a3, voffA);
            PG8_WAIT_V(8); PG8_WAIT_L(0); PG8_BAR; PG8_MMA(1, 0, At, B0); PG8_MMA(1, 1, At, B1); PG8_BAR; PG8_SCHED;
        }
        if (wr == 0) PG8_BAR;
        const bool keep = E(acc, cur, wr, wc, fr, fq);
        if (!has_next) break;
        if (!keep) {
#pragma unroll
        for (int a = 0; a < 2; ++a)
#pragma unroll
            for (int b = 0; b < 2; ++b)
#pragma unroll
                for (int m = 0; m < 4; ++m)
#pragma unroll
                    for (int n = 0; n < 2; ++n) acc[a][b][m][n] = (f32x4){0.f, 0.f, 0.f, 0.f};
        }
        cur = nxt; cA = nA; cB = nB; ++ui;
        if (wr == 1) PG8_BAR;
    }
    PG8_WAIT_V(0);
    PG8_BAR;
#undef PG8_SA
#undef PG8_SB
#undef PG8_STAGE
#undef PG8_LDA
#undef PG8_LDB
#undef PG8_MMA
#undef PG8_WAIT_V
#undef PG8_WAIT_L
#undef PG8_BAR
#undef PG8_SCHED
}
}
using pg8::Unit;

#define XB_TMO      128
#define XB_XCNT(j)  (256  + 64 * (j))
#define XB_XSUB(j)  (1280 + 64 * (j))
#define XB_XGEN(j)  (2304 + 64 * (j))
#define XB_TOP      3328
#define XB_TOPGEN   3392
#define XCD_BAR_WORDS 3456
#define XB_SPIN_CAP (1u << 18)
__device__ __forceinline__ unsigned xb_ld(unsigned* p)              { return __hip_atomic_load(p, __ATOMIC_RELAXED, __HIP_MEMORY_SCOPE_AGENT); }
__device__ __forceinline__ unsigned xb_add(unsigned* p, unsigned v) { return __hip_atomic_fetch_add(p, v, __ATOMIC_RELAXED, __HIP_MEMORY_SCOPE_AGENT); }
__device__ __forceinline__ unsigned xb_xcc_id() { return (unsigned)__builtin_amdgcn_s_getreg((3 << 11) | 20) & 0xFu; }
#define XB_SPIN(cond, bar) do { unsigned _sp = 0; while (cond) { __builtin_amdgcn_s_sleep(1); \
    if ((++_sp & 255u) == 0u) { if (xb_ld(&(bar)[XB_TMO])) break; if (_sp > XB_SPIN_CAP) { atomicAdd(&(bar)[XB_TMO], 1u); break; } } } } while (0)
struct XcdBarrier { unsigned* bar; unsigned x; volatile LAS unsigned* st; };
__device__ __forceinline__ XcdBarrier xcd_barrier_post(unsigned* bar, volatile LAS unsigned* st) {
    XcdBarrier b; b.bar = bar; b.x = xb_xcc_id(); b.st = st;
    if (threadIdx.x == 0) (void)xb_add(&bar[XB_XCNT(b.x)], 1u);
    return b;
}
__device__ __forceinline__ void xcd_barrier_complete(unsigned* bar, unsigned x, unsigned& nloc, unsigned& nx) {
    const unsigned G = gridDim.x * gridDim.y * gridDim.z;
    unsigned sum, cnt, mine, sp = 0u;
    for (;;) {
        sum = 0u; cnt = 0u; mine = 0u;
#pragma unroll
        for (unsigned j = 0; j < 16; ++j) { const unsigned c = xb_ld(&bar[XB_XCNT(j)]); sum += c; cnt += (c > 0u) ? 1u : 0u; mine = (j == x) ? c : mine; }
        if (sum == G) break;
        __builtin_amdgcn_s_sleep(1);
        if ((++sp & 255u) == 0u) { if (xb_ld(&bar[XB_TMO])) break; if (sp > XB_SPIN_CAP) { atomicAdd(&bar[XB_TMO], 1u); break; } }
    }
    nloc = mine > 0u ? mine : 1u; nx = cnt > 0u ? cnt : 1u;
}
__device__ __forceinline__ void xcd_barrier(const XcdBarrier& b) {
    asm volatile("s_waitcnt vmcnt(0)" ::: "memory");
    __syncthreads();
    if (threadIdx.x == 0) {
        unsigned* bar = b.bar;
        __builtin_amdgcn_s_waitcnt(0);
        unsigned nloc = b.st[0], nx = b.st[1];
        if (nloc == 0u) { xcd_barrier_complete(bar, b.x, nloc, nx); b.st[0] = nloc; b.st[1] = nx; }
        const unsigned old = xb_add(&bar[XB_XSUB(b.x)], 1u);
        const unsigned gen = old / nloc;
        if (old + 1u == (gen + 1u) * nloc) {
            __builtin_amdgcn_fence(__ATOMIC_RELEASE, "agent");
            asm volatile("s_waitcnt vmcnt(0)" ::: "memory");
            const unsigned og = xb_add(&bar[XB_TOP], 1u);
            const unsigned tg = og / nx;
            if (og + 1u == (tg + 1u) * nx) xb_add(&bar[XB_TOPGEN], 1u);
            else XB_SPIN(xb_ld(&bar[XB_TOPGEN]) == tg, bar);
            __builtin_amdgcn_fence(__ATOMIC_ACQUIRE, "agent");
            xb_add(&bar[XB_XGEN(b.x)], 1u);
            asm volatile("s_waitcnt vmcnt(0)" ::: "memory");
        } else {
            XB_SPIN(xb_ld(&bar[XB_XGEN(b.x)]) == gen, bar);
            __builtin_amdgcn_fence(__ATOMIC_ACQUIRE, "agent");
            asm volatile("s_waitcnt vmcnt(0)" ::: "memory");
        }
    }
    __syncthreads();
}

constexpr int NPHASE_K = 11;
struct Args { const float* in[20]; float* out; unsigned char* ws; int ph_lo, ph_hi; };
enum { I_X = 0, I_MEM, I_N1G, I_WIN, I_LNG, I_LNB, I_WSP, I_BSP, I_LB, I_HNG, I_MNG, I_WKV, I_WBR, I_WOUT, I_N2G, I_WUP, I_CW, I_CB, I_WDN, I_FG };

template <int MAP> __device__ __forceinline__ void transpose_item(const float* W, int K, int N, bf16_t* WT, const float* sk, LAS float* scr, int item, int lane) {
    const int nblk = N / 64, kb = item / nblk, nb = item % nblk, k0 = 64 * kb, n0 = 64 * nb;
    f32x4 v[16];
#pragma unroll
    for (int i = 0; i < 16; ++i) v[i] = *(const f32x4*)(W + (size_t)(k0 + 4 * i + (lane >> 4)) * N + n0 + 4 * (lane & 15));
#pragma unroll
    for (int i = 0; i < 16; ++i) { const int kk = 4 * i + (lane >> 4); f32x4 x = v[i]; if (sk) x = x * sk[k0 + kk]; LAS float* d = scr + kk * 65 + 4 * (lane & 15); d[0] = x[0]; d[1] = x[1]; d[2] = x[2]; d[3] = x[3]; }
    asm volatile("s_waitcnt lgkmcnt(0)" ::: "memory");
    const int c = lane & 7;
    int r0 = n0;
    if (MAP == 1) { const int half = n0 >= DFF, ch = n0 - half * DFF; r0 = 256 * (ch >> 7) + 128 * half + (ch & 127); }
#pragma unroll
    for (int j = 0; j < 8; ++j) { const int n = (lane >> 3) + 8 * j; const LAS float* p = scr + (8 * c) * 65 + n;
        u32x4 o; o.x = pk2(p[0 * 65], p[1 * 65]); o.y = pk2(p[2 * 65], p[3 * 65]); o.z = pk2(p[4 * 65], p[5 * 65]); o.w = pk2(p[6 * 65], p[7 * 65]);
        *(u32x4*)(WT + (size_t)(r0 + n) * K + k0 + 8 * c) = o; }
    asm volatile("s_waitcnt lgkmcnt(0)" ::: "memory");
}
__device__ __forceinline__ void rows4_to_bf16(const float* x, bf16_t* o, float* rs, int m0, int lane) {
    f32x4 v[4][4];
#pragma unroll
    for (int r = 0; r < 4; ++r)
#pragma unroll
        for (int j = 0; j < 4; ++j) v[r][j] = *((const f32x4*)(x + (size_t)(m0 + r) * D) + lane + 64 * j);
#pragma unroll
    for (int r = 0; r < 4; ++r) { float q = 0.f;
#pragma unroll
        for (int j = 0; j < 4; ++j) q += (v[r][j].x * v[r][j].x + v[r][j].y * v[r][j].y) + (v[r][j].z * v[r][j].z + v[r][j].w * v[r][j].w);
        q = wave_sum(q);
        if (lane == 0) rs[m0 + r] = 1.0f / sqrtf(q * (1.0f / D) + EPS);
        u32x2* o8 = (u32x2*)(o + (size_t)(m0 + r) * D) + lane;
#pragma unroll
        for (int j = 0; j < 4; ++j) o8[64 * j] = (u32x2){pk2(v[r][j].x, v[r][j].y), pk2(v[r][j].z, v[r][j].w)}; }
}
__device__ __forceinline__ void p0_prologue(const Args& A, LAS unsigned char* lds) {
    const int tid = otid(), lane = tid & 63, wave = tid >> 6;
    LAS float* scr = (LAS float*)(lds + wave * 16896);
    const int gw = blockIdx.x * 8 + wave, NGW = gridDim.x * 8;
    unsigned char* ws = A.ws;
    constexpr int I0 = 16 * (INW / 64), I1 = 16 * 16, I2 = 8 * 16, I3 = 16 * 16, I4 = 16 * (NUP / 64), I5 = (DFF / 64) * 16;
    constexpr int NITEMS = I0 + I1 + 3 * I2 + I3 + I4 + I5;
    for (int it = gw; it < NITEMS; it += NGW) {
        int r = it;
        if (r < I0) { transpose_item<0>(A.in[I_WIN], D, INW, (bf16_t*)(ws + WS_WIN), A.in[I_N1G], scr, r, lane); continue; } r -= I0;
        if (r < I1) { transpose_item<0>(A.in[I_WKV], D, 1024, (bf16_t*)(ws + WS_WKV), A.in[I_MNG], scr, r, lane); continue; } r -= I1;
        if (r < 3 * I2) { const int z = r / I2; transpose_item<0>(A.in[I_WBR] + (size_t)z * 512 * 1024, 512, 1024, (bf16_t*)(ws + WS_WBR) + (size_t)z * 1024 * 512, nullptr, scr, r % I2, lane); continue; } r -= 3 * I2;
        if (r < I3) { transpose_item<0>(A.in[I_WOUT], D, D, (bf16_t*)(ws + WS_WO), nullptr, scr, r, lane); continue; } r -= I3;
        if (r < I4) { transpose_item<1>(A.in[I_WUP], D, NUP, (bf16_t*)(ws + WS_WUP), A.in[I_N2G], scr, r, lane); continue; } r -= I4;
        transpose_item<0>(A.in[I_WDN], DFF, D, (bf16_t*)(ws + WS_WD), nullptr, scr, r, lane);
    }
    for (int m = 4 * gw; m < M; m += 4 * NGW) rows4_to_bf16(A.in[I_X], (bf16_t*)(ws + WS_XB), (float*)(ws + WS_RS1), m, lane);
    for (int m = 4 * gw; m < MEMROWS; m += 4 * NGW) rows4_to_bf16(A.in[I_MEM], (bf16_t*)(ws + WS_MEMB), (float*)(ws + WS_RSM), m, lane);
    for (int i = blockIdx.x * 512 + tid; i < 2 * M; i += gridDim.x * 512) ((float*)(ws + WS_SSQ2))[i] = 0.f;
}

struct ProbP1 { int K, lda, ldb; const bf16_t *xb, *memb, *win, *wkv;
    __device__ __forceinline__ const char* a(const Unit& u) const { return (const char*)((u.z ? memb : xb) + (size_t)u.pm * 256 * 1024); }
    __device__ __forceinline__ const char* b(const Unit& u) const { return (const char*)((u.z ? wkv : win) + (size_t)u.pn * 256 * 1024); } };
struct SchedP1 { int G, c;
    __device__ __forceinline__ bool next(int i, Unit& u) const { const int L = i * G + c; if (L >= 3328) return false; pg8::tile_map(L, 128, 26, u); u.z = 0; return true; } };
struct SchedKV { int G, c;
    __device__ __forceinline__ bool next(int i, Unit& u) const { const int L = i * G + c; if (L >= 64) return false; u.pm = L & 15; u.pn = L >> 4; u.z = 0; return true; } };
template <int MODE> __device__ __forceinline__ void p1_store(const f32x4 (&acc)[2][2][4][2], const float* rs, int row0, bf16_t* dst, int ldc, int col0, float sc, const float* lbl, int lcol0) {
    float lb[2][8];
    if (MODE == 4) {
#pragma unroll
        for (int bj = 0; bj < 2; ++bj)
#pragma unroll
            for (int j = 0; j < 8; ++j) { const int c = lcol0 + bj * 128 + j; lb[bj][j] = fsigmoid(lbl[c] - lbl[512 + c]); }
    }
    float rsv[2][4];
#pragma unroll
    for (int ai = 0; ai < 2; ++ai)
#pragma unroll
        for (int m = 0; m < 4; ++m) rsv[ai][m] = rs[row0 + ai * 128 + m * 16];
    __builtin_amdgcn_sched_barrier(0);
#pragma unroll
    for (int ai = 0; ai < 2; ++ai)
#pragma unroll
        for (int m = 0; m < 4; ++m) { const int row = row0 + ai * 128 + m * 16; const float r = rsv[ai][m]; bf16_t* rowp = dst + (size_t)row * ldc + col0;
#pragma unroll
            for (int bj = 0; bj < 2; ++bj) { float v[8];
#pragma unroll
                for (int j = 0; j < 8; ++j) { float x = acc[ai][bj][m][j >> 2][j & 3] * r;
                    if (MODE == 0) x *= sc; if (MODE == 1) x = fgelu(x); if (MODE == 2) x = fsilu(x); if (MODE == 3) x = fsigmoid(x);
                    if (MODE == 4) { const float fg = lb[bj][j] + (1.0f - lb[bj][j]) * fsigmoid(x); x = __logf(fg); }
                    v[j] = x; }
                u32x4 w;
                if (MODE == 4) { w.x = pkh2(v[0], v[1]); w.y = pkh2(v[2], v[3]); w.z = pkh2(v[4], v[5]); w.w = pkh2(v[6], v[7]); }
                else { w.x = pk2(v[0], v[1]); w.y = pk2(v[2], v[3]); w.z = pk2(v[4], v[5]); w.w = pk2(v[6], v[7]); }
                *(u32x4*)(rowp + bj * 128) = w; } }
}
struct EpiP1 { static constexpr bool PERM = true;
    const float *rs1, *rsm, *lbl; bf16_t *U, *V, *HQ, *HF, *HI, *HG, *XQ, *GATES, *KV;
    __device__ __forceinline__ bool operator()(f32x4 (&acc)[2][2][4][2], const Unit& u, int wr, int wc, int fr, int fq) const {
        const int row0 = u.pm * 256 + wr * 64 + fr, cw = wc * 32 + 8 * fq;
        const int seg = u.pn >> 1, col0 = (u.pn & 1) * 256 + cw;
        if (u.pn >= 14) { p1_store<3>(acc, rs1, row0, GATES, 3072, (u.pn - 14) * 256 + cw, 1.f, nullptr, 0); return false; }
        switch (seg) {
            case 0: p1_store<1>(acc, rs1, row0, U, 512, col0, 1.f, nullptr, 0); break;
            case 1: p1_store<1>(acc, rs1, row0, V, 512, col0, 1.f, nullptr, 0); break;
            case 2: p1_store<2>(acc, rs1, row0, HQ, 512, col0, 1.f, nullptr, 0); break;
            case 3: p1_store<4>(acc, rs1, row0, HF, 512, col0, 1.f, lbl, col0); break;
            case 4: p1_store<0>(acc, rs1, row0, HI, 512, col0, 1.f, nullptr, 0); break;
            case 5: p1_store<2>(acc, rs1, row0, HG, 512, col0, 1.f, nullptr, 0); break;
            default: p1_store<0>(acc, rs1, row0, XQ, 512, col0, 0.08838834764831845f * 1.4426950408889634f, nullptr, 0); break;
        }
        return false;
    }
};

struct EpiKV { static constexpr bool PERM = true; const float* rsm; bf16_t* KV;
    __device__ __forceinline__ bool operator()(f32x4 (&acc)[2][2][4][2], const Unit& u, int wr, int wc, int fr, int fq) const {
        p1_store<0>(acc, rsm, u.pm * 256 + wr * 64 + fr, KV, 1024, u.pn * 256 + wc * 32 + 8 * fq, 1.0f, nullptr, 0); return false; } };
struct ProbN { int K, lda, ldb; const bf16_t *A_, *B_;
    __device__ __forceinline__ const char* a(const Unit& u) const { return (const char*)(A_ + (size_t)u.pm * 256 * lda); }
    __device__ __forceinline__ const char* b(const Unit& u) const { return (const char*)(B_ + (size_t)u.pn * 256 * ldb); } };
__device__ __forceinline__ void attn_item(int item, const bf16_t* XQ, const bf16_t* KV, bf16_t* COUT, LAS unsigned char* lds) {
    const int tid = otid(), lane = tid & 63, wave = tid >> 6, g = lane >> 4, l15 = lane & 15;
    const int qt = item & 15, h = (item >> 4) & 3, b = item >> 6;
    LAS bf16_t* Ks = (LAS bf16_t*)lds; LAS bf16_t* Vs = Ks + 256 * 144;
#pragma unroll
    for (int i = 0; i < 8; ++i) { const int idx = tid + 512 * i, row = idx >> 4, ch = idx & 15;
        const bf16_t* src = KV + (size_t)(b * 256 + row) * 1024 + h * 128 + ch * 8;
        *(LAS u32x4*)(Ks + row * 144 + ch * 8) = *(const u32x4*)src; *(LAS u32x4*)(Vs + row * 144 + ch * 8) = *(const u32x4*)(src + 512); }
    const int t = b * SEQ + qt * 128 + wave * 16 + l15;
#if DBG_ATTN_COPY
    { __syncthreads(); const int rr = tid >> 2, cc = (tid & 3) * 32; const size_t o = (size_t)(b * SEQ + qt * 128 + rr) * 512 + h * 128 + cc;
      for (int e = 0; e < 4; ++e) *(u32x4*)(COUT + o + 8 * e) = *(const u32x4*)(KV + (size_t)((b * 256 + ((qt * 128 + rr) & 255))) * 1024 + (qt & 1) * 512 + h * 128 + cc + 8 * e);
      __syncthreads(); return; }
#endif
    bf16x8 Qf[4];
#pragma unroll
    for (int ks = 0; ks < 4; ++ks) Qf[ks] = *(const bf16x8*)(XQ + (size_t)t * 512 + h * 128 + 32 * ks + 8 * g);
    __syncthreads();
    f32x4 s[16];
#pragma unroll
    for (int i = 0; i < 16; ++i) { s[i] = (f32x4){0.f, 0.f, 0.f, 0.f};
#pragma unroll
        for (int ks = 0; ks < 4; ++ks) { const bf16x8 a = *(const LAS bf16x8*)(Ks + (16 * i + l15) * 144 + 32 * ks + 8 * g); s[i] = MFMA_BF16(a, Qf[ks], s[i]); } }
    float mx = -3.0e38f;
#pragma unroll
    for (int i = 0; i < 16; ++i) mx = fmaxf(fmaxf(fmaxf(s[i][0], s[i][1]), fmaxf(s[i][2], s[i][3])), mx);
    mx = fmaxf(mx, __shfl_xor(mx, 16)); mx = fmaxf(mx, __shfl_xor(mx, 32));
    float sum = 0.f;
#pragma unroll
    for (int i = 0; i < 16; ++i)
#pragma unroll
        for (int r = 0; r < 4; ++r) { const float p = __builtin_amdgcn_exp2f(s[i][r] - mx); s[i][r] = p; sum += p; }
    sum += __shfl_xor(sum, 16); sum += __shfl_xor(sum, 32);
    const float inv = 1.0f / sum;
    bf16x8 Pf[8];
#pragma unroll
    for (int kk = 0; kk < 8; ++kk) { u32x4 w; w.x = pk2(s[2 * kk][0] * inv, s[2 * kk][1] * inv); w.y = pk2(s[2 * kk][2] * inv, s[2 * kk][3] * inv);
        w.z = pk2(s[2 * kk + 1][0] * inv, s[2 * kk + 1][1] * inv); w.w = pk2(s[2 * kk + 1][2] * inv, s[2 * kk + 1][3] * inv); Pf[kk] = __builtin_bit_cast(bf16x8, w); }
    bf16_t* orow = COUT + (size_t)t * 512 + h * 128 + 4 * g;
#pragma unroll
    for (int dt = 0; dt < 8; ++dt) { f32x4 o = (f32x4){0.f, 0.f, 0.f, 0.f};
#pragma unroll
        for (int kk = 0; kk < 8; ++kk) { const bf16x8 a = tr8(Vs, 144, 32 * kk, 16 * dt, lane); o = MFMA_BF16(a, Pf[kk], o); }
        *(u32x2*)(orow + 16 * dt) = (u32x2){pk2(o[0], o[1]), pk2(o[2], o[3])}; }
    __syncthreads();
}
__device__ __forceinline__ void sgu_item(int item, const bf16_t* U, const bf16_t* V, const float* lng, const float* lnb, const float* wsp, const float* bsp, bf16_t* AOUT, LAS unsigned char* lds) {
    const int tid = otid(), lane = tid & 63, wave = tid >> 6, g = lane >> 4, l15 = lane & 15;
    const int t0 = item * 128;
    LAS bf16_t* vn = (LAS bf16_t*)lds;
    { float gg[8], bb[8];
#pragma unroll
      for (int j = 0; j < 8; ++j) { gg[j] = lng[8 * lane + j]; bb[j] = lnb[8 * lane + j]; }
#pragma unroll 4
      for (int i = 0; i < 16; ++i) { const int srow = wave * 16 + i; const u32x4 w = *(const u32x4*)(V + (size_t)(t0 + srow) * 512 + 8 * lane);
        float v[8] = {bflo(w.x), bfhi(w.x), bflo(w.y), bfhi(w.y), bflo(w.z), bfhi(w.z), bflo(w.w), bfhi(w.w)};
        float s = 0.f;
#pragma unroll
        for (int j = 0; j < 8; ++j) s += v[j];
        const float mu = wave_sum(s) * (1.0f / 512.0f); float q = 0.f;
#pragma unroll
        for (int j = 0; j < 8; ++j) { v[j] -= mu; q += v[j] * v[j]; }
        const float rstd = 1.0f / sqrtf(wave_sum(q) * (1.0f / 512.0f) + EPS);
#pragma unroll
        for (int j = 0; j < 8; ++j) v[j] = v[j] * rstd * gg[j] + bb[j];
        *(LAS u32x4*)(vn + srow * 528 + 8 * lane) = (u32x4){pk2(v[0], v[1]), pk2(v[2], v[3]), pk2(v[4], v[5]), pk2(v[6], v[7])}; } }
    __syncthreads();
    const int tl = wave * 16 + l15, nks = (wave >> 1) + 1;
#pragma unroll 1
    for (int g4 = 0; g4 < 4; ++g4) {
        bf16x8 Wf[4];
#pragma unroll
        for (int ks = 0; ks < 4; ++ks) { Wf[ks] = (bf16x8){0, 0, 0, 0, 0, 0, 0, 0};
            if (ks < nks) { const float* wp = wsp + (size_t)(g4 * 128 + tl) * 128 + 32 * ks + 4 * g; const f32x4 w0 = *(const f32x4*)wp, w1 = *(const f32x4*)(wp + 16);
                const int s0 = 32 * ks + 4 * g, s1 = s0 + 16; float e[8];
#pragma unroll
                for (int j = 0; j < 4; ++j) { e[j] = (s0 + j <= tl) ? w0[j] : 0.f; e[4 + j] = (s1 + j <= tl) ? w1[j] : 0.f; }
                const u32x4 w = (u32x4){pk2(e[0], e[1]), pk2(e[2], e[3]), pk2(e[4], e[5]), pk2(e[6], e[7])}; Wf[ks] = __builtin_bit_cast(bf16x8, w); } }
        const float bias = bsp[g4 * 128 + tl];
#pragma unroll
        for (int ct = 0; ct < 8; ++ct) { const int c0 = g4 * 128 + 16 * ct; f32x4 acc = (f32x4){0.f, 0.f, 0.f, 0.f};
#pragma unroll
            for (int ks = 0; ks < 4; ++ks) if (ks < nks) { const bf16x8 a = tr8(vn, 528, 32 * ks, c0, lane); acc = MFMA_BF16(a, Wf[ks], acc); }
            const size_t o = (size_t)(t0 + tl) * 512 + c0 + 4 * g; const u32x2 uw = *(const u32x2*)(U + o);
            *(u32x2*)(AOUT + o) = (u32x2){pk2(bflo(uw.x) * (acc[0] + bias), bfhi(uw.x) * (acc[1] + bias)), pk2(bflo(uw.y) * (acc[2] + bias), bfhi(uw.y) * (acc[3] + bias))}; }
    }
    __syncthreads();
}
constexpr int H_LF = 0, H_A = 18432, H_T0 = 52224, H_T1 = 70656, H_T2 = 89088, H_VS = 107520, H_RED = 125952;
#define LDS_SYNC() do { asm volatile("s_waitcnt lgkmcnt(0)" ::: "memory"); __builtin_amdgcn_s_barrier(); asm volatile("" ::: "memory"); } while (0)
struct HTile { u32x4 lf[2], vs[2]; };
__device__ __forceinline__ void hgrn_issue(int item, const bf16_t* HF, const bf16_t* HI, HTile& T) {
    const int tid = otid(), n = item & 31, bh = item >> 5, t0 = (bh >> 2) * SEQ + n * 64, cb = (bh & 3) * 128;
#pragma unroll
    for (int i = 0; i < 2; ++i) { const int idx = tid + 512 * i, row = idx >> 4, ch = idx & 15; const size_t o = (size_t)(t0 + row) * 512 + cb + ch * 8;
        T.lf[i] = *(const u32x4*)(HF + o); T.vs[i] = *(const u32x4*)(HI + o); }
}
__device__ __forceinline__ void hgrn_store_cumsum(const HTile& T, LAS unsigned char* lds) {
    const int tid = otid(), lane = tid & 63, wave = tid >> 6, g = lane >> 4, l15 = lane & 15;
    LAS bf16_t* LF = (LAS bf16_t*)(lds + H_LF); LAS bf16_t* VS = (LAS bf16_t*)(lds + H_VS); LAS float* A_ = (LAS float*)(lds + H_A);
#pragma unroll
    for (int i = 0; i < 2; ++i) { const int idx = tid + 512 * i, row = idx >> 4, ch = idx & 15;
        *(LAS u32x4*)(LF + row * 144 + ch * 8) = T.lf[i]; *(LAS u32x4*)(VS + row * 144 + ch * 8) = T.vs[i]; }
    LDS_SYNC();
    f16x8 Bf[2];
#pragma unroll
    for (int ks = 0; ks < 2; ++ks) Bf[ks] = __builtin_bit_cast(f16x8, tr8(LF, 144, 32 * ks, 16 * wave, lane));
#pragma unroll
    for (int tt = 0; tt < 4; ++tt) { f32x4 acc = (f32x4){0.f, 0.f, 0.f, 0.f}; const int t = 16 * tt + l15;
#pragma unroll
        for (int ks = 0; ks < 2; ++ks) { f16x8 a;
#pragma unroll
            for (int j = 0; j < 8; ++j) { const int sI = 32 * ks + 4 * g + (j & 3) + 16 * (j >> 2); a[j] = (sI <= t) ? (_Float16)1.0f : (_Float16)0.0f; }
            acc = __builtin_amdgcn_mfma_f32_16x16x32_f16(a, Bf[ks], acc, 0, 0, 0); }
#pragma unroll
        for (int r = 0; r < 4; ++r) A_[(16 * tt + 4 * g + r) * 132 + 16 * wave + l15] = acc[r]; }
    LDS_SYNC();
}
__device__ __forceinline__ float h2f(unsigned short h) { return (float)__builtin_bit_cast(_Float16, h); }
__device__ __forceinline__ void hgrn1_phase(int c, int G, const bf16_t* HF, const bf16_t* HI, bf16_t* GS, float* HD, LAS unsigned char* lds) {
    const int tid = otid(), lane = tid & 63, wave = tid >> 6, g = lane >> 4, l15 = lane & 15;
    LAS bf16_t* LF = (LAS bf16_t*)(lds + H_LF); LAS bf16_t* VS = (LAS bf16_t*)(lds + H_VS); LAS float* A_ = (LAS float*)(lds + H_A); LAS bf16_t* KD = (LAS bf16_t*)(lds + H_T0);
    HTile T;
    if (c < 2048) hgrn_issue(c, HF, HI, T);
#pragma unroll 1
    for (int item = c; item < 2048; item += G) {
        hgrn_store_cumsum(T, lds);
        if (item + G < 2048) hgrn_issue(item + G, HF, HI, T);
        { const int t = tid >> 3, kc = (tid & 7) * 16; unsigned w[8];
          f32x4 av[4], alv[4];
#pragma unroll
          for (int j = 0; j < 4; ++j) { av[j] = *(const LAS f32x4*)(A_ + t * 132 + kc + 4 * j); alv[j] = *(const LAS f32x4*)(A_ + 63 * 132 + kc + 4 * j); }
          const u32x4 l0 = *(const LAS u32x4*)(LF + t * 144 + kc), l1 = *(const LAS u32x4*)(LF + t * 144 + kc + 8);
          const unsigned lw[8] = {l0.x, l0.y, l0.z, l0.w, l1.x, l1.y, l1.z, l1.w};
#pragma unroll
          for (int e = 0; e < 16; e += 2) { float o[2];
#pragma unroll
            for (int d = 0; d < 2; ++d) { const int ee = e + d; const float a = av[ee >> 2][ee & 3], al = alv[ee >> 2][ee & 3], lf = h2f((unsigned short)(lw[e >> 1] >> (16 * d))); o[d] = (1.0f - fexp(lf)) * fexp(al - a); }
            w[e >> 1] = pk2(o[0], o[1]); }
          *(LAS u32x4*)(KD + t * 144 + kc) = (u32x4){w[0], w[1], w[2], w[3]}; *(LAS u32x4*)(KD + t * 144 + kc + 8) = (u32x4){w[4], w[5], w[6], w[7]};
          if (tid < 128) HD[(size_t)item * 128 + tid] = fexp(A_[63 * 132 + tid]); }
        LDS_SYNC();
        bf16x8 Af[2];
#pragma unroll
        for (int ks = 0; ks < 2; ++ks) Af[ks] = tr8(KD, 144, 32 * ks, 16 * wave, lane);
        bf16_t* gp = GS + (size_t)item * 16384 + 16 * wave + 4 * g;
#pragma unroll
        for (int vt = 0; vt < 8; ++vt) { f32x4 acc = (f32x4){0.f, 0.f, 0.f, 0.f};
#pragma unroll
            for (int ks = 0; ks < 2; ++ks) { const bf16x8 bb = tr8(VS, 144, 32 * ks, 16 * vt, lane); acc = MFMA_BF16(Af[ks], bb, acc); }
            *(u32x2*)(gp + (size_t)(16 * vt + l15) * 128) = (u32x2){pk2(acc[0], acc[1]), pk2(acc[2], acc[3])}; }
        LDS_SYNC();
    }
}
__device__ __forceinline__ void hgrn2_scan(bf16_t* GS, const float* HD, int vb, int nvb) {
    for (int gid = vb * 512 + otid(); gid < 64 * 2048; gid += nvb * 512) {
        const int bh = gid >> 11, e8 = gid & 2047, kk0 = (8 * e8) & 127;
        float S[8] = {0.f, 0.f, 0.f, 0.f, 0.f, 0.f, 0.f, 0.f};
#pragma unroll 1
        for (int nb = 0; nb < 32; nb += 8) {
            u32x4 gw[8]; f32x4 d0[8], d1[8];
#pragma unroll
            for (int j = 0; j < 8; ++j) { const int item = bh * 32 + nb + j; gw[j] = *(const u32x4*)(GS + (size_t)item * 16384 + 8 * e8);
                d0[j] = *(const f32x4*)(HD + (size_t)item * 128 + kk0); d1[j] = *(const f32x4*)(HD + (size_t)item * 128 + kk0 + 4); }
#pragma unroll
            for (int j = 0; j < 8; ++j) { const int item = bh * 32 + nb + j;
                *(u32x4*)(GS + (size_t)item * 16384 + 8 * e8) = (u32x4){pk2(S[0], S[1]), pk2(S[2], S[3]), pk2(S[4], S[5]), pk2(S[6], S[7])};
                S[0] = d0[j][0] * S[0] + bflo(gw[j].x); S[1] = d0[j][1] * S[1] + bfhi(gw[j].x); S[2] = d0[j][2] * S[2] + bflo(gw[j].y); S[3] = d0[j][3] * S[3] + bfhi(gw[j].y);
                S[4] = d1[j][0] * S[4] + bflo(gw[j].z); S[5] = d1[j][1] * S[5] + bfhi(gw[j].z); S[6] = d1[j][2] * S[6] + bflo(gw[j].w); S[7] = d1[j][3] * S[7] + bfhi(gw[j].w); }
        }
    }
}
__device__ __forceinline__ void hgrn3_phase(int c, int G, const bf16_t* HQ, const bf16_t* HF, const bf16_t* HI, const bf16_t* HG, const bf16_t* GS, const float* ng, bf16_t* BOUT, LAS unsigned char* lds) {
    const int tid = otid(), lane = tid & 63, wave = tid >> 6, g = lane >> 4, l15 = lane & 15;
    LAS bf16_t* LF = (LAS bf16_t*)(lds + H_LF); LAS bf16_t* VS = (LAS bf16_t*)(lds + H_VS); LAS float* A_ = (LAS float*)(lds + H_A);
    LAS bf16_t* QI = (LAS bf16_t*)(lds + H_T0); LAS bf16_t* QE = (LAS bf16_t*)(lds + H_T1); LAS bf16_t* KE = (LAS bf16_t*)(lds + H_T2); LAS float* RED = (LAS float*)(lds + H_RED);
    const int tt = wave & 3, vh = wave >> 2, tl = 16 * tt + l15;
    HTile T;
    if (c < 2048) hgrn_issue(c, HF, HI, T);
#pragma unroll 1
    for (int item = c; item < 2048; item += G) {
        const int n = item & 31, bh = item >> 5, h = bh & 3, b = bh >> 2, t0 = b * SEQ + n * 64, cb = h * 128;
        const int te = tid >> 3, kc = (tid & 7) * 16;
        const u32x4 q0 = *(const u32x4*)(HQ + (size_t)(t0 + te) * 512 + cb + kc), q1 = *(const u32x4*)(HQ + (size_t)(t0 + te) * 512 + cb + kc + 8);
        const bf16_t* ST = GS + (size_t)item * 16384;
        bf16x8 Sf[4][4]; u32x2 gw[4];
#pragma unroll
        for (int vt = 0; vt < 4; ++vt) { const int vd0 = 64 * vh + 16 * vt;
            gw[vt] = *(const u32x2*)(HG + (size_t)(t0 + tl) * 512 + cb + vd0 + 4 * g);
#pragma unroll
            for (int ks = 0; ks < 4; ++ks) Sf[vt][ks] = *(const bf16x8*)(ST + (size_t)(vd0 + l15) * 128 + 32 * ks + 8 * g); }
        hgrn_store_cumsum(T, lds);
        { unsigned wi[8], we[8], wk[8];
          const unsigned qw[8] = {q0.x, q0.y, q0.z, q0.w, q1.x, q1.y, q1.z, q1.w};
          f32x4 av[4], amv[4];
#pragma unroll
          for (int j = 0; j < 4; ++j) { av[j] = *(const LAS f32x4*)(A_ + te * 132 + kc + 4 * j); amv[j] = *(const LAS f32x4*)(A_ + 31 * 132 + kc + 4 * j); }
          const u32x4 l0 = *(const LAS u32x4*)(LF + te * 144 + kc), l1 = *(const LAS u32x4*)(LF + te * 144 + kc + 8);
          const unsigned lw[8] = {l0.x, l0.y, l0.z, l0.w, l1.x, l1.y, l1.z, l1.w};
#pragma unroll
          for (int e = 0; e < 16; e += 2) { float oi[2], oe[2], ok[2];
#pragma unroll
            for (int d = 0; d < 2; ++d) { const int ee = e + d; const float a = av[ee >> 2][ee & 3], am = amv[ee >> 2][ee & 3], lf = h2f((unsigned short)(lw[e >> 1] >> (16 * d)));
                const float q = d ? bfhi(qw[e >> 1]) : bflo(qw[e >> 1]);
                oi[d] = q * fexp(a); oe[d] = q * fexp(a - am); ok[d] = (1.0f - fexp(lf)) * fexp(am - a); }
            wi[e >> 1] = pk2(oi[0], oi[1]); we[e >> 1] = pk2(oe[0], oe[1]); wk[e >> 1] = pk2(ok[0], ok[1]); }
          *(LAS u32x4*)(QI + te * 144 + kc) = (u32x4){wi[0], wi[1], wi[2], wi[3]}; *(LAS u32x4*)(QI + te * 144 + kc + 8) = (u32x4){wi[4], wi[5], wi[6], wi[7]};
          *(LAS u32x4*)(QE + te * 144 + kc) = (u32x4){we[0], we[1], we[2], we[3]}; *(LAS u32x4*)(QE + te * 144 + kc + 8) = (u32x4){we[4], we[5], we[6], we[7]};
          *(LAS u32x4*)(KE + te * 144 + kc) = (u32x4){wk[0], wk[1], wk[2], wk[3]}; *(LAS u32x4*)(KE + te * 144 + kc + 8) = (u32x4){wk[4], wk[5], wk[6], wk[7]}; }
        LDS_SYNC();
        if (item + G < 2048) hgrn_issue(item + G, HF, HI, T);
        f32x4 P[4];
#pragma unroll
        for (int si = 0; si < 4; ++si) { P[si] = (f32x4){0.f, 0.f, 0.f, 0.f};
            if (si <= tt) {
#pragma unroll
                for (int ks = 0; ks < 4; ++ks) { const bf16x8 a = *(const LAS bf16x8*)(KE + (16 * si + l15) * 144 + 32 * ks + 8 * g), bb = *(const LAS bf16x8*)(QE + tl * 144 + 32 * ks + 8 * g); P[si] = MFMA_BF16(a, bb, P[si]); }
                if (si == tt) {
#pragma unroll
                    for (int r = 0; r < 4; ++r) if (4 * g + r > l15) P[si][r] = 0.f; } } }
        bf16x8 Pf[2];
#pragma unroll
        for (int k2 = 0; k2 < 2; ++k2) { const u32x4 w = (u32x4){pk2(P[2 * k2][0], P[2 * k2][1]), pk2(P[2 * k2][2], P[2 * k2][3]), pk2(P[2 * k2 + 1][0], P[2 * k2 + 1][1]), pk2(P[2 * k2 + 1][2], P[2 * k2 + 1][3])}; Pf[k2] = __builtin_bit_cast(bf16x8, w); }
        bf16x8 Qf[4];
#pragma unroll
        for (int ks = 0; ks < 4; ++ks) Qf[ks] = *(const LAS bf16x8*)(QI + tl * 144 + 32 * ks + 8 * g);
        f32x4 o[4]; float ssq = 0.f;
#pragma unroll
        for (int vt = 0; vt < 4; ++vt) { const int vd0 = 64 * vh + 16 * vt; o[vt] = (f32x4){0.f, 0.f, 0.f, 0.f};
#pragma unroll
            for (int k2 = 0; k2 < 2; ++k2) if (2 * k2 <= tt) { const bf16x8 a = tr8(VS, 144, 32 * k2, vd0, lane); o[vt] = MFMA_BF16(a, Pf[k2], o[vt]); }
#pragma unroll
            for (int ks = 0; ks < 4; ++ks) o[vt] = MFMA_BF16(Sf[vt][ks], Qf[ks], o[vt]);
            ssq += (o[vt][0] * o[vt][0] + o[vt][1] * o[vt][1]) + (o[vt][2] * o[vt][2] + o[vt][3] * o[vt][3]); }
        ssq += __shfl_xor(ssq, 16); ssq += __shfl_xor(ssq, 32);
        if (g == 0) RED[vh * 64 + tl] = ssq;
        LDS_SYNC();
        const float rstd = 1.0f / sqrtf((RED[tl] + RED[64 + tl]) * (1.0f / 128.0f) + EPS);
#pragma unroll
        for (int vt = 0; vt < 4; ++vt) { const int vd = 64 * vh + 16 * vt + 4 * g; const size_t off = (size_t)(t0 + tl) * 512 + cb + vd;
            const f32x4 nw = *(const f32x4*)(ng + vd);
            *(u32x2*)(BOUT + off) = (u32x2){pk2(o[vt][0] * rstd * nw[0] * bflo(gw[vt].x), o[vt][1] * rstd * nw[1] * bfhi(gw[vt].x)), pk2(o[vt][2] * rstd * nw[2] * bflo(gw[vt].y), o[vt][3] * rstd * nw[3] * bfhi(gw[vt].y))}; }
        LDS_SYNC();
    }
}

struct ProbP3 { int K, lda, ldb; const bf16_t *br, *wbr;
    __device__ __forceinline__ const char* a(const Unit& u) const { return (const char*)(br + (size_t)u.z * M * 512 + (size_t)u.pm * 256 * 512); }
    __device__ __forceinline__ const char* b(const Unit& u) const { return (const char*)(wbr + (size_t)u.z * 1024 * 512 + (size_t)u.pn * 256 * 512); } };
struct SchedP3 { int G, c;
    __device__ __forceinline__ bool next(int i, Unit& u) const { const int L = (i / 3) * G + c; if (L >= 512) return false; pg8::tile_map(L, 128, 4, u); u.z = i % 3; return true; } };
struct EpiP3 { static constexpr bool PERM = true; const bf16_t* GATES; bf16_t* MERGED;
    __device__ __forceinline__ bool operator()(f32x4 (&acc)[2][2][4][2], const Unit& u, int wr, int wc, int fr, int fq) const {
        const int row0 = u.pm * 256 + wr * 64 + fr, col0 = u.pn * 256 + wc * 32 + 8 * fq;
#pragma unroll
        for (int ai = 0; ai < 2; ++ai) {
            u32x4 g0[4][2], g1[4][2];
#pragma unroll
            for (int m = 0; m < 4; ++m)
#pragma unroll
                for (int bj = 0; bj < 2; ++bj) { const bf16_t* gp = GATES + (size_t)(row0 + ai * 128 + m * 16) * 3072 + u.z * 1024 + col0 + bj * 128;
                    g0[m][bj] = *(const u32x4*)gp; g1[m][bj] = (u.z < 2) ? *(const u32x4*)(gp + 1024) : (u32x4){0x3f803f80u, 0x3f803f80u, 0x3f803f80u, 0x3f803f80u}; }
            __builtin_amdgcn_sched_barrier(0);
#pragma unroll
            for (int m = 0; m < 4; ++m) { const int row = row0 + ai * 128 + m * 16;
#pragma unroll
                for (int bj = 0; bj < 2; ++bj) { const u32x4 a = g0[m][bj], d4 = g1[m][bj];
                    float f[8] = {bflo(a.x), bfhi(a.x), bflo(a.y), bfhi(a.y), bflo(a.z), bfhi(a.z), bflo(a.w), bfhi(a.w)};
                    if (u.z < 2) { const float d[8] = {bflo(d4.x), bfhi(d4.x), bflo(d4.y), bfhi(d4.y), bflo(d4.z), bfhi(d4.z), bflo(d4.w), bfhi(d4.w)};
#pragma unroll
                        for (int j = 0; j < 8; ++j) f[j] = f[j] * __builtin_amdgcn_rcpf(fmaxf(d[j], 1e-30f)); }
#pragma unroll
                    for (int j = 0; j < 8; ++j) acc[ai][bj][m][j >> 2][j & 3] *= f[j];
                    if (u.z == 2) { const f32x4 v0 = acc[ai][bj][m][0], v1 = acc[ai][bj][m][1];
                        *(u32x4*)(MERGED + (size_t)row * 1024 + col0 + bj * 128) = (u32x4){pk2(v0[0], v0[1]), pk2(v0[2], v0[3]), pk2(v1[0], v1[1]), pk2(v1[2], v1[3])}; } } }
            __builtin_amdgcn_sched_barrier(0);
        }
        return u.z < 2;
    }
};

struct SchedN { int G, c, nM, nN, rep = 1;
    __device__ __forceinline__ bool next(int i, Unit& u) const { const int nwg = nM * nN, cnt = (nwg - c + G - 1) / G; if (i >= rep * cnt) return false; const int L = (i % cnt) * G + c; pg8::tile_map(L, nM, nN, u); u.z = 0; return true; } };
struct EpiP4 { static constexpr bool PERM = true; const float* base; bf16_t* ob; float* ssq;
    __device__ __forceinline__ bool operator()(f32x4 (&acc)[2][2][4][2], const Unit& u, int wr, int wc, int fr, int fq) const {
        const int row0 = u.pm * 256 + wr * 64 + fr, col0 = u.pn * 256 + wc * 32 + 8 * fq;
#pragma unroll
        for (int ah = 0; ah < 4; ++ah) { const int ai = ah >> 1, mb = (ah & 1) * 2;
            f32x4 bs[4][2][2];
#pragma unroll
            for (int m = mb; m < mb + 2; ++m)
#pragma unroll
                for (int bj = 0; bj < 2; ++bj)
#pragma unroll
                    for (int n = 0; n < 2; ++n) bs[m][bj][n] = *(const f32x4*)(base + (size_t)(row0 + ai * 128 + m * 16) * 1024 + col0 + bj * 128 + n * 4);
            __builtin_amdgcn_sched_barrier(0);
#pragma unroll
            for (int m = mb; m < mb + 2; ++m) { const int row = row0 + ai * 128 + m * 16; const size_t off = (size_t)row * 1024 + col0; float s = 0.f;
#pragma unroll
                for (int bj = 0; bj < 2; ++bj) { const f32x4 v0 = bs[m][bj][0] + acc[ai][bj][m][0], v1 = bs[m][bj][1] + acc[ai][bj][m][1];
                    s += (v0[0] * v0[0] + v0[1] * v0[1]) + (v0[2] * v0[2] + v0[3] * v0[3]) + (v1[0] * v1[0] + v1[1] * v1[1]) + (v1[2] * v1[2] + v1[3] * v1[3]);
                    *(u32x4*)(ob + off + bj * 128) = (u32x4){pk2(v0[0], v0[1]), pk2(v0[2], v0[3]), pk2(v1[0], v1[1]), pk2(v1[2], v1[3])}; }
                s += __shfl_xor(s, 16); s += __shfl_xor(s, 32);
                if (fq == 0) atomicAdd(ssq + row, s); }
            __builtin_amdgcn_sched_barrier(0);
        }
        return false;
    }
};
struct EpiP6 { static constexpr bool PERM = true; const bf16_t* base; bf16_t* ob; float* ssq; int nofn;
    __device__ __forceinline__ bool operator()(f32x4 (&acc)[2][2][4][2], const Unit& u, int wr, int wc, int fr, int fq) const {
        const int row0 = u.pm * 256 + wr * 64 + fr, col0 = u.pn * 256 + wc * 32 + 8 * fq;
#pragma unroll
        for (int ai = 0; ai < 2; ++ai) {
        u32x4 bs[2][4][2];
#pragma unroll
            for (int m = 0; m < 4; ++m)
#pragma unroll
                for (int bj = 0; bj < 2; ++bj) bs[ai][m][bj] = *(const u32x4*)(base + (size_t)(row0 + ai * 128 + m * 16) * 1024 + col0 + bj * 128);
        __builtin_amdgcn_sched_barrier(0);
#pragma unroll
            for (int m = 0; m < 4; ++m) { const int row = row0 + ai * 128 + m * 16; const size_t off = (size_t)row * 1024 + col0; float s = 0.f;
#pragma unroll
                for (int bj = 0; bj < 2; ++bj) { const u32x4 w = bs[ai][m][bj];
                    f32x4 v0 = (f32x4){bflo(w.x), bfhi(w.x), bflo(w.y), bfhi(w.y)}, v1 = (f32x4){bflo(w.z), bfhi(w.z), bflo(w.w), bfhi(w.w)};
                    if (!nofn) { v0 = v0 + acc[ai][bj][m][0]; v1 = v1 + acc[ai][bj][m][1]; }
                    s += (v0[0] * v0[0] + v0[1] * v0[1]) + (v0[2] * v0[2] + v0[3] * v0[3]) + (v1[0] * v1[0] + v1[1] * v1[1]) + (v1[2] * v1[2] + v1[3] * v1[3]);
                    *(u32x4*)(ob + off + bj * 128) = (u32x4){pk2(v0[0], v0[1]), pk2(v0[2], v0[3]), pk2(v1[0], v1[1]), pk2(v1[2], v1[3])}; }
                s += __shfl_xor(s, 16); s += __shfl_xor(s, 32);
                if (fq == 0) atomicAdd(ssq + row, s); }
        __builtin_amdgcn_sched_barrier(0);
        }
        return false;
    }
};

__device__ __forceinline__ float dpp_ror1(float x) { return __builtin_bit_cast(float, __builtin_amdgcn_update_dpp(0, __builtin_bit_cast(int, x), 0x121, 0xf, 0xf, false)); }
__device__ __forceinline__ float dpp_ror2(float x) { return __builtin_bit_cast(float, __builtin_amdgcn_update_dpp(0, __builtin_bit_cast(int, x), 0x122, 0xf, 0xf, false)); }
struct EpiP5 { static constexpr bool PERM = true; const float *ssq2, *cw, *cbias; bf16_t* ACT; float *HALO, *TOPA, *TOPB;
    __device__ __forceinline__ bool operator()(f32x4 (&acc)[2][2][4][2], const Unit& u, int wr, int wc, int fr, int fq) const {
        const int ch0 = u.pn * 128 + wc * 32 + 8 * fq;
        float w0[8], w1[8], w2[8], cb[8], rr[2][4];
        { const f32x4 a0 = *(const f32x4*)(cw + ch0), a1 = *(const f32x4*)(cw + ch0 + 4), b0 = *(const f32x4*)(cw + DFF + ch0), b1 = *(const f32x4*)(cw + DFF + ch0 + 4),
                      c0 = *(const f32x4*)(cw + 2 * DFF + ch0), c1 = *(const f32x4*)(cw + 2 * DFF + ch0 + 4), d0 = *(const f32x4*)(cbias + ch0), d1 = *(const f32x4*)(cbias + ch0 + 4);
#pragma unroll
          for (int ai = 0; ai < 2; ++ai)
#pragma unroll
              for (int m = 0; m < 4; ++m) rr[ai][m] = ssq2[(u.pm * 4 + ai * 2 + wr) * 64 + m * 16 + fr];
#pragma unroll
          for (int j = 0; j < 4; ++j) { w0[j] = a0[j]; w0[4 + j] = a1[j]; w1[j] = b0[j]; w1[4 + j] = b1[j]; w2[j] = c0[j]; w2[4 + j] = c1[j]; cb[j] = d0[j]; cb[4 + j] = d1[j]; } }
#pragma unroll
        for (int ai = 0; ai < 2; ++ai) {
            const int blk = u.pm * 4 + ai * 2 + wr, rowb = blk * 64;
            float p1[8], p2[8];
#pragma unroll
            for (int j = 0; j < 8; ++j) { p1[j] = 0.f; p2[j] = 0.f; }
#pragma unroll
            for (int m = 0; m < 4; ++m) { const int row = rowb + m * 16 + fr; const float r = 1.0f / sqrtf(rr[ai][m] * (1.0f / D) + EPS);
                float a[8], bv[8], r1[8], r2[8];
#pragma unroll
                for (int j = 0; j < 8; ++j) { a[j] = acc[ai][0][m][j >> 2][j & 3] * r; bv[j] = acc[ai][1][m][j >> 2][j & 3] * r; r1[j] = dpp_ror1(a[j]); r2[j] = dpp_ror2(a[j]); }
                float o[8];
#pragma unroll
                for (int j = 0; j < 8; ++j) { const float am1 = fr >= 1 ? r1[j] : p1[j], am2 = fr >= 2 ? r2[j] : p2[j]; const float cv = cb[j] + w0[j] * am2 + w1[j] * am1 + w2[j] * a[j]; o[j] = fsilu(cv) * bv[j]; p1[j] = r1[j]; p2[j] = r2[j]; }
                if (m > 0 || fr >= 2) *(u32x4*)(ACT + (size_t)row * DFF + ch0) = (u32x4){pk2(o[0], o[1]), pk2(o[2], o[3]), pk2(o[4], o[5]), pk2(o[6], o[7])};
                else { float* ta = TOPA + ((size_t)blk * 2 + fr) * DFF + ch0; float* tb = TOPB + ((size_t)blk * 2 + fr) * DFF + ch0;
                    *(f32x4*)ta = (f32x4){a[0], a[1], a[2], a[3]}; *(f32x4*)(ta + 4) = (f32x4){a[4], a[5], a[6], a[7]}; *(f32x4*)tb = (f32x4){bv[0], bv[1], bv[2], bv[3]}; *(f32x4*)(tb + 4) = (f32x4){bv[4], bv[5], bv[6], bv[7]}; }
                if (m == 3 && fr >= 14) { float* hp = HALO + ((size_t)blk * 2 + (fr - 14)) * DFF + ch0; *(f32x4*)hp = (f32x4){a[0], a[1], a[2], a[3]}; *(f32x4*)(hp + 4) = (f32x4){a[4], a[5], a[6], a[7]}; }
            }
        }
        return false;
    }
};
__device__ __forceinline__ void p6_fix_all(int c, int G, const float* HALO, const float* TOPA, const float* TOPB, const float* cw, const float* cbias, bf16_t* ACT) {
    constexpr int NV = DFF / 4;
#pragma unroll 2
    for (int i = c * 512 + otid(); i < 512 * 2 * NV; i += G * 512) { const int ch = 4 * (i % NV), lr = (i / NV) & 1, blk = i / (2 * NV); const bool first = (blk & 31) == 0;
        const size_t hb = (size_t)(first ? blk : blk - 1) * 2 * DFF + ch, tb = (size_t)blk * 2 * DFF + ch;
        f32x4 h0 = *(const f32x4*)(HALO + hb), h1 = *(const f32x4*)(HALO + hb + DFF);
        if (first) { h0 = (f32x4){0.f, 0.f, 0.f, 0.f}; h1 = h0; }
        const f32x4 t0 = *(const f32x4*)(TOPA + tb), t1 = *(const f32x4*)(TOPA + tb + DFF), bv = *(const f32x4*)(TOPB + tb + (size_t)lr * DFF);
        const f32x4 w0 = *(const f32x4*)(cw + ch), w1 = *(const f32x4*)(cw + DFF + ch), w2 = *(const f32x4*)(cw + 2 * DFF + ch), cb = *(const f32x4*)(cbias + ch);
        const f32x4 am2 = lr ? h1 : h0, am1 = lr ? t0 : h1, a0 = lr ? t1 : t0;
        float o[4];
#pragma unroll
        for (int e = 0; e < 4; ++e) o[e] = fsilu(cb[e] + w0[e] * am2[e] + w1[e] * am1[e] + w2[e] * a0[e]) * bv[e];
        *(u32x2*)(ACT + (size_t)(blk * 64 + lr) * DFF + ch) = (u32x2){pk2(o[0], o[1]), pk2(o[2], o[3])}; }
}

__global__ void __launch_bounds__(512, 2) hybrid_fwd(Args A) {
    extern __shared__ __attribute__((aligned(16))) unsigned char lds_raw[];
    LAS unsigned char* lds = (LAS unsigned char*)lds_raw;
    cg::grid_group grid = cg::this_grid();
    unsigned char* ws = A.ws; const int G = gridDim.x, c = blockIdx.x;
    bf16_t* WIN = (bf16_t*)(ws + WS_WIN); bf16_t* WKV = (bf16_t*)(ws + WS_WKV); bf16_t* WBR = (bf16_t*)(ws + WS_WBR); bf16_t* WO = (bf16_t*)(ws + WS_WO); bf16_t* WUP = (bf16_t*)(ws + WS_WUP); bf16_t* WD = (bf16_t*)(ws + WS_WD);
    float* RS1 = (float*)(ws + WS_RS1); float* RSM = (float*)(ws + WS_RSM); float* SSQ2 = (float*)(ws + WS_SSQ2); float* SSQ3 = (float*)(ws + WS_SSQ3); float* HD = (float*)(ws + WS_HD);
    bf16_t* XB = (bf16_t*)(ws + WS_XB); bf16_t* GS = XB; bf16_t* MERGED = XB; bf16_t* X2B = XB; bf16_t* MEMB = (bf16_t*)(ws + WS_MEMB); bf16_t* KV = (bf16_t*)(ws + WS_KV);
    bf16_t* HI = (bf16_t*)(ws + WS_HI); bf16_t* HG = (bf16_t*)(ws + WS_HG); bf16_t* XQ = (bf16_t*)(ws + WS_XQ); bf16_t* X1B = HI;
    bf16_t* GATES = (bf16_t*)(ws + WS_GATES); bf16_t* ACT = GATES;
    bf16_t* AOUT = (bf16_t*)(ws + WS_AOUT); bf16_t* BOUT = (bf16_t*)(ws + WS_BOUT); bf16_t* COUT = (bf16_t*)(ws + WS_COUT);
    float* HALO = (float*)(ws + WS_AOUT); float* TOPA = HALO + (size_t)512 * 2 * DFF; float* TOPB = TOPA + (size_t)512 * 2 * DFF;
    bf16_t* U = (bf16_t*)A.out; bf16_t* V = U + (size_t)M * 512; bf16_t* HQ = V + (size_t)M * 512; bf16_t* HF = HQ + (size_t)M * 512;
    const int lo = A.ph_lo, hi = A.ph_hi;
    const unsigned stg = 0u;
#define IN(k) (lo <= (k) && (k) < hi)
#define SEAM(k) do { if (IN(k) && IN((k) + 1)) { if (lo < 0) grid.sync(); else xcd_barrier(xbar); } } while (0)
    unsigned long long tp0 = 0ull;
#define TSTART(k) do { if (DBG_TPHASE == (k) && c == 0 && threadIdx.x == 0) tp0 = __builtin_amdgcn_s_memrealtime(); } while (0)
#define TEND(k) do { if (DBG_TPHASE == (k) && c == 0 && threadIdx.x == 0) { *(volatile unsigned*)(ws + WS_BAR + 32768) = (unsigned)(__builtin_amdgcn_s_memrealtime() - tp0); } if (DBG_TPHASE == (k) && (k) == 9) xcd_barrier(xbar); } while (0)
    volatile LAS unsigned* xst = (volatile LAS unsigned*)(lds + LDS_BYTES - 16);
    if (threadIdx.x < 4) xst[threadIdx.x] = 0u;
    __syncthreads();
    XcdBarrier xbar; xbar.bar = (unsigned*)(ws + WS_BAR); xbar.x = 0; xbar.st = xst;
    if (hi - lo > 1) xbar = xcd_barrier_post((unsigned*)(ws + WS_BAR), xst);
    if (hi - lo == NPHASE_K) for (int q = 0; q < DBG_XSYNC; ++q) grid.sync();
    TSTART(0);
    if (IN(0)) { p0_prologue(A, lds); if (DBG_DUP == 100) { __syncthreads(); p0_prologue(A, lds); } }
    SEAM(0);
    TEND(0); TSTART(1);
    if (IN(1)) { ProbN P{1024, 1024, 1024, XB, WIN}; SchedP1 S{G, c}; EpiP1 E{RS1, RSM, A.in[I_LB], U, V, HQ, HF, HI, HG, XQ, GATES, KV}; pg8::gemm_phase(lds, P, S, E, stg * 650u); }
    SEAM(1);
    TEND(1); TSTART(2);
    for (int rep = 0; rep < 1 + (DBG_DUP == 2); ++rep) if (IN(2)) {
        hgrn1_phase(c, G, HF, HI, GS, HD, lds);
        __syncthreads();
        for (int it = c; it < 256; it += G) sgu_item(it, U, V, A.in[I_LNG], A.in[I_LNB], A.in[I_WSP], A.in[I_BSP], AOUT, lds);
    }
    SEAM(2);
    TEND(2); TSTART(3);
    if (IN(3)) {
        const bool split = G > 64;
        if (!split || c >= 64) hgrn2_scan(GS, HD, split ? c - 64 : c, split ? G - 64 : G);
        if (c < 64) { __syncthreads(); ProbN P{1024, 1024, 1024, MEMB, WKV}; SchedKV S{G, c}; EpiKV E{RSM, KV}; pg8::gemm_phase(lds, P, S, E); }
    }
    SEAM(3);
    TEND(3); TSTART(4);
    for (int rep = 0; rep < 1 + (DBG_DUP == 4); ++rep) if (IN(4)) {
        if (!((DBG_ZERO_MASK >> 1) & 1)) hgrn3_phase(c, G, HQ, HF, HI, HG, GS, A.in[I_HNG], BOUT, lds);
        __syncthreads();
        for (int it = c; it < 1024; it += G) attn_item(it, XQ, KV, COUT, lds);
        for (int z = 0; z < 3; ++z) if ((DBG_ZERO_MASK >> z) & 1) { u32x4* p = (u32x4*)(AOUT + (size_t)z * M * 512);
            for (size_t i = (size_t)c * 512 + threadIdx.x; i < (size_t)M * 512 / 8; i += (size_t)G * 512) p[i] = (u32x4){0u, 0u, 0u, 0u}; } }
    SEAM(4);
    TEND(4); TSTART(5);
    for (int rep = 0; rep < 1 + (DBG_DUP == 5); ++rep) if (IN(5)) { ProbP3 P{512, 512, 512, AOUT, WBR}; SchedP3 S{G, c}; EpiP3 E{GATES, MERGED}; pg8::gemm_phase(lds, P, S, E, stg * 300u); }
    SEAM(5);
    TEND(5); TSTART(6);
    if (IN(6)) { ProbN P{1024, 1024, 1024, MERGED, WO}; SchedN S{G, c, 128, 4}; EpiP4 E{A.in[I_X], X1B, SSQ2}; pg8::gemm_phase(lds, P, S, E, stg * 400u); }
    SEAM(6);
    TEND(6); TSTART(7);
    for (int rep = 0; rep < 1 + (DBG_DUP == 7); ++rep) if (IN(7)) { ProbN P{1024, 1024, 1024, X1B, WUP}; SchedN S{G, c, 128, 22, DBG_REP5}; EpiP5 E{SSQ2, A.in[I_CW], A.in[I_CB], ACT, HALO, TOPA, TOPB}; pg8::gemm_phase(lds, P, S, E, stg * 650u); }
    SEAM(7);
    TEND(7); TSTART(8);
    if (IN(8)) p6_fix_all(c, G, HALO, TOPA, TOPB, A.in[I_CW], A.in[I_CB], ACT);
    SEAM(8);
    TEND(8); TSTART(9);
    if (IN(9)) { SchedN S{G, c, 128, 4}; ProbN P{DFF, DFF, DFF, ACT, WD}; EpiP6 E{X1B, X2B, SSQ3, DBG_NO_FFN}; pg8::gemm_phase(lds, P, S, E, stg * 600u); }
    SEAM(9);
    TEND(9); TSTART(10);
    if (IN(10)) {
        const int t9 = otid(), lane = t9 & 63, gw = c * 8 + (t9 >> 6), NGW = G * 8; const float* fg = A.in[I_FG];
        f32x4 gv[4];
#pragma unroll
        for (int j = 0; j < 4; ++j) gv[j] = *((const f32x4*)fg + lane + 64 * j);
        const float tsc = (DBG_TPHASE >= 0) ? 1.0f + (float)(*(volatile unsigned*)(ws + WS_BAR + 32768)) * 0.01f * DBG_TSCALE : 1.0f;
        for (int m0 = 4 * gw; m0 < M; m0 += 4 * NGW) {
            u32x2 w[4][4]; float r[4];
#pragma unroll
            for (int q = 0; q < 4; ++q) { r[q] = tsc / sqrtf(SSQ3[m0 + q] * (1.0f / D) + EPS);
#pragma unroll
                for (int j = 0; j < 4; ++j) w[q][j] = *((const u32x2*)(X2B + (size_t)(m0 + q) * D) + lane + 64 * j); }
#pragma unroll
            for (int q = 0; q < 4; ++q) { f32x4* p = (f32x4*)(A.out + (size_t)(m0 + q) * D) + lane;
#pragma unroll
                for (int j = 0; j < 4; ++j) { f32x4 o = (f32x4){bflo(w[q][j].x), bfhi(w[q][j].x), bflo(w[q][j].y), bfhi(w[q][j].y)} * r[q] * gv[j];
#if DBG_SANITIZE
                    for (int e = 0; e < 4; ++e) if (!(fabsf(o[e]) < 1e30f)) o[e] = 0.f;
#endif
                    p[64 * j] = o; } } }
    }
#undef IN
#undef SEAM
}

constexpr int NPHASE = 11;
extern "C" void kernel_launch(void* const* d_in, const int* in_sizes, int n_in, void* d_out, int out_size, void* d_ws, size_t ws_size, hipStream_t stream) {
    static int grid = 0;
    if (grid == 0) {
        if (n_in != 20 || out_size != M * D || ws_size < WS_END) { fprintf(stderr, "kernel_launch: unexpected shapes (n_in %d out %d ws %zu)\n", n_in, out_size, ws_size); grid = -1; return; }
        int dev = 0, cus = 0, per_cu = 0;
        hipGetDevice(&dev); hipDeviceGetAttribute(&cus, hipDeviceAttributeMultiprocessorCount, dev);
        hipFuncSetAttribute((const void*)hybrid_fwd, hipFuncAttributeMaxDynamicSharedMemorySize, LDS_BYTES);
        hipOccupancyMaxActiveBlocksPerMultiprocessor(&per_cu, (const void*)hybrid_fwd, 512, LDS_BYTES);
        if (per_cu < 1) { fprintf(stderr, "kernel_launch: occupancy query says %d blocks per CU\n", per_cu); per_cu = 1; }
        (void)hipGetLastError();
        grid = cus * 1;
        if (grid > cus * per_cu) grid = cus * per_cu;
    }
    if (grid <= 0) return;
    Args a{};
    for (int i = 0; i < 20; ++i) a.in[i] = (const float*)d_in[i];
    a.out = (float*)d_out; a.ws = (unsigned char*)d_ws;
#if MK_PER_PHASE
    for (int p = 0; p < NPHASE; ++p) { a.ph_lo = p; a.ph_hi = p + 1; hipLaunchKernelGGL(hybrid_fwd, dim3(grid), dim3(512), LDS_BYTES, stream, a); }
#else
    a.ph_lo = 0; a.ph_hi = NPHASE;
    (void)hipMemsetAsync((unsigned char*)d_ws + WS_BAR, 0, XCD_BAR_WORDS * 4, stream);
    void* args[] = {&a};
    hipError_t e = hipLaunchCooperativeKernel((const void*)hybrid_fwd, dim3(grid), dim3(512), args, LDS_BYTES, stream);
    if (e != hipSuccess) fprintf(stderr, "cooperative launch failed: %s (grid %d)\n", hipGetErrorString(e), grid);
#endif
}
```

```cpp
#include <hip/hip_runtime.h>
#include <hip/hip_cooperative_groups.h>
#include <cstdio>
#include <cstdint>
namespace cg = cooperative_groups;

#define DBG_SANITIZE 0
#define DBG_ATTN_COPY 0
#define DBG_ZERO_MASK 0
#define DBG_NO_FFN 0
#define DBG_TPHASE -1
#define DBG_TSCALE 1e-4f
#define DBG_REP5 1
#define DBG_XSYNC 0
#define DBG_DUP 0
#ifndef MK_PER_PHASE
#define MK_PER_PHASE 0
#endif

#define LAS __attribute__((address_space(3)))
typedef unsigned short bf16_t;
typedef short bf16x8 __attribute__((ext_vector_type(8)));
typedef short s16x4 __attribute__((ext_vector_type(4)));
typedef _Float16 f16x8 __attribute__((ext_vector_type(8)));
typedef float f32x4 __attribute__((ext_vector_type(4)));
typedef float f32x2 __attribute__((ext_vector_type(2)));
typedef unsigned u32x4 __attribute__((ext_vector_type(4)));
typedef unsigned u32x2 __attribute__((ext_vector_type(2)));

constexpr int M = 32768, D = 1024, SEQ = 2048, INW = 6656, MEMROWS = 4096, MEML = 256, DFF = 2816, NUP = 5632;
constexpr float EPS = 1e-6f;
constexpr size_t MiB = 1u << 20;
constexpr size_t WS_WIN = 0, WS_WKV = 13 * MiB, WS_WBR = 15 * MiB, WS_WO = 18 * MiB, WS_WUP = 20 * MiB, WS_WD = 31 * MiB;
constexpr size_t WS_RS1 = 37 * MiB, WS_RSM = WS_RS1 + 128 * 1024, WS_SSQ2 = WS_RS1 + 256 * 1024, WS_SSQ3 = WS_RS1 + 384 * 1024, WS_HD = 38 * MiB;
constexpr size_t WS_BAR = 39 * MiB;
constexpr size_t WS_XB = 48 * MiB;
constexpr size_t WS_MEMB = 112 * MiB, WS_KV = 120 * MiB;
constexpr size_t WS_HI = 128 * MiB, WS_HG = 160 * MiB, WS_XQ = 192 * MiB;
constexpr size_t WS_GATES = 224 * MiB;
constexpr size_t WS_AOUT = 416 * MiB, WS_BOUT = 448 * MiB, WS_COUT = 480 * MiB;
constexpr size_t WS_END = 512 * MiB;
constexpr int LDS_BYTES = 159744;

typedef __bf16 bf16x2_t __attribute__((ext_vector_type(2)));
__device__ __forceinline__ unsigned pk2(float lo, float hi) { f32x2 v = {lo, hi}; bf16x2_t b = __builtin_convertvector(v, bf16x2_t); return __builtin_bit_cast(unsigned, b); }
__device__ __forceinline__ int otid() { int t = threadIdx.x; asm volatile("" : "+v"(t)); return t; }
__device__ __forceinline__ float bflo(unsigned w) { return __uint_as_float(w << 16); }
__device__ __forceinline__ float bfhi(unsigned w) { return __uint_as_float(w & 0xffff0000u); }
__device__ __forceinline__ float fexp(float x) { return __builtin_amdgcn_exp2f(x * 1.4426950408889634f); }
__device__ __forceinline__ float fsigmoid(float x) { return __builtin_amdgcn_rcpf(1.0f + fexp(-x)); }
__device__ __forceinline__ float fsilu(float x) { return x * fsigmoid(x); }
__device__ __forceinline__ float fgelu(float x) { return x * fsigmoid(1.5957691216057308f * (x + 0.044715f * x * x * x)); }
__device__ __forceinline__ unsigned pkh2(float lo, float hi) { _Float16 a = (_Float16)lo, b = (_Float16)hi; return (unsigned)__builtin_bit_cast(unsigned short, a) | ((unsigned)__builtin_bit_cast(unsigned short, b) << 16); }
__device__ __forceinline__ float wave_sum(float v) {
#pragma unroll
    for (int o = 1; o < 64; o <<= 1) v += __shfl_xor(v, o);
    return v;
}
typedef short v4i16_t __attribute__((ext_vector_type(4)));
__device__ __forceinline__ s16x4 tr4(const LAS bf16_t* p) { return __builtin_bit_cast(s16x4, __builtin_amdgcn_ds_read_tr16_b64_v4i16((LAS v4i16_t*)p)); }
__device__ __forceinline__ bf16x8 tr8(const LAS bf16_t* tile, int P, int k0, int c0, int lane) {
    const int g = lane >> 4, q = (lane & 15) >> 2, p = lane & 3;
    const LAS bf16_t* a = tile + (k0 + 4 * g + q) * P + c0 + 4 * p;
    const s16x4 lo = tr4(a), hi = tr4(a + 16 * P);
    return (bf16x8){lo[0], lo[1], lo[2], lo[3], hi[0], hi[1], hi[2], hi[3]};
}
#define LDS_SYNC() do { asm volatile("s_waitcnt lgkmcnt(0)" ::: "memory"); __builtin_amdgcn_s_barrier(); asm volatile("" ::: "memory"); } while (0)
#define MFMA_BF16(a, b, c) __builtin_amdgcn_mfma_f32_16x16x32_bf16((a), (b), (c), 0, 0, 0)

namespace pg8 {
constexpr int BM = 256, BK = 64, HALF = 128, HTB = HALF * BK * 2, STAGE_BYTES = 8 * HTB, NXCD = 8, WGM = 8;
__host__ __device__ __forceinline__ int lds_byte(int r, int c) { const int st = (r >> 4) * 2 + (c >> 5), rr = r & 15, cc = c & 31, ob = rr * 64 + cc * 2; return st * 1024 + (ob ^ (((ob >> 9) & 1) << 5)); }
__host__ __device__ __forceinline__ void stage_rc(int b, int& R, int& C) { const int st = b / 1024, sb = b % 1024, swz = sb ^ (((sb >> 9) & 1) << 5); R = (st >> 1) * 16 + swz / 64; C = (st & 1) * 32 + (swz % 64) / 2; }
__host__ __device__ __forceinline__ int perm32(int rho) { const int n = rho >> 4, i = rho & 15; return 8 * (i >> 2) + 4 * n + (i & 3); }
struct Unit { int pm, pn, z; };
__device__ __forceinline__ void tile_map(int wgid, int nM, int nN, Unit& u) {
    const int nwg = nM * nN;
    { const int q = nwg / NXCD, r = nwg % NXCD, xcd = wgid % NXCD, off = wgid / NXCD; wgid = (xcd < r ? xcd * (q + 1) : r * (q + 1) + (xcd - r) * q) + off; }
    const int nig = WGM * nN, gid = wgid / nig, fm = gid * WGM, gsz = (nM - fm) < WGM ? (nM - fm) : WGM;
    u.pm = fm + ((wgid % nig) % gsz); u.pn = (wgid % nig) / gsz;
}
template <class Prob, class Epi, class Sched>
__device__ __forceinline__ void gemm_phase(LAS unsigned char* lds, const Prob& Pb, const Sched& S, const Epi& E, unsigned delay = 0) {
    if (delay) { const unsigned long long t0 = __builtin_amdgcn_s_memrealtime(); while (__builtin_amdgcn_s_memrealtime() - t0 < delay) __builtin_amdgcn_s_sleep(8); }
    const int tid = otid(), wid = __builtin_amdgcn_readfirstlane(tid >> 6), lane = tid & 63, wr = wid >> 2, wc = wid & 3, fr = lane & 15, fq = lane >> 4;
    const int K = Pb.K, nt = K / BK;
    unsigned voffA[2], voffB[2];
#pragma unroll
    for (int i = 0; i < 2; ++i) { int R, C; stage_rc(tid * 16 + i * 8192, R, C); const int Rb = Epi::PERM ? ((R & ~31) + perm32(R & 31)) : R;
        voffA[i] = (unsigned)(R * Pb.lda + C) * 2u; voffB[i] = (unsigned)(Rb * Pb.ldb + C) * 2u; }
    const size_t kstep = (size_t)(BK * 2);
    const size_t hsA = (size_t)HALF * Pb.lda * 2, hsB = (size_t)HALF * Pb.ldb * 2;
    const unsigned ldsw = (unsigned)wid * 1024u;
    const int aoff = lds_byte(wr * 64 + fr, fq * 8), boff = lds_byte(wc * 32 + fr, fq * 8);
#define PG8_SA(b, h) (((b) * 2 + (h)) * HTB)
#define PG8_SB(b, h) ((4 + (b) * 2 + (h)) * HTB)
#define PG8_STAGE(bufoff, gbase, voff) do { _Pragma("unroll") for (int _i = 0; _i < 2; ++_i) \
        __builtin_amdgcn_global_load_lds((const unsigned*)((const char*)(gbase) + (voff)[_i]), (LAS unsigned*)(lds + (bufoff) + ldsw + _i * 8192), 16, 0, 0); } while (0)
#define PG8_LDA(dst, b, h) do { _Pragma("unroll") for (int m = 0; m < 4; ++m) _Pragma("unroll") for (int k = 0; k < 2; ++k) dst[m][k] = *(const LAS bf16x8*)(lds + PG8_SA(b, h) + aoff + m * 2048 + k * 1024); } while (0)
#define PG8_LDB(dst, b, h) do { _Pragma("unroll") for (int n = 0; n < 2; ++n) _Pragma("unroll") for (int k = 0; k < 2; ++k) dst[n][k] = *(const LAS bf16x8*)(lds + PG8_SB(b, h) + boff + n * 2048 + k * 1024); } while (0)
#define PG8_MMA(ai, bj, At, Bt) do { __builtin_amdgcn_s_setprio(1); _Pragma("unroll") for (int m = 0; m < 4; ++m) _Pragma("unroll") for (int n = 0; n < 2; ++n) _Pragma("unroll") for (int k = 0; k < 2; ++k) \
        acc[ai][bj][m][n] = __builtin_amdgcn_mfma_f32_16x16x32_bf16(Bt[n][k], At[m][k], acc[ai][bj][m][n], 0, 0, 0); __builtin_amdgcn_s_setprio(0); } while (0)
#define PG8_WAIT_V(n) asm volatile("s_waitcnt vmcnt(" #n ")" ::: "memory")
#define PG8_WAIT_L(n) asm volatile("s_waitcnt lgkmcnt(" #n ")" ::: "memory")
#define PG8_BAR __builtin_amdgcn_s_barrier()
#define PG8_SCHED __builtin_amdgcn_sched_barrier(0)
    Unit cur, nxt; int ui = 0;
    if (!S.next(0, cur)) return;
    f32x4 acc[2][2][4][2];
#pragma unroll
    for (int a = 0; a < 2; ++a)
#pragma unroll
        for (int b = 0; b < 2; ++b)
#pragma unroll
            for (int m = 0; m < 4; ++m)
#pragma unroll
                for (int n = 0; n < 2; ++n) acc[a][b][m][n] = (f32x4){0.f, 0.f, 0.f, 0.f};
    bf16x8 At[4][2], B0[2][2], B1[2][2];
    const char* cA = Pb.a(cur); const char* cB = Pb.b(cur);
    PG8_STAGE(PG8_SB(0, 0), cB, voffB); PG8_STAGE(PG8_SB(0, 1), cB + hsB, voffB); PG8_STAGE(PG8_SA(0, 0), cA, voffA); PG8_STAGE(PG8_SA(0, 1), cA + hsA, voffA);
    if (wr == 1) PG8_BAR;
    PG8_WAIT_V(2); PG8_BAR;
    PG8_STAGE(PG8_SB(1, 0), cB + kstep, voffB); PG8_STAGE(PG8_SA(1, 0), cA + kstep, voffA); PG8_STAGE(PG8_SB(1, 1), cB + hsB + kstep, voffB);
    PG8_WAIT_V(6); PG8_BAR;
    for (;;) {
        const bool has_next = S.next(ui + 1, nxt);
        const char* nA = has_next ? Pb.a(nxt) : cA; const char* nB = has_next ? Pb.b(nxt) : cB;
        for (int t = 0; t < nt; t += 2) {
            const bool last = (t == nt - 2);
            const char* a1 = cA + (size_t)(t + 1) * kstep;
            const char* a2 = last ? nA : cA + (size_t)(t + 2) * kstep; const char* b2 = last ? nB : cB + (size_t)(t + 2) * kstep;
            const char* a3 = a2 + kstep; const char* b3 = b2 + kstep;
            PG8_LDB(B0, 0, 0); PG8_LDB(B1, 0, 1); PG8_SCHED; PG8_LDA(At, 0, 0); PG8_STAGE(PG8_SA(1, 1), a1 + hsA, voffA);
            PG8_WAIT_V(8); PG8_WAIT_L(0); PG8_BAR; PG8_MMA(0, 0, At, B0); PG8_MMA(0, 1, At, B1); PG8_BAR; PG8_SCHED;
            PG8_LDA(At, 0, 1); PG8_STAGE(PG8_SB(0, 0), b2, voffB); PG8_STAGE(PG8_SB(0, 1), b2 + hsB, voffB); PG8_STAGE(PG8_SA(0, 0), a2, voffA);
            PG8_WAIT_V(8); PG8_WAIT_L(0); PG8_BAR; PG8_MMA(1, 0, At, B0); PG8_MMA(1, 1, At, B1); PG8_BAR; PG8_SCHED;
            PG8_LDB(B0, 1, 0); PG8_LDB(B1, 1, 1); PG8_SCHED; PG8_LDA(At, 1, 0); PG8_STAGE(PG8_SA(0, 1), a2 + hsA, voffA);
            PG8_WAIT_V(8); PG8_WAIT_L(0); PG8_BAR; PG8_MMA(0, 0, At, B0); PG8_MMA(0, 1, At, B1); PG8_BAR; PG8_SCHED;
            PG8_LDA(At, 1, 1); PG8_STAGE(PG8_SB(1, 0), b3, voffB); PG8_STAGE(PG8_SB(1, 1), b3 + hsB, voffB); PG8_STAGE(PG8_SA(1, 0), a3, voffA);
            PG8_WAIT_V(8); PG8_WAIT_L(0); PG8_BAR; PG8_MMA(1, 0, At, B0); PG8_MMA(1, 1, At, B1); PG8_BAR; PG8_SCHED;
        }
        if (wr == 0) PG8_BAR;
        const bool keep = E(acc, cur, wr, wc, fr, fq);
        if (!has_next) break;
        if (!keep) {
#pragma unroll
        for (int a = 0; a < 2; ++a)
#pragma unroll
            for (int b = 0; b < 2; ++b)
#pragma unroll
                for (int m = 0; m < 4; ++m)
#pragma unroll
                    for (int n = 0; n < 2; ++n) acc[a][b][m][n] = (f32x4){0.f, 0.f, 0.f, 0.f};
        }
        cur = nxt; cA = nA; cB = nB; ++ui;
        if (wr == 1) PG8_BAR;
    }
    PG8_WAIT_V(0);
    PG8_BAR;
#undef PG8_SA
#undef PG8_SB
#undef PG8_STAGE
#undef PG8_LDA
#undef PG8_LDB
#undef PG8_MMA
#undef PG8_WAIT_V
#undef PG8_WAIT_L
#undef PG8_BAR
#undef PG8_SCHED
}
}
using pg8::Unit;

#define XB_TMO      128
#define XB_XCNT(j)  (256  + 64 * (j))
#define XB_XSUB(j)  (1280 + 64 * (j))
#define XB_XGEN(j)  (2304 + 64 * (j))
#define XB_TOP      3328
#define XB_TOPGEN   3392
#define XCD_BAR_WORDS 3456
#define XB_SPIN_CAP (1u << 18)
__device__ __forceinline__ unsigned xb_ld(unsigned* p)              { return __hip_atomic_load(p, __ATOMIC_RELAXED, __HIP_MEMORY_SCOPE_AGENT); }
__device__ __forceinline__ unsigned xb_add(unsigned* p, unsigned v) { return __hip_atomic_fetch_add(p, v, __ATOMIC_RELAXED, __HIP_MEMORY_SCOPE_AGENT); }
__device__ __forceinline__ unsigned xb_xcc_id() { return (unsigned)__builtin_amdgcn_s_getreg((3 << 11) | 20) & 0xFu; }
#define XB_SPIN(cond, bar) do { unsigned _sp = 0; while (cond) { __builtin_amdgcn_s_sleep(1); \
    if ((++_sp & 255u) == 0u) { if (xb_ld(&(bar)[XB_TMO])) break; if (_sp > XB_SPIN_CAP) { atomicAdd(&(bar)[XB_TMO], 1u); break; } } } } while (0)
struct XcdBarrier { unsigned* bar; unsigned x; volatile LAS unsigned* st; };
__device__ __forceinline__ XcdBarrier xcd_barrier_post(unsigned* bar, volatile LAS unsigned* st) {
    XcdBarrier b; b.bar = bar; b.x = xb_xcc_id(); b.st = st;
    if (threadIdx.x == 0) (void)xb_add(&bar[XB_XCNT(b.x)], 1u);
    return b;
}
__device__ __forceinline__ void xcd_barrier_complete(unsigned* bar, unsigned x, unsigned& nloc, unsigned& nx) {
    const unsigned G = gridDim.x * gridDim.y * gridDim.z;
    unsigned sum, cnt, mine, sp = 0u;
    for (;;) {
        sum = 0u; cnt = 0u; mine = 0u;
#pragma unroll
        for (unsigned j = 0; j < 16; ++j) { const unsigned c = xb_ld(&bar[XB_XCNT(j)]); sum += c; cnt += (c > 0u) ? 1u : 0u; mine = (j == x) ? c : mine; }
        if (sum == G) break;
        __builtin_amdgcn_s_sleep(1);
        if ((++sp & 255u) == 0u) { if (xb_ld(&bar[XB_TMO])) break; if (sp > XB_SPIN_CAP) { atomicAdd(&bar[XB_TMO], 1u); break; } }
    }
    nloc = mine > 0u ? mine : 1u; nx = cnt > 0u ? cnt : 1u;
}
__device__ __forceinline__ void xcd_barrier(const XcdBarrier& b) {
    asm volatile("s_waitcnt vmcnt(0)" ::: "memory");
    __syncthreads();
    if (threadIdx.x == 0) {
        unsigned* bar = b.bar;
        __builtin_amdgcn_s_waitcnt(0);
        unsigned nloc = b.st[0], nx = b.st[1];
        if (nloc == 0u) { xcd_barrier_complete(bar, b.x, nloc, nx); b.st[0] = nloc; b.st[1] = nx; }
        const unsigned old = xb_add(&bar[XB_XSUB(b.x)], 1u);
        const unsigned gen = old / nloc;
        if (old + 1u == (gen + 1u) * nloc) {
            __builtin_amdgcn_fence(__ATOMIC_RELEASE, "agent");
            asm volatile("s_waitcnt vmcnt(0)" ::: "memory");
            const unsigned og = xb_add(&bar[XB_TOP], 1u);
            const unsigned tg = og / nx;
            if (og + 1u == (tg + 1u) * nx) xb_add(&bar[XB_TOPGEN], 1u);
            else XB_SPIN(xb_ld(&bar[XB_TOPGEN]) == tg, bar);
            __builtin_amdgcn_fence(__ATOMIC_ACQUIRE, "agent");
            xb_add(&bar[XB_XGEN(b.x)], 1u);
            asm volatile("s_waitcnt vmcnt(0)" ::: "memory");
        } else {
            XB_SPIN(xb_ld(&bar[XB_XGEN(b.x)]) == gen, bar);
            __builtin_amdgcn_fence(__ATOMIC_ACQUIRE, "agent");
            asm volatile("s_waitcnt vmcnt(0)" ::: "memory");
        }
    }
    __syncthreads();
}

constexpr int NPHASE_K = 11;
struct Args { const float* in[20]; float* out; unsigned char* ws; int ph_lo, ph_hi; };
enum { I_X = 0, I_MEM, I_N1G, I_WIN, I_LNG, I_LNB, I_WSP, I_BSP, I_LB, I_HNG, I_MNG, I_WKV, I_WBR, I_WOUT, I_N2G, I_WUP, I_CW, I_CB, I_WDN, I_FG };

template <int MAP> __device__ __forceinline__ void transpose_item(const float* W, int K, int N, bf16_t* WT, const float* sk, LAS float* scr, int item, int lane) {
    const int nblk = N / 64, kb = item / nblk, nb = item % nblk, k0 = 64 * kb, n0 = 64 * nb;
    f32x4 v[16];
#pragma unroll
    for (int i = 0; i < 16; ++i) v[i] = *(const f32x4*)(W + (size_t)(k0 + 4 * i + (lane >> 4)) * N + n0 + 4 * (lane & 15));
#pragma unroll
    for (int i = 0; i < 16; ++i) { const int kk = 4 * i + (lane >> 4); f32x4 x = v[i]; if (sk) x = x * sk[k0 + kk]; LAS float* d = scr + kk * 65 + 4 * (lane & 15); d[0] = x[0]; d[1] = x[1]; d[2] = x[2]; d[3] = x[3]; }
    asm volatile("s_waitcnt lgkmcnt(0)" ::: "memory");
    const int c = lane & 7;
    int r0 = n0;
    if (MAP == 1) { const int half = n0 >= DFF, ch = n0 - half * DFF; r0 = 256 * (ch >> 7) + 128 * half + (ch & 127); }
#pragma unroll
    for (int j = 0; j < 8; ++j) { const int n = (lane >> 3) + 8 * j; const LAS float* p = scr + (8 * c) * 65 + n;
        u32x4 o; o.x = pk2(p[0 * 65], p[1 * 65]); o.y = pk2(p[2 * 65], p[3 * 65]); o.z = pk2(p[4 * 65], p[5 * 65]); o.w = pk2(p[6 * 65], p[7 * 65]);
        *(u32x4*)(WT + (size_t)(r0 + n) * K + k0 + 8 * c) = o; }
    asm volatile("s_waitcnt lgkmcnt(0)" ::: "memory");
}
__device__ __forceinline__ void rows4_to_bf16(const float* x, bf16_t* o, float* rs, int m0, int lane) {
    f32x4 v[4][4];
#pragma unroll
    for (int r = 0; r < 4; ++r)
#pragma unroll
        for (int j = 0; j < 4; ++j) v[r][j] = *((const f32x4*)(x + (size_t)(m0 + r) * D) + lane + 64 * j);
#pragma unroll
    for (int r = 0; r < 4; ++r) { float q = 0.f;
#pragma unroll
        for (int j = 0; j < 4; ++j) q += (v[r][j].x * v[r][j].x + v[r][j].y * v[r][j].y) + (v[r][j].z * v[r][j].z + v[r][j].w * v[r][j].w);
        q = wave_sum(q);
        if (lane == 0) rs[m0 + r] = 1.0f / sqrtf(q * (1.0f / D) + EPS);
        u32x2* o8 = (u32x2*)(o + (size_t)(m0 + r) * D) + lane;
#pragma unroll
        for (int j = 0; j < 4; ++j) o8[64 * j] = (u32x2){pk2(v[r][j].x, v[r][j].y), pk2(v[r][j].z, v[r][j].w)}; }
}
__device__ __forceinline__ void p0_prologue(const Args& A, LAS unsigned char* lds) {
    const int tid = otid(), lane = tid & 63, wave = tid >> 6;
    LAS float* scr = (LAS float*)(lds + wave * 16896);
    const int gw = blockIdx.x * 8 + wave, NGW = gridDim.x * 8;
    unsigned char* ws = A.ws;
    constexpr int I0 = 16 * (INW / 64), I1 = 16 * 16, I2 = 8 * 16, I3 = 16 * 16, I4 = 16 * (NUP / 64), I5 = (DFF / 64) * 16;
    constexpr int NITEMS = I0 + I1 + 3 * I2 + I3 + I4 + I5;
    for (int it = gw; it < NITEMS; it += NGW) {
        int r = it;
        if (r < I0) { transpose_item<0>(A.in[I_WIN], D, INW, (bf16_t*)(ws + WS_WIN), A.in[I_N1G], scr, r, lane); continue; } r -= I0;
        if (r < I1) { transpose_item<0>(A.in[I_WKV], D, 1024, (bf16_t*)(ws + WS_WKV), A.in[I_MNG], scr, r, lane); continue; } r -= I1;
        if (r < 3 * I2) { const int z = r / I2; transpose_item<0>(A.in[I_WBR] + (size_t)z * 512 * 1024, 512, 1024, (bf16_t*)(ws + WS_WBR) + (size_t)z * 1024 * 512, nullptr, scr, r % I2, lane); continue; } r -= 3 * I2;
        if (r < I3) { transpose_item<0>(A.in[I_WOUT], D, D, (bf16_t*)(ws + WS_WO), nullptr, scr, r, lane); continue; } r -= I3;
        if (r < I4) { transpose_item<1>(A.in[I_WUP], D, NUP, (bf16_t*)(ws + WS_WUP), A.in[I_N2G], scr, r, lane); continue; } r -= I4;
        transpose_item<0>(A.in[I_WDN], DFF, D, (bf16_t*)(ws + WS_WD), nullptr, scr, r, lane);
    }
    for (int m = 4 * gw; m < M; m += 4 * NGW) rows4_to_bf16(A.in[I_X], (bf16_t*)(ws + WS_XB), (float*)(ws + WS_RS1), m, lane);
    for (int m = 4 * gw; m < MEMROWS; m += 4 * NGW) rows4_to_bf16(A.in[I_MEM], (bf16_t*)(ws + WS_MEMB), (float*)(ws + WS_RSM), m, lane);
    for (int i = blockIdx.x * 512 + tid; i < 2 * M; i += gridDim.x * 512) ((float*)(ws + WS_SSQ2))[i] = 0.f;
}

struct ProbP1 { int K, lda, ldb; const bf16_t *xb, *memb, *win, *wkv;
    __device__ __forceinline__ const char* a(const Unit& u) const { return (const char*)((u.z ? memb : xb) + (size_t)u.pm * 256 * 1024); }
    __device__ __forceinline__ const char* b(const Unit& u) const { return (const char*)((u.z ? wkv : win) + (size_t)u.pn * 256 * 1024); } };
struct SchedP1 { int G, c;
    __device__ __forceinline__ bool next(int i, Unit& u) const { const int L = i * G + c; if (L >= 3328) return false; pg8::tile_map(L, 128, 26, u); u.z = 0; return true; } };
struct SchedKV { int G, c;
    __device__ __forceinline__ bool next(int i, Unit& u) const { const int L = i * G + c; if (L >= 64) return false; u.pm = L & 15; u.pn = L >> 4; u.z = 0; return true; } };
template <int MODE> __device__ __forceinline__ void p1_store(const f32x4 (&acc)[2][2][4][2], const float* rs, int row0, bf16_t* dst, int ldc, int col0, float sc, const float* lbl, int lcol0) {
    float lb[2][8];
    if (MODE == 4) {
#pragma unroll
        for (int bj = 0; bj < 2; ++bj)
#pragma unroll
            for (int j = 0; j < 8; ++j) { const int c = lcol0 + bj * 128 + j; lb[bj][j] = fsigmoid(lbl[c] - lbl[512 + c]); }
    }
    float rsv[2][4];
#pragma unroll
    for (int ai = 0; ai < 2; ++ai)
#pragma unroll
        for (int m = 0; m < 4; ++m) rsv[ai][m] = rs[row0 + ai * 128 + m * 16];
    __builtin_amdgcn_sched_barrier(0);
#pragma unroll
    for (int ai = 0; ai < 2; ++ai)
#pragma unroll
        for (int m = 0; m < 4; ++m) { const int row = row0 + ai * 128 + m * 16; const float r = rsv[ai][m]; bf16_t* rowp = dst + (size_t)row * ldc + col0;
#pragma unroll
            for (int bj = 0; bj < 2; ++bj) { float v[8];
#pragma unroll
                for (int j = 0; j < 8; ++j) { float x = acc[ai][bj][m][j >> 2][j & 3] * r;
                    if (MODE == 0) x *= sc; if (MODE == 1) x = fgelu(x); if (MODE == 2) x = fsilu(x); if (MODE == 3) x = fsigmoid(x);
                    if (MODE == 4) { const float fg = lb[bj][j] + (1.0f - lb[bj][j]) * fsigmoid(x); x = __logf(fg); }
                    v[j] = x; }
                u32x4 w;
                if (MODE == 4) { w.x = pkh2(v[0], v[1]); w.y = pkh2(v[2], v[3]); w.z = pkh2(v[4], v[5]); w.w = pkh2(v[6], v[7]); }
                else { w.x = pk2(v[0], v[1]); w.y = pk2(v[2], v[3]); w.z = pk2(v[4], v[5]); w.w = pk2(v[6], v[7]); }
                *(u32x4*)(rowp + bj * 128) = w; } }
}
struct EpiP1 { static constexpr bool PERM = true;
    const float *rs1, *rsm, *lbl; bf16_t *U, *V, *HQ, *HF, *HI, *HG, *XQ, *GATES, *KV;
    __device__ __forceinline__ bool operator()(f32x4 (&acc)[2][2][4][2], const Unit& u, int wr, int wc, int fr, int fq) const {
        const int row0 = u.pm * 256 + wr * 64 + fr, cw = wc * 32 + 8 * fq;
        const int seg = u.pn >> 1, col0 = (u.pn & 1) * 256 + cw;
        if (u.pn >= 14) { p1_store<3>(acc, rs1, row0, GATES, 3072, (u.pn - 14) * 256 + cw, 1.f, nullptr, 0); return false; }
        switch (seg) {
            case 0: p1_store<1>(acc, rs1, row0, U, 512, col0, 1.f, nullptr, 0); break;
            case 1: p1_store<1>(acc, rs1, row0, V, 512, col0, 1.f, nullptr, 0); break;
            case 2: p1_store<2>(acc, rs1, row0, HQ, 512, col0, 1.f, nullptr, 0); break;
            case 3: p1_store<4>(acc, rs1, row0, HF, 512, col0, 1.f, lbl, col0); break;
            case 4: p1_store<0>(acc, rs1, row0, HI, 512, col0, 1.f, nullptr, 0); break;
            case 5: p1_store<2>(acc, rs1, row0, HG, 512, col0, 1.f, nullptr, 0); break;
            default: p1_store<0>(acc, rs1, row0, XQ, 512, col0, 0.08838834764831845f * 1.4426950408889634f, nullptr, 0); break;
        }
        return false;
    }
};

struct EpiKV { static constexpr bool PERM = true; const float* rsm; bf16_t* KV;
    __device__ __forceinline__ bool operator()(f32x4 (&acc)[2][2][4][2], const Unit& u, int wr, int wc, int fr, int fq) const {
        p1_store<0>(acc, rsm, u.pm * 256 + wr * 64 + fr, KV, 1024, u.pn * 256 + wc * 32 + 8 * fq, 1.0f, nullptr, 0); return false; } };
struct ProbN { int K, lda, ldb; const bf16_t *A_, *B_;
    __device__ __forceinline__ const char* a(const Unit& u) const { return (const char*)(A_ + (size_t)u.pm * 256 * lda); }
    __device__ __forceinline__ const char* b(const Unit& u) const { return (const char*)(B_ + (size_t)u.pn * 256 * ldb); } };
__device__ __forceinline__ void attn_phase(int c, int G, const bf16_t* XQ, const bf16_t* KV, bf16_t* COUT, LAS unsigned char* lds) {
    const int tid = otid(), lane = tid & 63, wave = tid >> 6, g = lane >> 4, l15 = lane & 15;
    LAS bf16_t* Ks = (LAS bf16_t*)lds; LAS bf16_t* Vs = Ks + 256 * 144;
    u32x4 pk[8], pv[8];
#define ATTN_ISSUE(it) do { const int _h = ((it) >> 4) & 3, _b = (it) >> 6; _Pragma("unroll") for (int i = 0; i < 8; ++i) { const int idx = tid + 512 * i, row = idx >> 4, ch = idx & 15; \
        const bf16_t* src = KV + (size_t)(_b * 256 + row) * 1024 + _h * 128 + ch * 8; pk[i] = *(const u32x4*)src; pv[i] = *(const u32x4*)(src + 512); } } while (0)
    if (c < 1024) ATTN_ISSUE(c);
#pragma unroll 1
    for (int item = c; item < 1024; item += G) {
        const int qt = item & 15, h = (item >> 4) & 3, b = item >> 6;
#pragma unroll
        for (int i = 0; i < 8; ++i) { const int idx = tid + 512 * i, row = idx >> 4, ch = idx & 15; *(LAS u32x4*)(Ks + row * 144 + ch * 8) = pk[i]; *(LAS u32x4*)(Vs + row * 144 + ch * 8) = pv[i]; }
        const int t = b * SEQ + qt * 128 + wave * 16 + l15;
        bf16x8 Qf[4];
#pragma unroll
        for (int ks = 0; ks < 4; ++ks) Qf[ks] = *(const bf16x8*)(XQ + (size_t)t * 512 + h * 128 + 32 * ks + 8 * g);
        LDS_SYNC();
        if (item + G < 1024) ATTN_ISSUE(item + G);
        f32x4 s[16];
#pragma unroll
        for (int i = 0; i < 16; ++i) { s[i] = (f32x4){0.f, 0.f, 0.f, 0.f};
#pragma unroll
            for (int ks = 0; ks < 4; ++ks) { const bf16x8 a = *(const LAS bf16x8*)(Ks + (16 * i + l15) * 144 + 32 * ks + 8 * g); s[i] = MFMA_BF16(a, Qf[ks], s[i]); } }
        float mx = -3.0e38f;
#pragma unroll
        for (int i = 0; i < 16; ++i) mx = fmaxf(fmaxf(fmaxf(s[i][0], s[i][1]), fmaxf(s[i][2], s[i][3])), mx);
        mx = fmaxf(mx, __shfl_xor(mx, 16)); mx = fmaxf(mx, __shfl_xor(mx, 32));
        float sum = 0.f;
#pragma unroll
        for (int i = 0; i < 16; ++i)
#pragma unroll
            for (int r = 0; r < 4; ++r) { const float p = __builtin_amdgcn_exp2f(s[i][r] - mx); s[i][r] = p; sum += p; }
        sum += __shfl_xor(sum, 16); sum += __shfl_xor(sum, 32);
        const float inv = 1.0f / sum;
        bf16x8 Pf[8];
#pragma unroll
        for (int kk = 0; kk < 8; ++kk) { u32x4 w; w.x = pk2(s[2 * kk][0] * inv, s[2 * kk][1] * inv); w.y = pk2(s[2 * kk][2] * inv, s[2 * kk][3] * inv);
            w.z = pk2(s[2 * kk + 1][0] * inv, s[2 * kk + 1][1] * inv); w.w = pk2(s[2 * kk + 1][2] * inv, s[2 * kk + 1][3] * inv); Pf[kk] = __builtin_bit_cast(bf16x8, w); }
        bf16_t* orow = COUT + (size_t)t * 512 + h * 128 + 4 * g;
#pragma unroll
        for (int dt = 0; dt < 8; ++dt) { f32x4 o = (f32x4){0.f, 0.f, 0.f, 0.f};
#pragma unroll
            for (int kk = 0; kk < 8; ++kk) { const bf16x8 a = tr8(Vs, 144, 32 * kk, 16 * dt, lane); o = MFMA_BF16(a, Pf[kk], o); }
            *(u32x2*)(orow + 16 * dt) = (u32x2){pk2(o[0], o[1]), pk2(o[2], o[3])}; }
        LDS_SYNC();
    }
#undef ATTN_ISSUE
}
__device__ __forceinline__ void sgu_item(int item, const bf16_t* U, const bf16_t* V, const float* lng, const float* lnb, const float* wsp, const float* bsp, bf16_t* AOUT, LAS unsigned char* lds) {
    const int tid = otid(), lane = tid & 63, wave = tid >> 6, g = lane >> 4, l15 = lane & 15;
    const int t0 = item * 128;
    LAS bf16_t* vn = (LAS bf16_t*)lds;
    { float gg[8], bb[8];
#pragma unroll
      for (int j = 0; j < 8; ++j) { gg[j] = lng[8 * lane + j]; bb[j] = lnb[8 * lane + j]; }
#pragma unroll 4
      for (int i = 0; i < 16; ++i) { const int srow = wave * 16 + i; const u32x4 w = *(const u32x4*)(V + (size_t)(t0 + srow) * 512 + 8 * lane);
        float v[8] = {bflo(w.x), bfhi(w.x), bflo(w.y), bfhi(w.y), bflo(w.z), bfhi(w.z), bflo(w.w), bfhi(w.w)};
        float s = 0.f;
#pragma unroll
        for (int j = 0; j < 8; ++j) s += v[j];
        const float mu = wave_sum(s) * (1.0f / 512.0f); float q = 0.f;
#pragma unroll
        for (int j = 0; j < 8; ++j) { v[j] -= mu; q += v[j] * v[j]; }
        const float rstd = 1.0f / sqrtf(wave_sum(q) * (1.0f / 512.0f) + EPS);
#pragma unroll
        for (int j = 0; j < 8; ++j) v[j] = v[j] * rstd * gg[j] + bb[j];
        *(LAS u32x4*)(vn + srow * 528 + 8 * lane) = (u32x4){pk2(v[0], v[1]), pk2(v[2], v[3]), pk2(v[4], v[5]), pk2(v[6], v[7])}; } }
    __syncthreads();
    const int tl = wave * 16 + l15, nks = (wave >> 1) + 1;
#pragma unroll 1
    for (int g4 = 0; g4 < 4; ++g4) {
        bf16x8 Wf[4];
#pragma unroll
        for (int ks = 0; ks < 4; ++ks) { Wf[ks] = (bf16x8){0, 0, 0, 0, 0, 0, 0, 0};
            if (ks < nks) { const float* wp = wsp + (size_t)(g4 * 128 + tl) * 128 + 32 * ks + 4 * g; const f32x4 w0 = *(const f32x4*)wp, w1 = *(const f32x4*)(wp + 16);
                const int s0 = 32 * ks + 4 * g, s1 = s0 + 16; float e[8];
#pragma unroll
                for (int j = 0; j < 4; ++j) { e[j] = (s0 + j <= tl) ? w0[j] : 0.f; e[4 + j] = (s1 + j <= tl) ? w1[j] : 0.f; }
                const u32x4 w = (u32x4){pk2(e[0], e[1]), pk2(e[2], e[3]), pk2(e[4], e[5]), pk2(e[6], e[7])}; Wf[ks] = __builtin_bit_cast(bf16x8, w); } }
        const float bias = bsp[g4 * 128 + tl];
#pragma unroll
        for (int ct = 0; ct < 8; ++ct) { const int c0 = g4 * 128 + 16 * ct; f32x4 acc = (f32x4){0.f, 0.f, 0.f, 0.f};
#pragma unroll
            for (int ks = 0; ks < 4; ++ks) if (ks < nks) { const bf16x8 a = tr8(vn, 528, 32 * ks, c0, lane); acc = MFMA_BF16(a, Wf[ks], acc); }
            const size_t o = (size_t)(t0 + tl) * 512 + c0 + 4 * g; const u32x2 uw = *(const u32x2*)(U + o);
            *(u32x2*)(AOUT + o) = (u32x2){pk2(bflo(uw.x) * (acc[0] + bias), bfhi(uw.x) * (acc[1] + bias)), pk2(bflo(uw.y) * (acc[2] + bias), bfhi(uw.y) * (acc[3] + bias))}; }
    }
    __syncthreads();
}
constexpr int H_LF = 0, H_A = 18432, H_T0 = 52224, H_T1 = 70656, H_T2 = 89088, H_VS = 107520, H_RED = 125952;
struct HTile { u32x4 lf[2], vs[2]; };
__device__ __forceinline__ void hgrn_issue(int item, const bf16_t* HF, const bf16_t* HI, HTile& T) {
    const int tid = otid(), n = item & 31, bh = item >> 5, t0 = (bh >> 2) * SEQ + n * 64, cb = (bh & 3) * 128;
#pragma unroll
    for (int i = 0; i < 2; ++i) { const int idx = tid + 512 * i, row = idx >> 4, ch = idx & 15; const size_t o = (size_t)(t0 + row) * 512 + cb + ch * 8;
        T.lf[i] = *(const u32x4*)(HF + o); T.vs[i] = *(const u32x4*)(HI + o); }
}
__device__ __forceinline__ void hgrn_store_cumsum(const HTile& T, LAS unsigned char* lds) {
    const int tid = otid(), lane = tid & 63, wave = tid >> 6, g = lane >> 4, l15 = lane & 15;
    LAS bf16_t* LF = (LAS bf16_t*)(lds + H_LF); LAS bf16_t* VS = (LAS bf16_t*)(lds + H_VS); LAS float* A_ = (LAS float*)(lds + H_A);
#pragma unroll
    for (int i = 0; i < 2; ++i) { const int idx = tid + 512 * i, row = idx >> 4, ch = idx & 15;
        *(LAS u32x4*)(LF + row * 144 + ch * 8) = T.lf[i]; *(LAS u32x4*)(VS + row * 144 + ch * 8) = T.vs[i]; }
    LDS_SYNC();
    f16x8 Bf[2];
#pragma unroll
    for (int ks = 0; ks < 2; ++ks) Bf[ks] = __builtin_bit_cast(f16x8, tr8(LF, 144, 32 * ks, 16 * wave, lane));
#pragma unroll
    for (int tt = 0; tt < 4; ++tt) { f32x4 acc = (f32x4){0.f, 0.f, 0.f, 0.f}; const int t = 16 * tt + l15;
#pragma unroll
        for (int ks = 0; ks < 2; ++ks) { f16x8 a;
#pragma unroll
            for (int j = 0; j < 8; ++j) { const int sI = 32 * ks + 4 * g + (j & 3) + 16 * (j >> 2); a[j] = (sI <= t) ? (_Float16)1.0f : (_Float16)0.0f; }
            acc = __builtin_amdgcn_mfma_f32_16x16x32_f16(a, Bf[ks], acc, 0, 0, 0); }
#pragma unroll
        for (int r = 0; r < 4; ++r) A_[(16 * tt + 4 * g + r) * 132 + 16 * wave + l15] = acc[r]; }
    LDS_SYNC();
}
__device__ __forceinline__ float h2f(unsigned short h) { return (float)__builtin_bit_cast(_Float16, h); }
__device__ __forceinline__ void hgrn1_phase(int c, int G, const bf16_t* HF, const bf16_t* HI, bf16_t* GS, float* HD, LAS unsigned char* lds) {
    const int tid = otid(), lane = tid & 63, wave = tid >> 6, g = lane >> 4, l15 = lane & 15;
    LAS bf16_t* LF = (LAS bf16_t*)(lds + H_LF); LAS bf16_t* VS = (LAS bf16_t*)(lds + H_VS); LAS float* A_ = (LAS float*)(lds + H_A); LAS bf16_t* KD = (LAS bf16_t*)(lds + H_T0);
    HTile T;
    if (c < 2048) hgrn_issue(c, HF, HI, T);
#pragma unroll 1
    for (int item = c; item < 2048; item += G) {
        hgrn_store_cumsum(T, lds);
        if (item + G < 2048) hgrn_issue(item + G, HF, HI, T);
        { const int t = tid >> 3, kc = (tid & 7) * 16; unsigned w[8];
          f32x4 av[4], alv[4];
#pragma unroll
          for (int j = 0; j < 4; ++j) { av[j] = *(const LAS f32x4*)(A_ + t * 132 + kc + 4 * j); alv[j] = *(const LAS f32x4*)(A_ + 63 * 132 + kc + 4 * j); }
          const u32x4 l0 = *(const LAS u32x4*)(LF + t * 144 + kc), l1 = *(const LAS u32x4*)(LF + t * 144 + kc + 8);
          const unsigned lw[8] = {l0.x, l0.y, l0.z, l0.w, l1.x, l1.y, l1.z, l1.w};
#pragma unroll
          for (int e = 0; e < 16; e += 2) { float o[2];
#pragma unroll
            for (int d = 0; d < 2; ++d) { const int ee = e + d; const float a = av[ee >> 2][ee & 3], al = alv[ee >> 2][ee & 3], lf = h2f((unsigned short)(lw[e >> 1] >> (16 * d))); o[d] = (1.0f - fexp(lf)) * fexp(al - a); }
            w[e >> 1] = pk2(o[0], o[1]); }
          *(LAS u32x4*)(KD + t * 144 + kc) = (u32x4){w[0], w[1], w[2], w[3]}; *(LAS u32x4*)(KD + t * 144 + kc + 8) = (u32x4){w[4], w[5], w[6], w[7]};
          if (tid < 128) HD[(size_t)item * 128 + tid] = fexp(A_[63 * 132 + tid]); }
        LDS_SYNC();
        bf16x8 Af[2];
#pragma unroll
        for (int ks = 0; ks < 2; ++ks) Af[ks] = tr8(KD, 144, 32 * ks, 16 * wave, lane);
        bf16_t* gp = GS + (size_t)item * 16384 + 16 * wave + 4 * g;
#pragma unroll
        for (int vt = 0; vt < 8; ++vt) { f32x4 acc = (f32x4){0.f, 0.f, 0.f, 0.f};
#pragma unroll
            for (int ks = 0; ks < 2; ++ks) { const bf16x8 bb = tr8(VS, 144, 32 * ks, 16 * vt, lane); acc = MFMA_BF16(Af[ks], bb, acc); }
            *(u32x2*)(gp + (size_t)(16 * vt + l15) * 128) = (u32x2){pk2(acc[0], acc[1]), pk2(acc[2], acc[3])}; }
        LDS_SYNC();
    }
}
__device__ __forceinline__ void hgrn2_scan(bf16_t* GS, const float* HD, int vb, int nvb) {
    for (int gid = vb * 512 + otid(); gid < 64 * 2048; gid += nvb * 512) {
        const int bh = gid >> 11, e8 = gid & 2047, kk0 = (8 * e8) & 127;
        float S[8] = {0.f, 0.f, 0.f, 0.f, 0.f, 0.f, 0.f, 0.f};
#pragma unroll 1
        for (int nb = 0; nb < 32; nb += 8) {
            u32x4 gw[8]; f32x4 d0[8], d1[8];
#pragma unroll
            for (int j = 0; j < 8; ++j) { const int item = bh * 32 + nb + j; gw[j] = *(const u32x4*)(GS + (size_t)item * 16384 + 8 * e8);
                d0[j] = *(const f32x4*)(HD + (size_t)item * 128 + kk0); d1[j] = *(const f32x4*)(HD + (size_t)item * 128 + kk0 + 4); }
#pragma unroll
            for (int j = 0; j < 8; ++j) { const int item = bh * 32 + nb + j;
                *(u32x4*)(GS + (size_t)item * 16384 + 8 * e8) = (u32x4){pk2(S[0], S[1]), pk2(S[2], S[3]), pk2(S[4], S[5]), pk2(S[6], S[7])};
                S[0] = d0[j][0] * S[0] + bflo(gw[j].x); S[1] = d0[j][1] * S[1] + bfhi(gw[j].x); S[2] = d0[j][2] * S[2] + bflo(gw[j].y); S[3] = d0[j][3] * S[3] + bfhi(gw[j].y);
                S[4] = d1[j][0] * S[4] + bflo(gw[j].z); S[5] = d1[j][1] * S[5] + bfhi(gw[j].z); S[6] = d1[j][2] * S[6] + bflo(gw[j].w); S[7] = d1[j][3] * S[7] + bfhi(gw[j].w); }
        }
    }
}
__device__ __forceinline__ void hgrn3_phase(int c, int G, const bf16_t* HQ, const bf16_t* HF, const bf16_t* HI, const bf16_t* HG, const bf16_t* GS, const float* ng, bf16_t* BOUT, LAS unsigned char* lds) {
    const int tid = otid(), lane = tid & 63, wave = tid >> 6, g = lane >> 4, l15 = lane & 15;
    LAS bf16_t* LF = (LAS bf16_t*)(lds + H_LF); LAS bf16_t* VS = (LAS bf16_t*)(lds + H_VS); LAS float* A_ = (LAS float*)(lds + H_A);
    LAS bf16_t* QI = (LAS bf16_t*)(lds + H_T0); LAS bf16_t* QE = (LAS bf16_t*)(lds + H_T1); LAS bf16_t* KE = (LAS bf16_t*)(lds + H_T2); LAS float* RED = (LAS float*)(lds + H_RED);
    const int tt = wave & 3, vh = wave >> 2, tl = 16 * tt + l15;
    HTile T;
    if (c < 2048) hgrn_issue(c, HF, HI, T);
    f32x4 nwv[4];
#pragma unroll
    for (int vt = 0; vt < 4; ++vt) nwv[vt] = *(const f32x4*)(ng + 64 * vh + 16 * vt + 4 * g);
#pragma unroll 1
    for (int item = c; item < 2048; item += G) {
        const int n = item & 31, bh = item >> 5, h = bh & 3, b = bh >> 2, t0 = b * SEQ + n * 64, cb = h * 128;
        const int te = tid >> 3, kc = (tid & 7) * 16;
        const u32x4 q0 = *(const u32x4*)(HQ + (size_t)(t0 + te) * 512 + cb + kc), q1 = *(const u32x4*)(HQ + (size_t)(t0 + te) * 512 + cb + kc + 8);
        const bf16_t* ST = GS + (size_t)item * 16384;
        bf16x8 Sf[4][4]; u32x2 gw[4];
#pragma unroll
        for (int vt = 0; vt < 4; ++vt) { const int vd0 = 64 * vh + 16 * vt;
            gw[vt] = *(const u32x2*)(HG + (size_t)(t0 + tl) * 512 + cb + vd0 + 4 * g);
#pragma unroll
            for (int ks = 0; ks < 4; ++ks) Sf[vt][ks] = *(const bf16x8*)(ST + (size_t)(vd0 + l15) * 128 + 32 * ks + 8 * g); }
        hgrn_store_cumsum(T, lds);
        { unsigned wi[8], we[8], wk[8];
          const unsigned qw[8] = {q0.x, q0.y, q0.z, q0.w, q1.x, q1.y, q1.z, q1.w};
          f32x4 av[4], amv[4];
#pragma unroll
          for (int j = 0; j < 4; ++j) { av[j] = *(const LAS f32x4*)(A_ + te * 132 + kc + 4 * j); amv[j] = *(const LAS f32x4*)(A_ + 31 * 132 + kc + 4 * j); }
          const u32x4 l0 = *(const LAS u32x4*)(LF + te * 144 + kc), l1 = *(const LAS u32x4*)(LF + te * 144 + kc + 8);
          const unsigned lw[8] = {l0.x, l0.y, l0.z, l0.w, l1.x, l1.y, l1.z, l1.w};
#pragma unroll
          for (int e = 0; e < 16; e += 2) { float oi[2], oe[2], ok[2];
#pragma unroll
            for (int d = 0; d < 2; ++d) { const int ee = e + d; const float a = av[ee >> 2][ee & 3], am = amv[ee >> 2][ee & 3], lf = h2f((unsigned short)(lw[e >> 1] >> (16 * d)));
                const float q = d ? bfhi(qw[e >> 1]) : bflo(qw[e >> 1]);
                oi[d] = q * fexp(a); oe[d] = q * fexp(a - am); ok[d] = (1.0f - fexp(lf)) * fexp(am - a); }
            wi[e >> 1] = pk2(oi[0], oi[1]); we[e >> 1] = pk2(oe[0], oe[1]); wk[e >> 1] = pk2(ok[0], ok[1]); }
          *(LAS u32x4*)(QI + te * 144 + kc) = (u32x4){wi[0], wi[1], wi[2], wi[3]}; *(LAS u32x4*)(QI + te * 144 + kc + 8) = (u32x4){wi[4], wi[5], wi[6], wi[7]};
          *(LAS u32x4*)(QE + te * 144 + kc) = (u32x4){we[0], we[1], we[2], we[3]}; *(LAS u32x4*)(QE + te * 144 + kc + 8) = (u32x4){we[4], we[5], we[6], we[7]};
          *(LAS u32x4*)(KE + te * 144 + kc) = (u32x4){wk[0], wk[1], wk[2], wk[3]}; *(LAS u32x4*)(KE + te * 144 + kc + 8) = (u32x4){wk[4], wk[5], wk[6], wk[7]}; }
        LDS_SYNC();
        if (item + G < 2048) hgrn_issue(item + G, HF, HI, T);
        f32x4 P[4];
#pragma unroll
        for (int si = 0; si < 4; ++si) { P[si] = (f32x4){0.f, 0.f, 0.f, 0.f};
            if (si <= tt) {
#pragma unroll
                for (int ks = 0; ks < 4; ++ks) { const bf16x8 a = *(const LAS bf16x8*)(KE + (16 * si + l15) * 144 + 32 * ks + 8 * g), bb = *(const LAS bf16x8*)(QE + tl * 144 + 32 * ks + 8 * g); P[si] = MFMA_BF16(a, bb, P[si]); }
                if (si == tt) {
#pragma unroll
                    for (int r = 0; r < 4; ++r) if (4 * g + r > l15) P[si][r] = 0.f; } } }
        bf16x8 Pf[2];
#pragma unroll
        for (int k2 = 0; k2 < 2; ++k2) { const u32x4 w = (u32x4){pk2(P[2 * k2][0], P[2 * k2][1]), pk2(P[2 * k2][2], P[2 * k2][3]), pk2(P[2 * k2 + 1][0], P[2 * k2 + 1][1]), pk2(P[2 * k2 + 1][2], P[2 * k2 + 1][3])}; Pf[k2] = __builtin_bit_cast(bf16x8, w); }
        bf16x8 Qf[4];
#pragma unroll
        for (int ks = 0; ks < 4; ++ks) Qf[ks] = *(const LAS bf16x8*)(QI + tl * 144 + 32 * ks + 8 * g);
        f32x4 o[4]; float ssq = 0.f;
#pragma unroll
        for (int vt = 0; vt < 4; ++vt) { const int vd0 = 64 * vh + 16 * vt; o[vt] = (f32x4){0.f, 0.f, 0.f, 0.f};
#pragma unroll
            for (int k2 = 0; k2 < 2; ++k2) if (2 * k2 <= tt) { const bf16x8 a = tr8(VS, 144, 32 * k2, vd0, lane); o[vt] = MFMA_BF16(a, Pf[k2], o[vt]); }
#pragma unroll
            for (int ks = 0; ks < 4; ++ks) o[vt] = MFMA_BF16(Sf[vt][ks], Qf[ks], o[vt]);
            ssq += (o[vt][0] * o[vt][0] + o[vt][1] * o[vt][1]) + (o[vt][2] * o[vt][2] + o[vt][3] * o[vt][3]); }
        ssq += __shfl_xor(ssq, 16); ssq += __shfl_xor(ssq, 32);
        if (g == 0) RED[vh * 64 + tl] = ssq;
        LDS_SYNC();
        const float rstd = 1.0f / sqrtf((RED[tl] + RED[64 + tl]) * (1.0f / 128.0f) + EPS);
#pragma unroll
        for (int vt = 0; vt < 4; ++vt) { const int vd = 64 * vh + 16 * vt + 4 * g; const size_t off = (size_t)(t0 + tl) * 512 + cb + vd;
            const f32x4 nw = nwv[vt];
            *(u32x2*)(BOUT + off) = (u32x2){pk2(o[vt][0] * rstd * nw[0] * bflo(gw[vt].x), o[vt][1] * rstd * nw[1] * bfhi(gw[vt].x)), pk2(o[vt][2] * rstd * nw[2] * bflo(gw[vt].y), o[vt][3] * rstd * nw[3] * bfhi(gw[vt].y))}; }
        LDS_SYNC();
    }
}

struct ProbP3 { int K, lda, ldb; const bf16_t *br, *wbr;
    __device__ __forceinline__ const char* a(const Unit& u) const { return (const char*)(br + (size_t)u.z * M * 512 + (size_t)u.pm * 256 * 512); }
    __device__ __forceinline__ const char* b(const Unit& u) const { return (const char*)(wbr + (size_t)u.z * 1024 * 512 + (size_t)u.pn * 256 * 512); } };
struct SchedP3 { int G, c;
    __device__ __forceinline__ bool next(int i, Unit& u) const { const int L = (i / 3) * G + c; if (L >= 512) return false; pg8::tile_map(L, 128, 4, u); u.z = i % 3; return true; } };
struct EpiP3 { static constexpr bool PERM = true; const bf16_t* GATES; bf16_t* MERGED;
    __device__ __forceinline__ bool operator()(f32x4 (&acc)[2][2][4][2], const Unit& u, int wr, int wc, int fr, int fq) const {
        const int row0 = u.pm * 256 + wr * 64 + fr, col0 = u.pn * 256 + wc * 32 + 8 * fq;
#pragma unroll
        for (int ai = 0; ai < 2; ++ai) {
            u32x4 g0[4][2], g1[4][2];
#pragma unroll
            for (int m = 0; m < 4; ++m)
#pragma unroll
                for (int bj = 0; bj < 2; ++bj) { const bf16_t* gp = GATES + (size_t)(row0 + ai * 128 + m * 16) * 3072 + u.z * 1024 + col0 + bj * 128;
                    g0[m][bj] = *(const u32x4*)gp; g1[m][bj] = (u.z < 2) ? *(const u32x4*)(gp + 1024) : (u32x4){0x3f803f80u, 0x3f803f80u, 0x3f803f80u, 0x3f803f80u}; }
            __builtin_amdgcn_sched_barrier(0);
#pragma unroll
            for (int m = 0; m < 4; ++m) { const int row = row0 + ai * 128 + m * 16;
#pragma unroll
                for (int bj = 0; bj < 2; ++bj) { const u32x4 a = g0[m][bj], d4 = g1[m][bj];
                    float f[8] = {bflo(a.x), bfhi(a.x), bflo(a.y), bfhi(a.y), bflo(a.z), bfhi(a.z), bflo(a.w), bfhi(a.w)};
                    if (u.z < 2) { const float d[8] = {bflo(d4.x), bfhi(d4.x), bflo(d4.y), bfhi(d4.y), bflo(d4.z), bfhi(d4.z), bflo(d4.w), bfhi(d4.w)};
#pragma unroll
                        for (int j = 0; j < 8; ++j) f[j] = f[j] * __builtin_amdgcn_rcpf(fmaxf(d[j], 1e-30f)); }
#pragma unroll
                    for (int j = 0; j < 8; ++j) acc[ai][bj][m][j >> 2][j & 3] *= f[j];
                    if (u.z == 2) { const f32x4 v0 = acc[ai][bj][m][0], v1 = acc[ai][bj][m][1];
                        *(u32x4*)(MERGED + (size_t)row * 1024 + col0 + bj * 128) = (u32x4){pk2(v0[0], v0[1]), pk2(v0[2], v0[3]), pk2(v1[0], v1[1]), pk2(v1[2], v1[3])}; } } }
            __builtin_amdgcn_sched_barrier(0);
        }
        return u.z < 2;
    }
};

struct SchedN { int G, c, nM, nN, rep = 1;
    __device__ __forceinline__ bool next(int i, Unit& u) const { const int nwg = nM * nN, cnt = (nwg - c + G - 1) / G; if (i >= rep * cnt) return false; const int L = (i % cnt) * G + c; pg8::tile_map(L, nM, nN, u); u.z = 0; return true; } };
struct EpiP4 { static constexpr bool PERM = true; const float* base; bf16_t* ob; float* ssq;
    __device__ __forceinline__ bool operator()(f32x4 (&acc)[2][2][4][2], const Unit& u, int wr, int wc, int fr, int fq) const {
        const int row0 = u.pm * 256 + wr * 64 + fr, col0 = u.pn * 256 + wc * 32 + 8 * fq;
#pragma unroll
        for (int ah = 0; ah < 4; ++ah) { const int ai = ah >> 1, mb = (ah & 1) * 2;
            f32x4 bs[4][2][2];
#pragma unroll
            for (int m = mb; m < mb + 2; ++m)
#pragma unroll
                for (int bj = 0; bj < 2; ++bj)
#pragma unroll
                    for (int n = 0; n < 2; ++n) bs[m][bj][n] = *(const f32x4*)(base + (size_t)(row0 + ai * 128 + m * 16) * 1024 + col0 + bj * 128 + n * 4);
            __builtin_amdgcn_sched_barrier(0);
#pragma unroll
            for (int m = mb; m < mb + 2; ++m) { const int row = row0 + ai * 128 + m * 16; const size_t off = (size_t)row * 1024 + col0; float s = 0.f;
#pragma unroll
                for (int bj = 0; bj < 2; ++bj) { const f32x4 v0 = bs[m][bj][0] + acc[ai][bj][m][0], v1 = bs[m][bj][1] + acc[ai][bj][m][1];
                    s += (v0[0] * v0[0] + v0[1] * v0[1]) + (v0[2] * v0[2] + v0[3] * v0[3]) + (v1[0] * v1[0] + v1[1] * v1[1]) + (v1[2] * v1[2] + v1[3] * v1[3]);
                    *(u32x4*)(ob + off + bj * 128) = (u32x4){pk2(v0[0], v0[1]), pk2(v0[2], v0[3]), pk2(v1[0], v1[1]), pk2(v1[2], v1[3])}; }
                s += __shfl_xor(s, 16); s += __shfl_xor(s, 32);
                if (fq == 0) atomicAdd(ssq + row, s); }
            __builtin_amdgcn_sched_barrier(0);
        }
        return false;
    }
};
struct EpiP6 { static constexpr bool PERM = true; const bf16_t* base; bf16_t* ob; float* ssq; int nofn;
    __device__ __forceinline__ bool operator()(f32x4 (&acc)[2][2][4][2], const Unit& u, int wr, int wc, int fr, int fq) const {
        const int row0 = u.pm * 256 + wr * 64 + fr, col0 = u.pn * 256 + wc * 32 + 8 * fq;
#pragma unroll
        for (int ai = 0; ai < 2; ++ai) {
        u32x4 bs[2][4][2];
#pragma unroll
            for (int m = 0; m < 4; ++m)
#pragma unroll
                for (int bj = 0; bj < 2; ++bj) bs[ai][m][bj] = *(const u32x4*)(base + (size_t)(row0 + ai * 128 + m * 16) * 1024 + col0 + bj * 128);
        __builtin_amdgcn_sched_barrier(0);
#pragma unroll
            for (int m = 0; m < 4; ++m) { const int row = row0 + ai * 128 + m * 16; const size_t off = (size_t)row * 1024 + col0; float s = 0.f;
#pragma unroll
                for (int bj = 0; bj < 2; ++bj) { const u32x4 w = bs[ai][m][bj];
                    f32x4 v0 = (f32x4){bflo(w.x), bfhi(w.x), bflo(w.y), bfhi(w.y)}, v1 = (f32x4){bflo(w.z), bfhi(w.z), bflo(w.w), bfhi(w.w)};
                    if (!nofn) { v0 = v0 + acc[ai][bj][m][0]; v1 = v1 + acc[ai][bj][m][1]; }
                    s += (v0[0] * v0[0] + v0[1] * v0[1]) + (v0[2] * v0[2] + v0[3] * v0[3]) + (v1[0] * v1[0] + v1[1] * v1[1]) + (v1[2] * v1[2] + v1[3] * v1[3]);
                    *(u32x4*)(ob + off + bj * 128) = (u32x4){pk2(v0[0], v0[1]), pk2(v0[2], v0[3]), pk2(v1[0], v1[1]), pk2(v1[2], v1[3])}; }
                s += __shfl_xor(s, 16); s += __shfl_xor(s, 32);
                if (fq == 0) atomicAdd(ssq + row, s); }
        __builtin_amdgcn_sched_barrier(0);
        }
        return false;
    }
};

__device__ __forceinline__ float dpp_ror1(float x) { return __builtin_bit_cast(float, __builtin_amdgcn_update_dpp(0, __builtin_bit_cast(int, x), 0x121, 0xf, 0xf, false)); }
__device__ __forceinline__ float dpp_ror2(float x) { return __builtin_bit_cast(float, __builtin_amdgcn_update_dpp(0, __builtin_bit_cast(int, x), 0x122, 0xf, 0xf, false)); }
struct EpiP5 { static constexpr bool PERM = true; const float *ssq2, *cw, *cbias; bf16_t* ACT; float *HALO, *TOPA, *TOPB;
    __device__ __forceinline__ bool operator()(f32x4 (&acc)[2][2][4][2], const Unit& u, int wr, int wc, int fr, int fq) const {
        const int ch0 = u.pn * 128 + wc * 32 + 8 * fq;
        float w0[8], w1[8], w2[8], cb[8], rr[2][4];
        { const f32x4 a0 = *(const f32x4*)(cw + ch0), a1 = *(const f32x4*)(cw + ch0 + 4), b0 = *(const f32x4*)(cw + DFF + ch0), b1 = *(const f32x4*)(cw + DFF + ch0 + 4),
                      c0 = *(const f32x4*)(cw + 2 * DFF + ch0), c1 = *(const f32x4*)(cw + 2 * DFF + ch0 + 4), d0 = *(const f32x4*)(cbias + ch0), d1 = *(const f32x4*)(cbias + ch0 + 4);
#pragma unroll
          for (int ai = 0; ai < 2; ++ai)
#pragma unroll
              for (int m = 0; m < 4; ++m) rr[ai][m] = ssq2[(u.pm * 4 + ai * 2 + wr) * 64 + m * 16 + fr];
#pragma unroll
          for (int j = 0; j < 4; ++j) { w0[j] = a0[j]; w0[4 + j] = a1[j]; w1[j] = b0[j]; w1[4 + j] = b1[j]; w2[j] = c0[j]; w2[4 + j] = c1[j]; cb[j] = d0[j]; cb[4 + j] = d1[j]; } }
#pragma unroll
        for (int ai = 0; ai < 2; ++ai) {
            const int blk = u.pm * 4 + ai * 2 + wr, rowb = blk * 64;
            float p1[8], p2[8];
#pragma unroll
            for (int j = 0; j < 8; ++j) { p1[j] = 0.f; p2[j] = 0.f; }
#pragma unroll
            for (int m = 0; m < 4; ++m) { const int row = rowb + m * 16 + fr; const float r = 1.0f / sqrtf(rr[ai][m] * (1.0f / D) + EPS);
                float a[8], bv[8], r1[8], r2[8];
#pragma unroll
                for (int j = 0; j < 8; ++j) { a[j] = acc[ai][0][m][j >> 2][j & 3] * r; bv[j] = acc[ai][1][m][j >> 2][j & 3] * r; r1[j] = dpp_ror1(a[j]); r2[j] = dpp_ror2(a[j]); }
                float o[8];
#pragma unroll
                for (int j = 0; j < 8; ++j) { const float am1 = fr >= 1 ? r1[j] : p1[j], am2 = fr >= 2 ? r2[j] : p2[j]; const float cv = cb[j] + w0[j] * am2 + w1[j] * am1 + w2[j] * a[j]; o[j] = fsilu(cv) * bv[j]; p1[j] = r1[j]; p2[j] = r2[j]; }
                if (m > 0 || fr >= 2) *(u32x4*)(ACT + (size_t)row * DFF + ch0) = (u32x4){pk2(o[0], o[1]), pk2(o[2], o[3]), pk2(o[4], o[5]), pk2(o[6], o[7])};
                else { float* ta = TOPA + ((size_t)blk * 2 + fr) * DFF + ch0; float* tb = TOPB + ((size_t)blk * 2 + fr) * DFF + ch0;
                    *(f32x4*)ta = (f32x4){a[0], a[1], a[2], a[3]}; *(f32x4*)(ta + 4) = (f32x4){a[4], a[5], a[6], a[7]}; *(f32x4*)tb = (f32x4){bv[0], bv[1], bv[2], bv[3]}; *(f32x4*)(tb + 4) = (f32x4){bv[4], bv[5], bv[6], bv[7]}; }
                if (m == 3 && fr >= 14) { float* hp = HALO + ((size_t)blk * 2 + (fr - 14)) * DFF + ch0; *(f32x4*)hp = (f32x4){a[0], a[1], a[2], a[3]}; *(f32x4*)(hp + 4) = (f32x4){a[4], a[5], a[6], a[7]}; }
            }
        }
        return false;
    }
};
__device__ __forceinline__ void p6_fix_all(int c, int G, const float* HALO, const float* TOPA, const float* TOPB, const float* cw, const float* cbias, bf16_t* ACT) {
    constexpr int NV = DFF / 4;
#pragma unroll 2
    for (int i = c * 512 + otid(); i < 512 * 2 * NV; i += G * 512) { const int ch = 4 * (i % NV), lr = (i / NV) & 1, blk = i / (2 * NV); const bool first = (blk & 31) == 0;
        const size_t hb = (size_t)(first ? blk : blk - 1) * 2 * DFF + ch, tb = (size_t)blk * 2 * DFF + ch;
        f32x4 h0 = *(const f32x4*)(HALO + hb), h1 = *(const f32x4*)(HALO + hb + DFF);
        if (first) { h0 = (f32x4){0.f, 0.f, 0.f, 0.f}; h1 = h0; }
        const f32x4 t0 = *(const f32x4*)(TOPA + tb), t1 = *(const f32x4*)(TOPA + tb + DFF), bv = *(const f32x4*)(TOPB + tb + (size_t)lr * DFF);
        const f32x4 w0 = *(const f32x4*)(cw + ch), w1 = *(const f32x4*)(cw + DFF + ch), w2 = *(const f32x4*)(cw + 2 * DFF + ch), cb = *(const f32x4*)(cbias + ch);
        const f32x4 am2 = lr ? h1 : h0, am1 = lr ? t0 : h1, a0 = lr ? t1 : t0;
        float o[4];
#pragma unroll
        for (int e = 0; e < 4; ++e) o[e] = fsilu(cb[e] + w0[e] * am2[e] + w1[e] * am1[e] + w2[e] * a0[e]) * bv[e];
        *(u32x2*)(ACT + (size_t)(blk * 64 + lr) * DFF + ch) = (u32x2){pk2(o[0], o[1]), pk2(o[2], o[3])}; }
}

__global__ void __launch_bounds__(512, 2) hybrid_fwd(Args A) {
    extern __shared__ __attribute__((aligned(16))) unsigned char lds_raw[];
    LAS unsigned char* lds = (LAS unsigned char*)lds_raw;
    cg::grid_group grid = cg::this_grid();
    unsigned char* ws = A.ws; const int G = gridDim.x, c = blockIdx.x;
    bf16_t* WIN = (bf16_t*)(ws + WS_WIN); bf16_t* WKV = (bf16_t*)(ws + WS_WKV); bf16_t* WBR = (bf16_t*)(ws + WS_WBR); bf16_t* WO = (bf16_t*)(ws + WS_WO); bf16_t* WUP = (bf16_t*)(ws + WS_WUP); bf16_t* WD = (bf16_t*)(ws + WS_WD);
    float* RS1 = (float*)(ws + WS_RS1); float* RSM = (float*)(ws + WS_RSM); float* SSQ2 = (float*)(ws + WS_SSQ2); float* SSQ3 = (float*)(ws + WS_SSQ3); float* HD = (float*)(ws + WS_HD);
    bf16_t* XB = (bf16_t*)(ws + WS_XB); bf16_t* GS = XB; bf16_t* MERGED = XB; bf16_t* X2B = XB; bf16_t* MEMB = (bf16_t*)(ws + WS_MEMB); bf16_t* KV = (bf16_t*)(ws + WS_KV);
    bf16_t* HI = (bf16_t*)(ws + WS_HI); bf16_t* HG = (bf16_t*)(ws + WS_HG); bf16_t* XQ = (bf16_t*)(ws + WS_XQ); bf16_t* X1B = HI;
    bf16_t* GATES = (bf16_t*)(ws + WS_GATES); bf16_t* ACT = GATES;
    bf16_t* AOUT = (bf16_t*)(ws + WS_AOUT); bf16_t* BOUT = (bf16_t*)(ws + WS_BOUT); bf16_t* COUT = (bf16_t*)(ws + WS_COUT);
    float* HALO = (float*)(ws + WS_AOUT); float* TOPA = HALO + (size_t)512 * 2 * DFF; float* TOPB = TOPA + (size_t)512 * 2 * DFF;
    bf16_t* U = (bf16_t*)A.out; bf16_t* V = U + (size_t)M * 512; bf16_t* HQ = V + (size_t)M * 512; bf16_t* HF = HQ + (size_t)M * 512;
    const int lo = A.ph_lo, hi = A.ph_hi;
    const unsigned stg = 0u;
#define IN(k) (lo <= (k) && (k) < hi)
#define SEAM(k) do { if (IN(k) && IN((k) + 1)) { if (lo < 0) grid.sync(); else xcd_barrier(xbar); } } while (0)
    unsigned long long tp0 = 0ull;
#define TSTART(k) do { if (DBG_TPHASE == (k) && c == 0 && threadIdx.x == 0) tp0 = __builtin_amdgcn_s_memrealtime(); } while (0)
#define TEND(k) do { if (DBG_TPHASE == (k) && c == 0 && threadIdx.x == 0) { *(volatile unsigned*)(ws + WS_BAR + 32768) = (unsigned)(__builtin_amdgcn_s_memrealtime() - tp0); } if (DBG_TPHASE == (k) && (k) == 9) xcd_barrier(xbar); } while (0)
    volatile LAS unsigned* xst = (volatile LAS unsigned*)(lds + LDS_BYTES - 16);
    if (threadIdx.x < 4) xst[threadIdx.x] = 0u;
    __syncthreads();
    XcdBarrier xbar; xbar.bar = (unsigned*)(ws + WS_BAR); xbar.x = 0; xbar.st = xst;
    if (hi - lo > 1) xbar = xcd_barrier_post((unsigned*)(ws + WS_BAR), xst);
    if (hi - lo == NPHASE_K) for (int q = 0; q < DBG_XSYNC; ++q) grid.sync();
    TSTART(0);
    if (IN(0)) { p0_prologue(A, lds); if (DBG_DUP == 100) { __syncthreads(); p0_prologue(A, lds); } }
    SEAM(0);
    TEND(0); TSTART(1);
    if (IN(1)) { ProbN P{1024, 1024, 1024, XB, WIN}; SchedP1 S{G, c}; EpiP1 E{RS1, RSM, A.in[I_LB], U, V, HQ, HF, HI, HG, XQ, GATES, KV}; pg8::gemm_phase(lds, P, S, E, stg * 650u); }
    SEAM(1);
    TEND(1); TSTART(2);
    for (int rep = 0; rep < 1 + (DBG_DUP == 2); ++rep) if (IN(2)) {
        hgrn1_phase(c, G, HF, HI, GS, HD, lds);
        __syncthreads();
        for (int it = c; it < 256; it += G) sgu_item(it, U, V, A.in[I_LNG], A.in[I_LNB], A.in[I_WSP], A.in[I_BSP], AOUT, lds);
    }
    SEAM(2);
    TEND(2); TSTART(3);
    if (IN(3)) {
        const bool split = G > 64;
        if (!split || c >= 64) hgrn2_scan(GS, HD, split ? c - 64 : c, split ? G - 64 : G);
        if (c < 64) { __syncthreads(); ProbN P{1024, 1024, 1024, MEMB, WKV}; SchedKV S{G, c}; EpiKV E{RSM, KV}; pg8::gemm_phase(lds, P, S, E); }
    }
    SEAM(3);
    TEND(3); TSTART(4);
    for (int rep = 0; rep < 1 + (DBG_DUP == 4); ++rep) if (IN(4)) {
        if (!((DBG_ZERO_MASK >> 1) & 1)) hgrn3_phase(c, G, HQ, HF, HI, HG, GS, A.in[I_HNG], BOUT, lds);
        __syncthreads();
        attn_phase(c, G, XQ, KV, COUT, lds);
        __syncthreads();
        for (int z = 0; z < 3; ++z) if ((DBG_ZERO_MASK >> z) & 1) { u32x4* p = (u32x4*)(AOUT + (size_t)z * M * 512);
            for (size_t i = (size_t)c * 512 + threadIdx.x; i < (size_t)M * 512 / 8; i += (size_t)G * 512) p[i] = (u32x4){0u, 0u, 0u, 0u}; } }
    SEAM(4);
    TEND(4); TSTART(5);
    for (int rep = 0; rep < 1 + (DBG_DUP == 5); ++rep) if (IN(5)) { ProbP3 P{512, 512, 512, AOUT, WBR}; SchedP3 S{G, c}; EpiP3 E{GATES, MERGED}; pg8::gemm_phase(lds, P, S, E, stg * 300u); }
    SEAM(5);
    TEND(5); TSTART(6);
    if (IN(6)) { ProbN P{1024, 1024, 1024, MERGED, WO}; SchedN S{G, c, 128, 4}; EpiP4 E{A.in[I_X], X1B, SSQ2}; pg8::gemm_phase(lds, P, S, E, stg * 400u); }
    SEAM(6);
    TEND(6); TSTART(7);
    for (int rep = 0; rep < 1 + (DBG_DUP == 7); ++rep) if (IN(7)) { ProbN P{1024, 1024, 1024, X1B, WUP}; SchedN S{G, c, 128, 22, DBG_REP5}; EpiP5 E{SSQ2, A.in[I_CW], A.in[I_CB], ACT, HALO, TOPA, TOPB}; pg8::gemm_phase(lds, P, S, E, stg * 650u); }
    SEAM(7);
    TEND(7); TSTART(8);
    if (IN(8)) p6_fix_all(c, G, HALO, TOPA, TOPB, A.in[I_CW], A.in[I_CB], ACT);
    SEAM(8);
    TEND(8); TSTART(9);
    if (IN(9)) { SchedN S{G, c, 128, 4}; ProbN P{DFF, DFF, DFF, ACT, WD}; EpiP6 E{X1B, X2B, SSQ3, DBG_NO_FFN}; pg8::gemm_phase(lds, P, S, E, stg * 600u); }
    SEAM(9);
    TEND(9); TSTART(10);
    if (IN(10)) {
        const int t9 = otid(), lane = t9 & 63, gw = c * 8 + (t9 >> 6), NGW = G * 8; const float* fg = A.in[I_FG];
        f32x4 gv[4];
#pragma unroll
        for (int j = 0; j < 4; ++j) gv[j] = *((const f32x4*)fg + lane + 64 * j);
        const float tsc = (DBG_TPHASE >= 0) ? 1.0f + (float)(*(volatile unsigned*)(ws + WS_BAR + 32768)) * 0.01f * DBG_TSCALE : 1.0f;
        for (int m0 = 4 * gw; m0 < M; m0 += 4 * NGW) {
            u32x2 w[4][4]; float r[4];
#pragma unroll
            for (int q = 0; q < 4; ++q) { r[q] = tsc / sqrtf(SSQ3[m0 + q] * (1.0f / D) + EPS);
#pragma unroll
                for (int j = 0; j < 4; ++j) w[q][j] = *((const u32x2*)(X2B + (size_t)(m0 + q) * D) + lane + 64 * j); }
#pragma unroll
            for (int q = 0; q < 4; ++q) { f32x4* p = (f32x4*)(A.out + (size_t)(m0 + q) * D) + lane;
#pragma unroll
                for (int j = 0; j < 4; ++j) { f32x4 o = (f32x4){bflo(w[q][j].x), bfhi(w[q][j].x), bflo(w[q][j].y), bfhi(w[q][j].y)} * r[q] * gv[j];
#if DBG_SANITIZE
                    for (int e = 0; e < 4; ++e) if (!(fabsf(o[e]) < 1e30f)) o[e] = 0.f;
#endif
                    p[64 * j] = o; } } }
    }
#undef IN
#undef SEAM
}

constexpr int NPHASE = 11;
extern "C" void kernel_launch(void* const* d_in, const int* in_sizes, int n_in, void* d_out, int out_size, void* d_ws, size_t ws_size, hipStream_t stream) {
    static int grid = 0;
    if (grid == 0) {
        if (n_in != 20 || out_size != M * D || ws_size < WS_END) { fprintf(stderr, "kernel_launch: unexpected shapes (n_in %d out %d ws %zu)\n", n_in, out_size, ws_size); grid = -1; return; }
        int dev = 0, cus = 0, per_cu = 0;
        hipGetDevice(&dev); hipDeviceGetAttribute(&cus, hipDeviceAttributeMultiprocessorCount, dev);
        hipFuncSetAttribute((const void*)hybrid_fwd, hipFuncAttributeMaxDynamicSharedMemorySize, LDS_BYTES);
        hipOccupancyMaxActiveBlocksPerMultiprocessor(&per_cu, (const void*)hybrid_fwd, 512, LDS_BYTES);
        if (per_cu < 1) { fprintf(stderr, "kernel_launch: occupancy query says %d blocks per CU\n", per_cu); per_cu = 1; }
        (void)hipGetLastError();
        grid = cus * 1;
        if (grid > cus * per_cu) grid = cus * per_cu;
    }
    if (grid <= 0) return;
    Args a{};
    for (int i = 0; i < 20; ++i) a.in[i] = (const float*)d_in[i];
    a.out = (float*)d_out; a.ws = (unsigned char*)d_ws;
#if MK_PER_PHASE
    for (int p = 0; p < NPHASE; ++p) { a.ph_lo = p; a.ph_hi = p + 1; hipLaunchKernelGGL(hybrid_fwd, dim3(grid), dim3(512), LDS_BYTES, stream, a); }
#else
    a.ph_lo = 0; a.ph_hi = NPHASE;
    (void)hipMemsetAsync((unsigned char*)d_ws + WS_BAR, 0, XCD_BAR_WORDS * 4, stream);
    void* args[] = {&a};
    hipError_t e = hipLaunchCooperativeKernel((const void*)hybrid_fwd, dim3(grid), dim3(512), args, LDS_BYTES, stream);
    if (e != hipSuccess) fprintf(stderr, "cooperative launch failed: %s (grid %d)\n", hipGetErrorString(e), grid);
#endif
}
```
